# Optimizing an MI355X kernel written in HIP

```python
import math, functools
import jax, jax.numpy as jnp
from jax import lax
import numpy as np

D_MODEL = 1024
BATCH = 8
SEQ = 4096
DEPTH = 1

GRID_W = 64
CTX_LEN = 256
D_MIX = D_MODEL
D_SSM = D_MIX // 2
SSM_HEADDIM = 64
SSM_HEADS = D_SSM // SSM_HEADDIM
SSM_STATE = 128
SSM_GROUPS = 2
SSM_CONV = 5
SSD_CHUNK = 128
XBC_DIM = D_SSM + 2 * SSM_GROUPS * SSM_STATE
D_CONV = D_MIX - D_SSM
CONV_WIDTH = 31
IN_COLS = D_SSM + XBC_DIM + 2 * SSM_HEADS + 2 * D_CONV
PEER_HEADS = 8
PEER_KEY_DIM = 256
N_KEYS = 128
N_EXPERTS = N_KEYS * N_KEYS
PEER_TOPK = 16
PEER_BLOCK = 128
EPS = 1e-6

kernel_name = "hymba_ssd_conformer_peer_dit_layer"


def rms_norm(h, w):
    hf = h.astype(jnp.float32)
    hf = hf * lax.rsqrt(jnp.mean(hf * hf, axis=-1, keepdims=True) + EPS)
    return (hf * w.astype(jnp.float32)).astype(h.dtype)


def layer_norm(h, w, b):
    hf = h.astype(jnp.float32)
    mu = jnp.mean(hf, axis=-1, keepdims=True)
    var = jnp.mean(jnp.square(hf - mu), axis=-1, keepdims=True)
    out = (hf - mu) * lax.rsqrt(var + EPS) * w.astype(jnp.float32) + b.astype(jnp.float32)
    return out.astype(h.dtype)


def gated_rms_norm(y, z, w):
    bsz, length, ch = y.shape
    g = (y * jax.nn.silu(z)).astype(jnp.float32).reshape(bsz, length, SSM_GROUPS, ch // SSM_GROUPS)
    g = g * lax.rsqrt(jnp.mean(g * g, axis=-1, keepdims=True) + EPS)
    return (g.reshape(bsz, length, ch) * w.astype(jnp.float32)).astype(y.dtype)


def modulate(h, shift, scale):
    return h * (1 + scale[:, None, :]) + shift[:, None, :]


def dwconv_seq(h, w, b):
    k, ch = w.shape
    pad = (k - 1) // 2
    out = lax.conv_general_dilated(h, w[:, None, :], window_strides=(1,), padding=[(pad, pad)],
                                   dimension_numbers=("NWC", "WIO", "NWC"), feature_group_count=ch)
    return out + b


def dwconv_grid_axial(h, w, b, rows):
    bsz, length, ch = h.shape
    k = w.shape[0]
    pad = (k - 1) // 2
    half = ch // 2
    g = h.reshape(bsz, rows, GRID_W, ch)
    dn = ("NHWC", "HWIO", "NHWC")
    horiz = lax.conv_general_dilated(g[..., :half], w[:, :half].reshape(1, k, 1, half), (1, 1),
                                     [(0, 0), (pad, pad)], dimension_numbers=dn,
                                     feature_group_count=half)
    vert = lax.conv_general_dilated(g[..., half:], w[:, half:].reshape(k, 1, 1, ch - half), (1, 1),
                                    [(pad, pad), (0, 0)], dimension_numbers=dn,
                                    feature_group_count=ch - half)
    return jnp.concatenate([horiz, vert], axis=-1).reshape(bsz, length, ch) + b


def segsum_exp(a):
    t = a.shape[-1]
    acum = jnp.cumsum(a, axis=-1)
    diff = acum[..., :, None] - acum[..., None, :]
    mask = jnp.tril(jnp.ones((t, t), dtype=bool))
    return jnp.where(mask, jnp.exp(jnp.where(mask, diff, 0.0)), 0.0)


def ssd(xs, dt, a, bm, cm, h0):
    bsz, length, nh, hp = xs.shape
    nc = length // SSD_CHUNK
    rep = nh // bm.shape[2]
    f32 = jnp.float32
    xdt = (xs.astype(f32) * dt[..., None]).reshape(bsz, nc, SSD_CHUNK, nh, hp)
    bh = jnp.repeat(bm.astype(f32), rep, axis=2).reshape(bsz, nc, SSD_CHUNK, nh, SSM_STATE)
    ch = jnp.repeat(cm.astype(f32), rep, axis=2).reshape(bsz, nc, SSD_CHUNK, nh, SSM_STATE)
    ac = (dt * a).reshape(bsz, nc, SSD_CHUNK, nh).transpose(0, 3, 1, 2)
    acum = jnp.cumsum(ac, axis=-1)
    scores = jnp.einsum("bclhn,bcshn->bhcls", ch, bh) * segsum_exp(ac)
    y_diag = jnp.einsum("bhcls,bcshp->bclhp", scores, xdt)
    decay_to_end = jnp.exp(acum[..., -1:] - acum)
    states = jnp.einsum("bclhn,bhcl,bclhp->bchpn", bh, decay_to_end, xdt)
    states = jnp.concatenate([h0[:, None], states], axis=1)
    chunk_decay = segsum_exp(jnp.pad(acum[..., -1], ((0, 0), (0, 0), (1, 0))))
    states = jnp.einsum("bhzc,bchpn->bzhpn", chunk_decay, states)
    y_off = jnp.einsum("bclhn,bchpn,bhcl->bclhp", ch, states[:, :-1], jnp.exp(acum))
    y = (y_diag + y_off).reshape(bsz, length, nh, hp).astype(xs.dtype)
    return y, states[:, -1]


def ssd_final_state(xs, dt, a, bm):
    rep = xs.shape[2] // bm.shape[2]
    acum = jnp.cumsum(dt * a, axis=1)
    w = jnp.exp(acum[:, -1:] - acum) * dt
    bh = jnp.repeat(bm.astype(jnp.float32), rep, axis=2)
    return jnp.einsum("blhn,blh,blhp->bhpn", bh, w, xs.astype(jnp.float32))


def split_in(p):
    return jnp.split(p, [D_SSM, D_SSM + XBC_DIM, D_SSM + XBC_DIM + 2 * SSM_HEADS], axis=-1)


def ssm_prep(xbc, dt_raw, conv_w, conv_b, dt_bias):
    bsz, length, _ = xbc.shape
    xbc = jax.nn.silu(dwconv_seq(xbc, conv_w, conv_b))
    xs, bm, cm = jnp.split(xbc, [D_SSM, D_SSM + SSM_GROUPS * SSM_STATE], axis=-1)
    dt = jax.nn.softplus((dt_raw.reshape(bsz, length, 2, SSM_HEADS) + dt_bias).astype(jnp.float32))
    return (xs.reshape(bsz, length, SSM_HEADS, SSM_HEADDIM),
            bm.reshape(bsz, length, SSM_GROUPS, SSM_STATE),
            cm.reshape(bsz, length, SSM_GROUPS, SSM_STATE),
            dt)


def conformer_branch(glu, conv_fn, conv_w, conv_b, ln_w, ln_b):
    u = glu[..., :D_CONV] * jax.nn.sigmoid(glu[..., D_CONV:])
    return jax.nn.silu(layer_norm(conv_fn(u, conv_w, conv_b), ln_w, ln_b))


def peer(h, wq, sub_keys, u_tab, v_tab):
    bsz, length, d = h.shape
    t = bsz * length
    hf = h.reshape(t, d)
    q = (hf @ wq).reshape(t, PEER_HEADS, 2, PEER_KEY_DIM // 2)
    s = jnp.einsum("thpd,hpkd->thpk", q, sub_keys).astype(jnp.float32)
    sv, si = lax.top_k(s, PEER_TOPK)
    cand = sv[:, :, 0, :, None] + sv[:, :, 1, None, :]
    best, flat = lax.top_k(cand.reshape(t, PEER_HEADS, PEER_TOPK * PEER_TOPK), PEER_TOPK)
    i1 = jnp.take_along_axis(si[:, :, 0], flat // PEER_TOPK, axis=-1)
    i2 = jnp.take_along_axis(si[:, :, 1], flat % PEER_TOPK, axis=-1)
    experts = (i1 * N_KEYS + i2).reshape(t, PEER_HEADS * PEER_TOPK)
    gates = jax.nn.softmax(best, axis=-1).reshape(t, PEER_HEADS * PEER_TOPK).astype(h.dtype)
    nb = t // PEER_BLOCK

    def block(args):
        xb, eb, gb = args
        act = jax.nn.gelu(jnp.einsum("pd,ped->pe", xb, u_tab[eb]), approximate=False)
        return jnp.einsum("pe,ped->pd", gb * act, v_tab[eb])

    out = lax.map(block, (hf.reshape(nb, PEER_BLOCK, d),
                          experts.reshape(nb, PEER_BLOCK, PEER_HEADS * PEER_TOPK),
                          gates.reshape(nb, PEER_BLOCK, PEER_HEADS * PEER_TOPK)))
    return out.reshape(bsz, length, d)


def mixer_sublayer(x, ctx, mod, mod_ctx, rows, norm_w, w_in, ssm_conv_w, ssm_conv_b, ssm_dt_bias,
                   ssm_a_log, ssm_d, ssm_norm_w, cfm_conv_w, cfm_conv_b, cfm_ln_w, cfm_ln_b, w_out,
                   update_ctx):
    a = -jnp.exp(ssm_a_log.astype(jnp.float32))
    flip = lambda t: t[:, ::-1]
    z_l, xbc_l, dt_l, glu_l = split_in(modulate(rms_norm(x, norm_w), mod[:, 0], mod[:, 1]) @ w_in)
    h_c = modulate(rms_norm(ctx, norm_w), mod_ctx[:, 0], mod_ctx[:, 1])
    if update_ctx:
        z_c, xbc_c, dt_c, glu_c = split_in(h_c @ w_in)
    else:
        xbc_c, dt_c = jnp.split(h_c @ w_in[:, D_SSM:D_SSM + XBC_DIM + 2 * SSM_HEADS], [XBC_DIM], axis=-1)
    xs_l, b_l, c_l, dts_l = ssm_prep(xbc_l, dt_l, ssm_conv_w, ssm_conv_b, ssm_dt_bias)
    xs_c, b_c, c_c, dts_c = ssm_prep(xbc_c, dt_c, ssm_conv_w, ssm_conv_b, ssm_dt_bias)

    if update_ctx:
        h0 = jnp.zeros((ctx.shape[0], SSM_HEADS, SSM_HEADDIM, SSM_STATE), jnp.float32)
        yc_f, hc_f = ssd(xs_c, dts_c[:, :, 0], a[0], b_c, c_c, h0)
        yc_b, hc_b = ssd(flip(xs_c), flip(dts_c[:, :, 1]), a[1], flip(b_c), flip(c_c), h0)
    else:
        hc_f = ssd_final_state(xs_c, dts_c[:, :, 0], a[0], b_c)
        hc_b = ssd_final_state(flip(xs_c), flip(dts_c[:, :, 1]), a[1], flip(b_c))
    y_f, _ = ssd(xs_l, dts_l[:, :, 0], a[0], b_l, c_l, hc_f)
    y_b, _ = ssd(flip(xs_l), flip(dts_l[:, :, 1]), a[1], flip(b_l), flip(c_l), hc_b)
    y_l = (y_f + flip(y_b) + ssm_d[:, None] * xs_l).reshape(x.shape[0], x.shape[1], D_SSM)
    ssm_l = gated_rms_norm(y_l, z_l, ssm_norm_w)
    cfm_l = conformer_branch(glu_l, functools.partial(dwconv_grid_axial, rows=rows),
                             cfm_conv_w, cfm_conv_b, cfm_ln_w, cfm_ln_b)
    x_out = x + mod[:, 2, None, :] * (jnp.concatenate([ssm_l, cfm_l], axis=-1) @ w_out)
    if not update_ctx:
        return x_out, ctx
    y_c = (yc_f + flip(yc_b) + ssm_d[:, None] * xs_c).reshape(ctx.shape[0], ctx.shape[1], D_SSM)
    ssm_c = gated_rms_norm(y_c, z_c, ssm_norm_w)
    cfm_c = conformer_branch(glu_c, dwconv_seq, cfm_conv_w, cfm_conv_b, cfm_ln_w, cfm_ln_b)
    ctx_out = ctx + mod_ctx[:, 2, None, :] * (jnp.concatenate([ssm_c, cfm_c], axis=-1) @ w_out)
    return x_out, ctx_out


def setup_inputs(seed: int = 0) -> dict:
    key = jax.random.key(seed)
    ks = jax.random.split(key, 26)
    D = D_MODEL

    def nrm(k, shape, scale):
        return jax.random.normal(k, shape, jnp.float32) * scale

    dt0 = jnp.exp(jax.random.uniform(ks[9], (DEPTH, 2, SSM_HEADS), jnp.float32,
                                     minval=math.log(1e-3), maxval=math.log(1e-1)))
    return {
        "x": nrm(ks[0], (BATCH, SEQ, D), 1.0),
        "c": nrm(ks[1], (BATCH, D), 1.0),
        "ctx": nrm(ks[2], (BATCH, CTX_LEN, D), 1.0),
        "c_ctx": nrm(ks[3], (D,), 1.0),
        "ada_w": nrm(ks[4], (DEPTH, D, 6 * D), 0.5 * D ** -0.5),
        "ada_b": nrm(ks[5], (DEPTH, 6 * D), 0.02),
        "norm1_w": 1.0 + nrm(ks[6], (DEPTH, D), 0.02),
        "norm2_w": 1.0 + nrm(ks[7], (DEPTH, D), 0.02),
        "w_in": nrm(ks[8], (DEPTH, D, IN_COLS), D ** -0.5),
        "ssm_conv_w": nrm(ks[10], (DEPTH, SSM_CONV, XBC_DIM), SSM_CONV ** -0.5),
        "ssm_conv_b": nrm(ks[11], (DEPTH, XBC_DIM), 0.02),
        "ssm_dt_bias": dt0 + jnp.log(-jnp.expm1(-dt0)),
        "ssm_a_log": jnp.log(jax.random.uniform(ks[12], (DEPTH, 2, SSM_HEADS), jnp.float32,
                                                 minval=1.0, maxval=16.0)),
        "ssm_d": 1.0 + nrm(ks[13], (DEPTH, SSM_HEADS), 0.1),
        "ssm_norm_w": 1.0 + nrm(ks[14], (DEPTH, D_SSM), 0.02),
        "cfm_conv_w": nrm(ks[15], (DEPTH, CONV_WIDTH, D_CONV), CONV_WIDTH ** -0.5),
        "cfm_conv_b": nrm(ks[16], (DEPTH, D_CONV), 0.02),
        "cfm_ln_w": 1.0 + nrm(ks[17], (DEPTH, D_CONV), 0.02),
        "cfm_ln_b": nrm(ks[18], (DEPTH, D_CONV), 0.02),
        "w_out": nrm(ks[19], (DEPTH, D_MIX, D), D_MIX ** -0.5),
        "peer_wq": nrm(ks[20], (DEPTH, D, PEER_HEADS * PEER_KEY_DIM), D ** -0.5),
        "peer_subkeys": nrm(ks[21], (DEPTH, PEER_HEADS, 2, N_KEYS, PEER_KEY_DIM // 2),
                            (PEER_KEY_DIM // 2) ** -0.5),
        "peer_u": nrm(ks[22], (DEPTH, N_EXPERTS, D), D ** -0.5),
        "peer_v": nrm(ks[23], (DEPTH, N_EXPERTS, D), PEER_HEADS ** -0.5),
        "final_norm_w": 1.0 + nrm(ks[24], (D,), 0.02),
    }


def reference(x, c, ctx, c_ctx, ada_w, ada_b, norm1_w, norm2_w, w_in, ssm_conv_w, ssm_conv_b,
              ssm_dt_bias, ssm_a_log, ssm_d, ssm_norm_w, cfm_conv_w, cfm_conv_b, cfm_ln_w, cfm_ln_b,
              w_out, peer_wq, peer_subkeys, peer_u, peer_v, final_norm_w):
    rows = x.shape[1] // GRID_W
    sc = jax.nn.silu(c)
    sc_ctx = jax.nn.silu(c_ctx)[None]
    for i in range(DEPTH):
        update_ctx = i < DEPTH - 1
        mod = (sc @ ada_w[i] + ada_b[i]).reshape(-1, 6, D_MODEL)
        mod_ctx = (sc_ctx @ ada_w[i] + ada_b[i]).reshape(1, 6, D_MODEL)
        x, ctx = mixer_sublayer(x, ctx, mod, mod_ctx, rows, norm1_w[i], w_in[i], ssm_conv_w[i],
                                ssm_conv_b[i], ssm_dt_bias[i], ssm_a_log[i], ssm_d[i], ssm_norm_w[i],
                                cfm_conv_w[i], cfm_conv_b[i], cfm_ln_w[i], cfm_ln_b[i], w_out[i],
                                update_ctx)
        x = x + mod[:, 5, None, :] * peer(modulate(rms_norm(x, norm2_w[i]), mod[:, 3], mod[:, 4]),
                                          peer_wq[i], peer_subkeys[i], peer_u[i], peer_v[i])
        if update_ctx:
            ctx = ctx + mod_ctx[:, 5, None, :] * peer(
                modulate(rms_norm(ctx, norm2_w[i]), mod_ctx[:, 3], mod_ctx[:, 4]),
                peer_wq[i], peer_subkeys[i], peer_u[i], peer_v[i])
    return rms_norm(x, final_norm_w)
```

```cpp
#include <hip/hip_runtime.h>
#include <cstdio>
#include <cstdint>
namespace pg8 {
#define PG8_LAS __attribute__((address_space(3)))
typedef unsigned short bf16_t;
typedef short bf16x8 __attribute__((ext_vector_type(8)));
typedef float f32x4 __attribute__((ext_vector_type(4)));
typedef unsigned u32x4 __attribute__((ext_vector_type(4)));
constexpr int BM = 256, BK = 64, HALF = 128, HTB = HALF * BK * 2  , STAGE_BYTES = 8 * HTB, NXCD = 8, WGM = 8;

__host__ __device__ __forceinline__ int lds_byte(int r, int c) { const int st = (r >> 4) * 2 + (c >> 5), rr = r & 15, cc = c & 31, ob = rr * 64 + cc * 2; return st * 1024 + (ob ^ (((ob >> 9) & 1) << 5)); }
__host__ __device__ __forceinline__ void stage_rc(int b, int& R, int& C) { const int st = b / 1024, sb = b % 1024, swz = sb ^ (((sb >> 9) & 1) << 5); R = (st >> 1) * 16 + swz / 64; C = (st & 1) * 32 + (swz % 64) / 2; }
__host__ __device__ __forceinline__ int perm32(int rho) { const int n = rho >> 4, i = rho & 15; return 8 * (i >> 2) + 4 * n + (i & 3); }

struct Unit { int pm, pn; };
struct Gemm { const bf16_t* A; const bf16_t* Bt; int M, N, K; };

struct StaticOrder {
    int nM, nN, nwg, G, c;
    __host__ __device__ void init(int M, int N, int G_, int c_) { nM = M / BM; nN = N / BM; nwg = nM * nN; G = G_; c = c_; }
    __host__ __device__ bool next(int i, Unit& u) const {
        const long L = (long)i * G + c; if (L >= nwg) return false;
        int wgid = (int)L; { const int q = nwg / NXCD, r = nwg % NXCD, xcd = wgid % NXCD, off = wgid / NXCD; wgid = (xcd < r ? xcd * (q + 1) : r * (q + 1) + (xcd - r) * q) + off; }
        const int nig = WGM * nN, gid = wgid / nig, fm = gid * WGM, gsz = (nM - fm) < WGM ? (nM - fm) : WGM;
        u.pm = fm + ((wgid % nig) % gsz); u.pn = (wgid % nig) / gsz; return true;
    }
    __device__ __forceinline__ void a_ready(const Unit&) const {}
    __device__ __forceinline__ void done(const Unit&) const {}
};

__device__ __forceinline__ unsigned cvt_pk_bf16(float lo, float hi) { unsigned r; asm volatile("v_cvt_pk_bf16_f32 %0, %1, %2" : "=v"(r) : "v"(lo), "v"(hi)); return r; }
template <class Epi, class Sched, bool ALIGN_EPI = false, bool SP2 = false>
__device__ __forceinline__ void gemm_phase(PG8_LAS unsigned char* lds, const Gemm g, const Sched& S, const Epi& E) {
    const int tid = threadIdx.x, wid = __builtin_amdgcn_readfirstlane(tid >> 6), lane = tid & 63, wr = wid >> 2, wc = wid & 3, fr = lane & 15, fq = lane >> 4;
    const int K = g.K, nt = K / BK;
    unsigned voffA[2], voffB[2];
#pragma unroll
    for (int i = 0; i < 2; ++i) { int R, C; stage_rc(tid * 16 + i * 8192, R, C); const int Rb = Epi::PERM ? ((R & ~31) + perm32(R & 31)) : R;
        voffA[i] = (unsigned)(R * K + C) * 2u; voffB[i] = (unsigned)(Rb * K + C) * 2u; }
    const size_t kstep = (size_t)(BK * 2);
    const size_t hstep = (size_t)HALF * K * 2;
    const size_t tstep = 2 * hstep;
    const unsigned ldsw = (unsigned)wid * 1024u;
    const int aoff = lds_byte(wr * 64 + fr, fq * 8), boff = lds_byte(wc * 32 + fr, fq * 8);
#define PG8_SA(b, h) (((b) * 2 + (h)) * HTB)
#define PG8_SB(b, h) ((4 + (b) * 2 + (h)) * HTB)
#define PG8_STAGE(bufoff, gbase, voff) do { _Pragma("unroll") for (int _i = 0; _i < 2; ++_i) \
        __builtin_amdgcn_global_load_lds((const unsigned*)((const char*)(gbase) + (voff)[_i]), (PG8_LAS unsigned*)(lds + (bufoff) + ldsw + _i * 8192), 16, 0, 0); } while (0)
#define PG8_LDA(dst, b, h) do { _Pragma("unroll") for (int m = 0; m < 4; ++m) _Pragma("unroll") for (int k = 0; k < 2; ++k) dst[m][k] = *(const PG8_LAS bf16x8*)(lds + PG8_SA(b, h) + aoff + m * 2048 + k * 1024); } while (0)
#define PG8_LDB(dst, b, h) do { _Pragma("unroll") for (int n = 0; n < 2; ++n) _Pragma("unroll") for (int k = 0; k < 2; ++k) dst[n][k] = *(const PG8_LAS bf16x8*)(lds + PG8_SB(b, h) + boff + n * 2048 + k * 1024); } while (0)
#define PG8_MMA(ai, bj, At, Bt) do { __builtin_amdgcn_s_setprio(1); _Pragma("unroll") for (int m = 0; m < 4; ++m) _Pragma("unroll") for (int n = 0; n < 2; ++n) _Pragma("unroll") for (int k = 0; k < 2; ++k) \
        acc[ai][bj][m][n] = __builtin_amdgcn_mfma_f32_16x16x32_bf16(Bt[n][k], At[m][k], acc[ai][bj][m][n], 0, 0, 0); __builtin_amdgcn_s_setprio(0); } while (0)
#define PG8_WAIT_V(n) asm volatile("s_waitcnt vmcnt(" #n ")" ::: "memory")
#define PG8_WAIT_L(n) asm volatile("s_waitcnt lgkmcnt(" #n ")" ::: "memory")
#define PG8_BAR __builtin_amdgcn_s_barrier()
#define PG8_SCHED __builtin_amdgcn_sched_barrier(0)
    Unit cur, nxt; int ui = 0;
    if (!S.next(0, cur)) return;
    f32x4 acc[2][2][4][2];
#pragma unroll
    for (int a = 0; a < 2; ++a)
#pragma unroll
        for (int b = 0; b < 2; ++b)
#pragma unroll
            for (int m = 0; m < 4; ++m)
#pragma unroll
                for (int n = 0; n < 2; ++n) acc[a][b][m][n] = (f32x4){0.f, 0.f, 0.f, 0.f};
    bf16x8 At[4][2], B0[2][2], B1[2][2];
    const char* cA = (const char*)g.A + (size_t)cur.pm * tstep; const char* cB = (const char*)g.Bt + (size_t)cur.pn * tstep;
    S.a_ready(cur);
    if constexpr (SP2) {
        PG8_STAGE(PG8_SB(0, 0), cB, voffB); PG8_STAGE(PG8_SB(0, 1), cB + hstep, voffB); PG8_STAGE(PG8_SA(0, 0), cA, voffA); PG8_STAGE(PG8_SA(0, 1), cA + hstep, voffA);
        if (wr == 1) PG8_BAR;
        PG8_WAIT_V(2); PG8_BAR;
        PG8_STAGE(PG8_SB(1, 0), cB + kstep, voffB); PG8_STAGE(PG8_SA(1, 0), cA + kstep, voffA); PG8_STAGE(PG8_SB(1, 1), cB + hstep + kstep, voffB);
        PG8_WAIT_V(6); PG8_BAR;
    } else {
        PG8_STAGE(PG8_SB(0, 0), cB, voffB); PG8_STAGE(PG8_SA(0, 0), cA, voffA); PG8_STAGE(PG8_SB(0, 1), cB + hstep, voffB); PG8_STAGE(PG8_SA(0, 1), cA + hstep, voffA);
        if (wr == 1) PG8_BAR;
        PG8_WAIT_V(4); PG8_BAR;
        PG8_STAGE(PG8_SB(1, 0), cB + kstep, voffB); PG8_STAGE(PG8_SA(1, 0), cA + kstep, voffA); PG8_STAGE(PG8_SB(1, 1), cB + hstep + kstep, voffB);
        PG8_WAIT_V(6); PG8_BAR;
    }
    for (;;) {
        const bool has_next = S.next(ui + 1, nxt);
        const char* nA = has_next ? (const char*)g.A + (size_t)nxt.pm * tstep : cA; const char* nB = has_next ? (const char*)g.Bt + (size_t)nxt.pn * tstep : cB;
        for (int t = 0; t < nt; t += 2) {
            const bool last = (t == nt - 2);
            const char* a1 = cA + (size_t)(t + 1) * kstep;
            const char* a2 = last ? nA : cA + (size_t)(t + 2) * kstep; const char* b2 = last ? nB : cB + (size_t)(t + 2) * kstep;
            const char* a3 = a2 + kstep; const char* b3 = b2 + kstep;
            if (last && has_next) S.a_ready(nxt);
            if constexpr (SP2) {
            PG8_LDB(B0, 0, 0); PG8_LDB(B1, 0, 1); PG8_SCHED; PG8_LDA(At, 0, 0); PG8_STAGE(PG8_SA(1, 1), a1 + hstep, voffA);
            PG8_WAIT_V(8); PG8_WAIT_L(0); PG8_BAR; PG8_MMA(0, 0, At, B0); PG8_MMA(0, 1, At, B1); PG8_BAR; PG8_SCHED;
            PG8_LDA(At, 0, 1); PG8_STAGE(PG8_SB(0, 0), b2, voffB); PG8_STAGE(PG8_SB(0, 1), b2 + hstep, voffB); PG8_STAGE(PG8_SA(0, 0), a2, voffA);
            PG8_WAIT_V(8); PG8_WAIT_L(0); PG8_BAR; PG8_MMA(1, 0, At, B0); PG8_MMA(1, 1, At, B1); PG8_BAR; PG8_SCHED;
            PG8_LDB(B0, 1, 0); PG8_LDB(B1, 1, 1); PG8_SCHED; PG8_LDA(At, 1, 0); PG8_STAGE(PG8_SA(0, 1), a2 + hstep, voffA);
            PG8_WAIT_V(8); PG8_WAIT_L(0); PG8_BAR; PG8_MMA(0, 0, At, B0); PG8_MMA(0, 1, At, B1); PG8_BAR; PG8_SCHED;
            PG8_LDA(At, 1, 1); PG8_STAGE(PG8_SB(1, 0), b3, voffB); PG8_STAGE(PG8_SB(1, 1), b3 + hstep, voffB); PG8_STAGE(PG8_SA(1, 0), a3, voffA);
            PG8_WAIT_V(8); PG8_WAIT_L(0); PG8_BAR; PG8_MMA(1, 0, At, B0); PG8_MMA(1, 1, At, B1); PG8_BAR; PG8_SCHED;
            } else {
            PG8_LDB(B0, 0, 0); PG8_SCHED; PG8_LDA(At, 0, 0); PG8_STAGE(PG8_SA(1, 1), a1 + hstep, voffA);
            PG8_WAIT_L(8); PG8_BAR; PG8_WAIT_L(0); PG8_MMA(0, 0, At, B0); PG8_BAR; PG8_SCHED;
            PG8_LDB(B1, 0, 1); PG8_STAGE(PG8_SB(0, 0), b2, voffB);
            PG8_BAR; PG8_WAIT_L(0); PG8_MMA(0, 1, At, B1); PG8_BAR;
            PG8_LDA(At, 0, 1); PG8_STAGE(PG8_SA(0, 0), a2, voffA);
            PG8_BAR; PG8_WAIT_L(0); PG8_MMA(1, 0, At, B0); PG8_BAR; PG8_SCHED;
            PG8_STAGE(PG8_SB(0, 1), b2 + hstep, voffB);
            PG8_WAIT_V(6); PG8_BAR; PG8_MMA(1, 1, At, B1); PG8_BAR;
            PG8_LDB(B0, 1, 0); PG8_SCHED; PG8_LDA(At, 1, 0); PG8_STAGE(PG8_SA(0, 1), a2 + hstep, voffA);
            PG8_WAIT_L(8); PG8_BAR; PG8_WAIT_L(0); PG8_MMA(0, 0, At, B0); PG8_BAR; PG8_SCHED;
            PG8_LDB(B1, 1, 1); PG8_STAGE(PG8_SB(1, 0), b3, voffB);
            PG8_BAR; PG8_WAIT_L(0); PG8_MMA(0, 1, At, B1); PG8_BAR;
            PG8_LDA(At, 1, 1); PG8_STAGE(PG8_SA(1, 0), a3, voffA);
            PG8_BAR; PG8_WAIT_L(0); PG8_MMA(1, 0, At, B0); PG8_BAR; PG8_SCHED;
            PG8_STAGE(PG8_SB(1, 1), b3 + hstep, voffB);
            PG8_WAIT_V(6); PG8_BAR; PG8_MMA(1, 1, At, B1); PG8_BAR;
            }
        }
        if constexpr (ALIGN_EPI) { if (wr == 0) PG8_BAR; }
        if constexpr (!Epi::AFTER_DRAIN) { E(acc, cur, wr, wc, fr, fq); S.done(cur); }
        if (!has_next) break;
#pragma unroll
        for (int a = 0; a < 2; ++a)
#pragma unroll
            for (int b = 0; b < 2; ++b)
#pragma unroll
                for (int m = 0; m < 4; ++m)
#pragma unroll
                    for (int n = 0; n < 2; ++n) acc[a][b][m][n] = (f32x4){0.f, 0.f, 0.f, 0.f};
        cur = nxt; cA = nA; cB = nB; ++ui;
        if constexpr (ALIGN_EPI) { if (wr == 1) PG8_BAR; }
    }
    PG8_WAIT_V(0);
    if constexpr (!ALIGN_EPI) { if (wr == 0) PG8_BAR; }
    PG8_BAR;
    if constexpr (Epi::AFTER_DRAIN) { E.fused(acc, cur, wr, wc, fr, fq, lds, wid, lane); S.done(cur); }
#undef PG8_SA
#undef PG8_SB
#undef PG8_STAGE
#undef PG8_LDA
#undef PG8_LDB
#undef PG8_MMA
#undef PG8_WAIT_V
#undef PG8_WAIT_L
#undef PG8_BAR
#undef PG8_SCHED
}
}
#ifndef PEER_FP8
#define PEER_FP8 1
#endif
#ifndef MK_N_LAUNCHES
#define MK_N_LAUNCHES 1
#endif
constexpr int NPHASE = 11;
constexpr int N_LAUNCHES = MK_N_LAUNCHES;

constexpr int NB = 8, SEQ = 4096, D = 1024, T = NB * SEQ, CTXL = 256, TC = NB * CTXL, MROWS = T + TC;
constexpr int NCC = 34;
constexpr int IN_COLS = 2576, DT_COL0 = 1536, GLU_COL0 = 1552;
constexpr int NEXP = 16384;
constexpr float EPS = 1e-6f;

constexpr size_t MiB = 1u << 20;
constexpr size_t WS_CTL = 0, CTL_ZERO_BYTES = 64 * 1024;
constexpr size_t WS_MODV = 1 * MiB;
constexpr size_t WS_CS = 2 * MiB;
constexpr size_t WS_DEC = 4 * MiB;
constexpr size_t WS_DT = 5 * MiB;
constexpr size_t WS_USC = 7 * MiB + 256 * 1024, WS_VSC = 7 * MiB + 512 * 1024;
constexpr size_t WS_WIN = 8 * MiB;
constexpr size_t WS_WOUT = 13 * MiB;
constexpr size_t WS_WC = 15 * MiB;
constexpr size_t WS_U = 20 * MiB, WS_V = 52 * MiB;
constexpr size_t WS_XN = 84 * MiB;
constexpr size_t WS_XBC = 152 * MiB;
constexpr size_t WS_ZS = 220 * MiB;
constexpr size_t WS_UGLU = 252 * MiB;
constexpr size_t WS_YD = 284 * MiB;
constexpr size_t WS_SLOC = 316 * MiB;
constexpr size_t WS_CONVO = 384 * MiB;
constexpr size_t WS_CCONV = 416 * MiB;
constexpr size_t WS_SC = 152 * MiB;
constexpr size_t WS_X1B = 284 * MiB;
constexpr size_t WS_EIDX = 432 * MiB;
constexpr size_t WS_GATE = 448 * MiB;
constexpr size_t WS_USA = 464 * MiB;
constexpr size_t WS_END = 480 * MiB;
constexpr int CW_BAR = 4096;

constexpr int RING_BYTES = 131072, LDSCTL_OFF = 143360, MISC_OFF = LDSCTL_OFF + 320, LDS_BYTES = 147456;

#define GAS __attribute__((address_space(1)))
#define LAS __attribute__((address_space(3)))
typedef unsigned short bf16;
typedef unsigned v4u __attribute__((ext_vector_type(4)));
typedef unsigned v2u __attribute__((ext_vector_type(2)));
typedef float f32x4 __attribute__((ext_vector_type(4)));
typedef float f32x2 __attribute__((ext_vector_type(2)));
typedef short bf16x8 __attribute__((ext_vector_type(8)));
typedef GAS unsigned gu32;
#define RLX_AGENT __ATOMIC_RELAXED, __HIP_MEMORY_SCOPE_AGENT
__device__ __forceinline__ unsigned f2bf(float f) { unsigned u = __builtin_bit_cast(unsigned, f); return (u + 0x7fffu + ((u >> 16) & 1u)) >> 16; }
typedef __bf16 bf16x2_t __attribute__((ext_vector_type(2)));
__device__ __forceinline__ unsigned pk2(float lo, float hi) { const f32x2 v = {lo, hi}; return __builtin_bit_cast(unsigned, __builtin_convertvector(v, bf16x2_t)); }
__device__ __forceinline__ float bflo(unsigned u) { return __builtin_bit_cast(float, u << 16); }
__device__ __forceinline__ float bfhi(unsigned u) { return __builtin_bit_cast(float, u & 0xffff0000u); }
template <int CTRL> __device__ __forceinline__ float dppf(float x) { return __builtin_bit_cast(float, __builtin_amdgcn_mov_dpp(__builtin_bit_cast(int, x), CTRL, 0xf, 0xf, true)); }
__device__ __forceinline__ float swapsum32(float a, float b) { auto r = __builtin_amdgcn_permlane32_swap(__builtin_bit_cast(unsigned, a), __builtin_bit_cast(unsigned, b), false, false); const unsigned r0 = r[0], r1 = r[1]; return __uint_as_float(r0) + __uint_as_float(r1); }
__device__ __forceinline__ float swapsum16(float a, float b) { auto r = __builtin_amdgcn_permlane16_swap(__builtin_bit_cast(unsigned, a), __builtin_bit_cast(unsigned, b), false, false); const unsigned r0 = r[0], r1 = r[1]; return __uint_as_float(r0) + __uint_as_float(r1); }
__device__ __forceinline__ float allsumf8(float m) { m += dppf<0xB1>(m); m += dppf<0x4E>(m); m += dppf<0x141>(m); return m; }
__device__ __forceinline__ float allsumf16(float m) { m = allsumf8(m); m += dppf<0x140>(m); return m; }
__device__ __forceinline__ float wave_sum(float v) { v = allsumf16(v); v = swapsum16(v, v); return swapsum32(v, v); }
__device__ __forceinline__ void wave_tsum16(float (&p)[16], int lane) {
#pragma unroll
    for (int k = 0; k < 8; ++k) p[k] = swapsum32(p[k], p[k + 8]);
#pragma unroll
    for (int k = 0; k < 4; ++k) p[k] = swapsum16(p[k], p[k + 4]);
    const bool up = (lane & 8) != 0;
#pragma unroll
    for (int k = 0; k < 2; ++k) { const float snd = up ? p[k] : p[k + 2]; const float keep = up ? p[k + 2] : p[k]; p[k] = keep + dppf<0x128>(snd); }
    p[0] = allsumf8(p[0]); p[1] = allsumf8(p[1]);
}
__device__ __forceinline__ float silu_f(float x) { return x * __builtin_amdgcn_rcpf(1.f + __expf(-x)); }
__device__ __forceinline__ float sigmoid_f(float x) { return __builtin_amdgcn_rcpf(1.f + __expf(-x)); }
__device__ __forceinline__ float softplus_f(float x) { return fmaxf(x, 0.f) + log1pf(__expf(-fabsf(x))); }
__device__ __forceinline__ float gelu_f(float x) { return 0.5f * x * (1.f + erff(x * 0.70710678118654752f)); }

#define XB_TMO      128
#define XB_XCNT(j)  (256  + 64 * (j))
#define XB_XSUB(j)  (1280 + 64 * (j))
#define XB_XGEN(j)  (2304 + 64 * (j))
#define XB_TOP      3328
#define XB_TOPGEN   3392
#define XCD_BAR_WORDS 3456
#define XB_SPIN_CAP (1u << 22)
__device__ __forceinline__ unsigned xb_ld(unsigned* p)              { return __hip_atomic_load(p, __ATOMIC_RELAXED, __HIP_MEMORY_SCOPE_AGENT); }
__device__ __forceinline__ unsigned xb_add(unsigned* p, unsigned v) { return __hip_atomic_fetch_add(p, v, __ATOMIC_RELAXED, __HIP_MEMORY_SCOPE_AGENT); }
__device__ __forceinline__ unsigned xb_xcc_id() { return (unsigned)__builtin_amdgcn_s_getreg((3 << 11) | 20) & 0xFu; }
#define XB_SPIN(cond, bar) do { unsigned _sp = 0; while (cond) { __builtin_amdgcn_s_sleep(1); \
    if ((++_sp & 255u) == 0u) { if (xb_ld(&(bar)[XB_TMO])) break; if (_sp > XB_SPIN_CAP) { atomicAdd(&(bar)[XB_TMO], 1u); break; } } } } while (0)

struct XcdBarrier {
    unsigned* bar; unsigned x;
    volatile LAS unsigned* st;
};

__device__ __forceinline__ XcdBarrier xcd_barrier_post(unsigned* bar, volatile LAS unsigned* st) {
    XcdBarrier b; b.bar = bar; b.x = xb_xcc_id(); b.st = st;
    if (threadIdx.x == 0) (void)xb_add(&bar[XB_XCNT(b.x)], 1u);
    return b;
}
__device__ __forceinline__ void xcd_barrier_complete(unsigned* bar, unsigned x, unsigned& nloc, unsigned& nx) {
    const unsigned G = gridDim.x * gridDim.y * gridDim.z;
    unsigned sum, cnt, mine, sp = 0u;
    for (;;) {
        sum = 0u; cnt = 0u; mine = 0u;
#pragma unroll
        for (unsigned j = 0; j < 16; ++j) { const unsigned c = xb_ld(&bar[XB_XCNT(j)]); sum += c; cnt += (c > 0u) ? 1u : 0u; mine = (j == x) ? c : mine; }
        if (sum == G) break;
        __builtin_amdgcn_s_sleep(1);
        if ((++sp & 255u) == 0u) { if (xb_ld(&bar[XB_TMO])) break; if (sp > XB_SPIN_CAP) { atomicAdd(&bar[XB_TMO], 1u); break; } }
    }
    nloc = mine > 0u ? mine : 1u; nx = cnt > 0u ? cnt : 1u;
}

__device__ __forceinline__ void xcd_barrier(const XcdBarrier& b) {
    asm volatile("s_waitcnt vmcnt(0)" ::: "memory");
    __syncthreads();
    if (threadIdx.x == 0) {
        unsigned* bar = b.bar;
        __builtin_amdgcn_s_waitcnt(0);
        unsigned nloc = b.st[0], nx = b.st[1];
        if (nloc == 0u) { xcd_barrier_complete(bar, b.x, nloc, nx); b.st[0] = nloc; b.st[1] = nx; }
        const unsigned old = xb_add(&bar[XB_XSUB(b.x)], 1u);
        const unsigned gen = old / nloc;
        if (old + 1u == (gen + 1u) * nloc) {
            __builtin_amdgcn_fence(__ATOMIC_RELEASE, "agent");
            asm volatile("s_waitcnt vmcnt(0)" ::: "memory");
            const unsigned og = xb_add(&bar[XB_TOP], 1u);
            const unsigned tg = og / nx;
            if (og + 1u == (tg + 1u) * nx) xb_add(&bar[XB_TOPGEN], 1u);
            else XB_SPIN(xb_ld(&bar[XB_TOPGEN]) == tg, bar);
            __builtin_amdgcn_fence(__ATOMIC_ACQUIRE, "agent");
            xb_add(&bar[XB_XGEN(b.x)], 1u);
            asm volatile("s_waitcnt vmcnt(0)" ::: "memory");
        } else {
            XB_SPIN(xb_ld(&bar[XB_XGEN(b.x)]) == gen, bar);
            __builtin_amdgcn_fence(__ATOMIC_ACQUIRE, "agent");
            asm volatile("s_waitcnt vmcnt(0)" ::: "memory");
        }
    }
    __syncthreads();
}
struct EpiInProj {
    static constexpr bool PERM = true, AFTER_DRAIN = false;
    bf16* ZS; bf16* XBC; bf16* UG;
    __device__ __forceinline__ void operator()(const pg8::f32x4 (&acc)[2][2][4][2], const pg8::Unit& u, int wr, int wc, int fr, int fq) const {
        const int row0 = u.pm * 256 + wr * 64 + fr, cl0 = wc * 32 + 8 * fq;
        if (u.pn < 2) {
#pragma unroll
            for (int ai = 0; ai < 2; ++ai)
#pragma unroll
                for (int m = 0; m < 4; ++m) { bf16* rowp = ZS + (size_t)(row0 + ai * 128 + m * 16) * 512 + u.pn * 256 + cl0;
#pragma unroll
                    for (int bj = 0; bj < 2; ++bj) { const pg8::f32x4 a = acc[ai][bj][m][0], b = acc[ai][bj][m][1]; v4u w;
                        w.x = pk2(silu_f(a[0]), silu_f(a[1])); w.y = pk2(silu_f(a[2]), silu_f(a[3])); w.z = pk2(silu_f(b[0]), silu_f(b[1])); w.w = pk2(silu_f(b[2]), silu_f(b[3]));
                        *(v4u*)(rowp + bj * 128) = w; } }
        } else if (u.pn < 6) {
#pragma unroll
            for (int ai = 0; ai < 2; ++ai)
#pragma unroll
                for (int m = 0; m < 4; ++m) { bf16* rowp = XBC + (size_t)(row0 + ai * 128 + m * 16) * 1024 + (u.pn - 2) * 256 + cl0;
#pragma unroll
                    for (int bj = 0; bj < 2; ++bj) { const pg8::f32x4 a = acc[ai][bj][m][0], b = acc[ai][bj][m][1]; v4u w;
                        w.x = pk2(a[0], a[1]); w.y = pk2(a[2], a[3]); w.z = pk2(b[0], b[1]); w.w = pk2(b[2], b[3]);
                        *(v4u*)(rowp + bj * 128) = w; } }
        } else {
            const int ch0 = 128 * (u.pn - 6) + 16 * wc + 4 * fq;
#pragma unroll
            for (int ai = 0; ai < 2; ++ai)
#pragma unroll
                for (int m = 0; m < 4; ++m) { bf16* rowp = UG + (size_t)(row0 + ai * 128 + m * 16) * 512 + ch0;
#pragma unroll
                    for (int bj = 0; bj < 2; ++bj) { const pg8::f32x4 a = acc[ai][bj][m][0], g = acc[ai][bj][m][1]; v2u w;
                        w.x = pk2(a[0] * sigmoid_f(g[0]), a[1] * sigmoid_f(g[1])); w.y = pk2(a[2] * sigmoid_f(g[2]), a[3] * sigmoid_f(g[3]));
                        *(v2u*)(rowp + bj * 64) = w; } }
        }
    }
};
struct EpiOutProj {
    static constexpr bool PERM = true, AFTER_DRAIN = false;
    const float* X; bf16* X1; float* MODV;
    __device__ __forceinline__ void operator()(const pg8::f32x4 (&acc)[2][2][4][2], const pg8::Unit& u, int wr, int wc, int fr, int fq) const {
        const int row0 = u.pm * 256 + wr * 64 + fr, col0 = u.pn * 256 + wc * 32 + 8 * fq;
        const float* gp = MODV + (size_t)(row0 >> 12) * 6144 + 2 * 1024 + col0;
        pg8::f32x4 g[2][2];
#pragma unroll
        for (int bj = 0; bj < 2; ++bj) { g[bj][0] = *(const pg8::f32x4*)(gp + bj * 128); g[bj][1] = *(const pg8::f32x4*)(gp + bj * 128 + 4); }
#pragma unroll
        for (int ai = 0; ai < 2; ++ai) {
            pg8::f32x4 xv[4][2][2];
#pragma unroll
            for (int m = 0; m < 4; ++m) { const size_t o = (size_t)(row0 + ai * 128 + m * 16) * 1024 + col0;
#pragma unroll
                for (int bj = 0; bj < 2; ++bj) { xv[m][bj][0] = *(const pg8::f32x4*)(X + o + bj * 128); xv[m][bj][1] = *(const pg8::f32x4*)(X + o + bj * 128 + 4); } }
#pragma unroll
            for (int m = 0; m < 4; ++m) { const size_t o = (size_t)(row0 + ai * 128 + m * 16) * 1024 + col0;
#pragma unroll
                for (int bj = 0; bj < 2; ++bj) {
                    const pg8::f32x4 y0 = xv[m][bj][0] + g[bj][0] * acc[ai][bj][m][0], y1 = xv[m][bj][1] + g[bj][1] * acc[ai][bj][m][1];
                    v4u w; w.x = pk2(y0[0], y0[1]); w.y = pk2(y0[2], y0[3]); w.z = pk2(y1[0], y1[1]); w.w = pk2(y1[2], y1[3]);
                    *(v4u*)(X1 + o + bj * 128) = w; } } }
    }
};
struct EpiScore {
    static constexpr bool PERM = true, AFTER_DRAIN = false;
    _Float16* SC;
    __device__ __forceinline__ void operator()(const pg8::f32x4 (&acc)[2][2][4][2], const pg8::Unit& u, int wr, int wc, int fr, int fq) const {
        const int row0 = u.pm * 256 + wr * 64 + fr, col0 = u.pn * 256 + wc * 32 + 8 * fq;
        typedef _Float16 h8 __attribute__((ext_vector_type(8)));
#pragma unroll
        for (int ai = 0; ai < 2; ++ai)
#pragma unroll
            for (int m = 0; m < 4; ++m) { _Float16* rp = SC + (size_t)(row0 + ai * 128 + m * 16) * T + col0;
#pragma unroll
                for (int bj = 0; bj < 2; ++bj) { const pg8::f32x4 a = acc[ai][bj][m][0], b = acc[ai][bj][m][1];
                    h8 o = {(_Float16)a[0], (_Float16)a[1], (_Float16)a[2], (_Float16)a[3], (_Float16)b[0], (_Float16)b[1], (_Float16)b[2], (_Float16)b[3]};
                    *(h8*)(rp + bj * 128) = o; } }
    }
};
struct InProjOrder {
    pg8::StaticOrder S; int G, c;
    __device__ void init(int G_, int c_) { S.init(T, 2560, G_, c_); G = G_; c = c_; }
    __device__ bool next(int i, pg8::Unit& u) const {
        const long L = (long)i * G + c;
        if (L < 1280) return S.next(i, u);
        if (L >= 1312) return false;
        const int l2 = (int)L - 1280; u.pm = 128 + (l2 >> 2); u.pn = 2 + (l2 & 3); return true;
    }
    __device__ __forceinline__ void a_ready(const pg8::Unit&) const {}
    __device__ __forceinline__ void done(const pg8::Unit&) const {}
};
struct Args { const float* in[25]; float* out; unsigned char* ws; int ph_lo, ph_hi, li, pad; };
enum { I_X = 0, I_C, I_CTX, I_CCTX, I_ADAW, I_ADAB, I_N1W, I_N2W, I_WIN, I_SCW, I_SCB, I_DTB, I_ALOG, I_SSD, I_SNW, I_CCW, I_CCB, I_CLW, I_CLB, I_WOUT, I_WQ, I_SK, I_PU, I_PV, I_FNW };

__device__ __forceinline__ void p0_mod(const Args& A, LAS unsigned char* lds, int tid) {
    LAS float* s = (LAS float*)lds;
    LAS float* red = (LAS float*)(lds + 36864);
    const float* c = A.in[I_C]; const float* cctx = A.in[I_CCTX]; const float* adaw = A.in[I_ADAW]; const float* adab = A.in[I_ADAB];
    float* MODV = (float*)(A.ws + WS_MODV);
    for (int item = blockIdx.x; item < 192; item += gridDim.x) {
        for (int i = tid; i < 9 * 1024; i += 512) { const int b = i >> 10, k = i & 1023; const float v = (b < 8) ? c[b * 1024 + k] : cctx[k]; s[i] = silu_f(v); }
        __syncthreads();
        const int chunk = tid & 7, rg = tid >> 3, col = item * 32 + chunk * 4;
        f32x4 acc[9];
#pragma unroll
        for (int b = 0; b < 9; ++b) acc[b] = (f32x4){0.f, 0.f, 0.f, 0.f};
#pragma unroll 4
        for (int i = 0; i < 16; ++i) { const int r = rg + 64 * i; const f32x4 w = *(const f32x4*)(adaw + (size_t)r * 6144 + col);
#pragma unroll
            for (int b = 0; b < 9; ++b) acc[b] += w * s[b * 1024 + r]; }
#pragma unroll
        for (int b = 0; b < 9; ++b) *(LAS f32x4*)(red + (rg * 9 + b) * 32 + chunk * 4) = acc[b];
        __syncthreads();
        if (tid < 288) { const int b = tid >> 5, cc = tid & 31; float sum = 0.f;
            for (int r2 = 0; r2 < 64; ++r2) sum += red[(r2 * 9 + b) * 32 + cc];
            MODV[b * 6144 + item * 32 + cc] = sum + adab[item * 32 + cc]; }
        __syncthreads();
    }
}
__device__ __forceinline__ int win_dest(int n) {
    if (n < 1536) return n;
    int ch = n - GLU_COL0;
    if (ch < 512) return 1536 + 8 * (ch >> 2) + (ch & 3);
    ch -= 512; return 1536 + 8 * (ch >> 2) + 4 + (ch & 3);
}
template <int MODE>
__device__ __forceinline__ void transpose_item(const float* W, int ldw, int k0, int n0, bf16* WT, LAS float* scr, int lane) {
#pragma unroll 8
    for (int i = 0; i < 32; ++i) { const int kk = 2 * i + (lane >> 5); scr[kk * 33 + (lane & 31)] = W[(size_t)(k0 + kk) * ldw + n0 + (lane & 31)]; }
    asm volatile("s_waitcnt lgkmcnt(0)" ::: "memory");
    const int c = lane & 7;
#pragma unroll
    for (int j = 0; j < 4; ++j) { const int n = (lane >> 3) + 8 * j; const LAS float* sp = scr + (8 * c) * 33 + n;
        v4u o; o.x = pk2(sp[0 * 33], sp[1 * 33]); o.y = pk2(sp[2 * 33], sp[3 * 33]); o.z = pk2(sp[4 * 33], sp[5 * 33]); o.w = pk2(sp[6 * 33], sp[7 * 33]);
        const int row = (MODE == 1) ? win_dest(n0 + n) : (n0 + n);
        *(v4u*)(WT + (size_t)row * 1024 + k0 + 8 * c) = o; }
    asm volatile("s_waitcnt lgkmcnt(0)" ::: "memory");
}
__device__ __forceinline__ void p0_weights(const Args& A, LAS unsigned char* lds, int tid, int wave, int lane) {
    LAS float* scr = (LAS float*)(lds + wave * 16384);
    const int gw = blockIdx.x * 8 + wave, NGW = gridDim.x * 8;
    bf16* WIN = (bf16*)(A.ws + WS_WIN); bf16* WOUT = (bf16*)(A.ws + WS_WOUT);
    for (int it = gw; it < 80 * 16 + 32 * 16; it += NGW) {
        if (it < 80 * 16) { const int nb = it >> 4, kb = it & 15; const int n0 = nb < 48 ? 32 * nb : GLU_COL0 + 32 * (nb - 48);
            transpose_item<1>(A.in[I_WIN], IN_COLS, 64 * kb, n0, WIN, scr, lane); }
        else { const int r = it - 80 * 16; transpose_item<0>(A.in[I_WOUT], 1024, 64 * (r & 15), 32 * (r >> 4), WOUT, scr, lane); }
    }
    const float* pu = A.in[I_PU]; const float* pv = A.in[I_PV];
#if PEER_FP8
    for (int row = gw; row < 2 * NEXP; row += NGW) {
        const int r = row & (NEXP - 1); const bool isv = row >= NEXP;
        const float* src = (isv ? pv : pu) + (size_t)r * 1024 + 4 * lane;
        f32x4 v[4]; float am = 0.f;
#pragma unroll
        for (int j = 0; j < 4; ++j) { v[j] = *(const f32x4*)(src + 256 * j); am = fmaxf(am, fmaxf(fmaxf(fabsf(v[j][0]), fabsf(v[j][1])), fmaxf(fabsf(v[j][2]), fabsf(v[j][3])))); }
#pragma unroll
        for (int o = 1; o < 64; o <<= 1) am = fmaxf(am, __shfl_xor(am, o));
        const float inv = am > 0.f ? 440.f / am : 0.f;
        unsigned char* dst = A.ws + (isv ? WS_V : WS_U) + (size_t)r * 1024 + 4 * lane;
        if (isv) {
#pragma unroll
            for (int j = 0; j < 4; ++j) { int w = __builtin_amdgcn_cvt_pk_fp8_f32(v[j][0] * inv, v[j][1] * inv, 0, false); w = __builtin_amdgcn_cvt_pk_fp8_f32(v[j][2] * inv, v[j][3] * inv, w, true);
                *(unsigned*)(dst + 256 * j) = (unsigned)w; }
            if (lane == 0) ((float*)(A.ws + WS_VSC))[r] = am * (1.f / 440.f);
        } else {
            const float inv8 = am > 0.f ? 127.f / am : 0.f;
#pragma unroll
            for (int j = 0; j < 4; ++j) { const unsigned w = ((unsigned)__float2int_rn(v[j][0] * inv8) & 255u) | (((unsigned)__float2int_rn(v[j][1] * inv8) & 255u) << 8)
                                                        | (((unsigned)__float2int_rn(v[j][2] * inv8) & 255u) << 16) | (((unsigned)__float2int_rn(v[j][3] * inv8) & 255u) << 24);
                *(unsigned*)(dst + 256 * j) = w; }
            if (lane == 0) ((float*)(A.ws + WS_USC))[r] = am * (1.f / 127.f);
        }
    }
#else
    bf16* U = (bf16*)(A.ws + WS_U); bf16* V = (bf16*)(A.ws + WS_V);
    const size_t nthr = (size_t)gridDim.x * 512, gt = (size_t)blockIdx.x * 512 + tid;
    for (size_t i = gt; i < (size_t)NEXP * 1024 / 8; i += nthr) {
        const f32x4 a = *(const f32x4*)(pu + i * 8), b = *(const f32x4*)(pu + i * 8 + 4);
        v4u o; o.x = pk2(a[0], a[1]); o.y = pk2(a[2], a[3]); o.z = pk2(b[0], b[1]); o.w = pk2(b[2], b[3]); *(v4u*)(U + i * 8) = o;
        const f32x4 c2 = *(const f32x4*)(pv + i * 8), d2 = *(const f32x4*)(pv + i * 8 + 4);
        v4u q; q.x = pk2(c2[0], c2[1]); q.y = pk2(c2[2], c2[3]); q.z = pk2(d2[0], d2[1]); q.w = pk2(d2[2], d2[3]); *(v4u*)(V + i * 8) = q;
    }
#endif
}
__device__ __forceinline__ void p0_wc(const Args& A, LAS unsigned char* lds, int tid) {
    LAS float* wqs = (LAS float*)lds;
    LAS float* sks = (LAS float*)(lds + 32768);
    const float* wq = A.in[I_WQ]; const float* sk = A.in[I_SK]; bf16* WC = (bf16*)(A.ws + WS_WC);
    for (int item = blockIdx.x; item < 256; item += gridDim.x) {
        const int hp = item >> 4, k0 = (item & 15) * 64;
        __syncthreads();
        for (int i = tid; i < 64 * 32; i += 512) { const int kk = i >> 5, d4 = i & 31; *(LAS f32x4*)(wqs + kk * 128 + 4 * d4) = *(const f32x4*)(wq + (size_t)(k0 + kk) * 2048 + hp * 128 + 4 * d4); }
        for (int i = tid; i < 128 * 32; i += 512) { const int j = i >> 5, d4 = i & 31; *(LAS f32x4*)(sks + j * 132 + 4 * d4) = *(const f32x4*)(sk + (size_t)(hp * 128 + j) * 128 + 4 * d4); }
        __syncthreads();
        const int j = tid & 127, kq = tid >> 7;
        float acc[16];
#pragma unroll
        for (int i = 0; i < 16; ++i) acc[i] = 0.f;
        for (int d4 = 0; d4 < 32; ++d4) { const f32x4 sv = *(LAS f32x4*)(sks + j * 132 + 4 * d4);
#pragma unroll
            for (int i = 0; i < 16; ++i) { const f32x4 wv = *(LAS f32x4*)(wqs + (kq * 16 + i) * 128 + 4 * d4); acc[i] += sv[0] * wv[0] + sv[1] * wv[1] + sv[2] * wv[2] + sv[3] * wv[3]; } }
        v4u o0, o1; o0.x = pk2(acc[0], acc[1]); o0.y = pk2(acc[2], acc[3]); o0.z = pk2(acc[4], acc[5]); o0.w = pk2(acc[6], acc[7]);
        o1.x = pk2(acc[8], acc[9]); o1.y = pk2(acc[10], acc[11]); o1.z = pk2(acc[12], acc[13]); o1.w = pk2(acc[14], acc[15]);
        bf16* dst = WC + (size_t)(hp * 128 + j) * 1024 + k0 + kq * 16;
        *(v4u*)dst = o0; *(v4u*)(dst + 8) = o1;
    }
}

__device__ __forceinline__ void p1_norm(const Args& A, LAS unsigned char* lds, int tid, int wave, int lane, int wg0) {
    LAS float* wdt = (LAS float*)lds;
    const float* win = A.in[I_WIN];
    for (int i = tid; i < 16384; i += 512) { const int k = i >> 4, c = i & 15; wdt[c * 1024 + k] = win[(size_t)k * IN_COLS + DT_COL0 + c]; }
    __syncthreads();
    const float* x = A.in[I_X]; const float* ctx = A.in[I_CTX]; const float* n1w = A.in[I_N1W]; const float* dtb = A.in[I_DTB];
    float* MODV = (float*)(A.ws + WS_MODV); bf16* XN = (bf16*)(A.ws + WS_XN); float* DT = (float*)(A.ws + WS_DT);
    const int gw = ((int)blockIdx.x - wg0) * 8 + wave, NGW = ((int)gridDim.x - wg0) * 8;
    f32x4 nx[4];
    if (gw < MROWS) { const float* xr = gw < T ? x + (size_t)gw * 1024 : ctx + (size_t)(gw - T) * 1024;
#pragma unroll
        for (int j = 0; j < 4; ++j) nx[j] = *(const f32x4*)(xr + 4 * lane + 256 * j); }
    const int myc = 8 * ((lane >> 5) & 1) + 4 * ((lane >> 4) & 1) + 2 * ((lane >> 3) & 1) + (lane & 1);
    const float mybias = dtb[myc];
    for (int row = gw; row < MROWS; row += NGW) {
        const float* mp = MODV + (size_t)(row < T ? (row >> 12) : 8) * 6144;
        f32x4 v[4]; float ss = 0.f;
#pragma unroll
        for (int j = 0; j < 4; ++j) { v[j] = nx[j]; ss += v[j][0] * v[j][0] + v[j][1] * v[j][1] + v[j][2] * v[j][2] + v[j][3] * v[j][3]; }
        { const int rn = row + NGW < MROWS ? row + NGW : row;
          const float* xr = rn < T ? x + (size_t)rn * 1024 : ctx + (size_t)(rn - T) * 1024;
#pragma unroll
          for (int j = 0; j < 4; ++j) nx[j] = *(const f32x4*)(xr + 4 * lane + 256 * j); }
        const float rstd = rsqrtf(wave_sum(ss) * (1.f / 1024.f) + EPS);
#pragma unroll
        for (int j = 0; j < 4; ++j) { const int col = 4 * lane + 256 * j;
            const f32x4 nw = *(const f32x4*)(n1w + col), sh = *(const f32x4*)(mp + col), sc = *(const f32x4*)(mp + 1024 + col);
            v[j] = v[j] * rstd * nw * (sc + 1.f) + sh;
            v2u o; o.x = pk2(v[j][0], v[j][1]); o.y = pk2(v[j][2], v[j][3]); *(v2u*)(XN + (size_t)row * 1024 + col) = o; }
        float p[16];
#pragma unroll
        for (int c = 0; c < 16; ++c) { float q = 0.f;
            if ((c & 3) == 0) asm volatile("" ::: "memory");
#pragma unroll
            for (int j = 0; j < 4; ++j) { const f32x4 w4 = *(LAS f32x4*)(wdt + c * 1024 + 4 * lane + 256 * j); q += v[j][0] * w4[0] + v[j][1] * w4[1] + v[j][2] * w4[2] + v[j][3] * w4[3]; }
            p[c] = q; }
        wave_tsum16(p, lane);
        if ((lane & 6) == 0) DT[(size_t)row * 16 + myc] = softplus_f(((lane & 1) ? p[1] : p[0]) + mybias);
    }
}
constexpr int LROW = 272;
constexpr int XT_OFF = 0, BM_OFF = 17408, BT_OFF = 52224, CM_OFF = 87040, SCAL_OFF = 121856;
__device__ __forceinline__ float bfe(const v4u& v, int i) { const unsigned w = v[i >> 1]; return (i & 1) ? bfhi(w) : bflo(w); }
__device__ __forceinline__ pg8::f32x4 mfma16(const v4u& a, const v4u& b, const pg8::f32x4& c) {
    return __builtin_amdgcn_mfma_f32_16x16x32_bf16(__builtin_bit_cast(bf16x8, a), __builtin_bit_cast(bf16x8, b), c, 0, 0, 0); }

__device__ __forceinline__ void ssd_stage_kind(const Args& A, LAS unsigned char* lds, int kind, int h, int g, size_t row0, int t0, int L, int tid) {
    if (kind == 0 && tid >= 256) return;
    const bf16* XBC = (const bf16*)(A.ws + WS_XBC);
    const int pair = kind == 0 ? (tid & 31) : (tid & 63), sg = kind == 0 ? (tid >> 5) : (tid >> 6);
    const int nl = 2 * pair;
    const int gch = (kind == 0 ? 64 * h : (kind == 1 ? 512 + 128 * g : 768 + 128 * g)) + nl;
    const float* scw = A.in[I_SCW] + gch; const float* scb = A.in[I_SCB] + gch;
    float w0[5], w1[5];
#pragma unroll
    for (int k = 0; k < 5; ++k) { w0[k] = scw[k * 1024]; w1[k] = scw[k * 1024 + 1]; }
    const float b0 = scb[0], b1 = scb[1];
    float lo[20], hi[20];
#pragma unroll
    for (int i = 0; i < 20; ++i) { const int tl = t0 + 16 * sg - 2 + i;
        const unsigned raw = (tl >= 0 && tl < L) ? *(const unsigned*)(XBC + (row0 + tl) * 1024 + gch) : 0u;
        lo[i] = bflo(raw); hi[i] = bfhi(raw); }
    float s0[16], s1[16];
#pragma unroll
    for (int o = 0; o < 16; ++o) { float a0 = b0, a1 = b1;
#pragma unroll
        for (int k = 0; k < 5; ++k) { a0 += w0[k] * lo[o + k]; a1 += w1[k] * hi[o + k]; }
        s0[o] = silu_f(a0); s1[o] = silu_f(a1); }
    if (kind != 2) {
        LAS unsigned char* base = lds + (kind == 0 ? XT_OFF : BT_OFF) + nl * LROW + 32 * sg;
        v4u a, bb, c2, d2;
        a.x = pk2(s0[0], s0[1]); a.y = pk2(s0[2], s0[3]); a.z = pk2(s0[4], s0[5]); a.w = pk2(s0[6], s0[7]);
        bb.x = pk2(s0[8], s0[9]); bb.y = pk2(s0[10], s0[11]); bb.z = pk2(s0[12], s0[13]); bb.w = pk2(s0[14], s0[15]);
        c2.x = pk2(s1[0], s1[1]); c2.y = pk2(s1[2], s1[3]); c2.z = pk2(s1[4], s1[5]); c2.w = pk2(s1[6], s1[7]);
        d2.x = pk2(s1[8], s1[9]); d2.y = pk2(s1[10], s1[11]); d2.z = pk2(s1[12], s1[13]); d2.w = pk2(s1[14], s1[15]);
        *(LAS v4u*)base = a; *(LAS v4u*)(base + 16) = bb; *(LAS v4u*)(base + LROW) = c2; *(LAS v4u*)(base + LROW + 16) = d2;
    }
    if (kind != 0) {
        LAS unsigned char* base = lds + (kind == 1 ? BM_OFF : CM_OFF) + (16 * sg) * LROW + nl * 2;
#pragma unroll
        for (int o = 0; o < 16; ++o) *(LAS unsigned*)(base + o * LROW) = pk2(s0[o], s1[o]);
    }
}

__device__ __forceinline__ void ssd_stage_x(const Args& A, LAS unsigned char* lds, int h, size_t row0, int t0, int L, int tid) {
    const bf16* XBC = (const bf16*)(A.ws + WS_XBC);
    const int pair = tid & 31, sg = tid >> 5, nl = 2 * pair, gch = 64 * h + nl;
    const float* scw = A.in[I_SCW] + gch; const float* scb = A.in[I_SCB] + gch;
    float w0[5], w1[5];
#pragma unroll
    for (int k = 0; k < 5; ++k) { w0[k] = scw[k * 1024]; w1[k] = scw[k * 1024 + 1]; }
    const float b0 = scb[0], b1 = scb[1];
    float lo[12], hi[12];
#pragma unroll
    for (int i = 0; i < 12; ++i) { const int tl = t0 + 8 * sg - 2 + i;
        const unsigned raw = (tl >= 0 && tl < L) ? *(const unsigned*)(XBC + (row0 + tl) * 1024 + gch) : 0u;
        lo[i] = bflo(raw); hi[i] = bfhi(raw); }
    float s0[8], s1[8];
#pragma unroll
    for (int o = 0; o < 8; ++o) { float a0 = b0, a1 = b1;
#pragma unroll
        for (int k = 0; k < 5; ++k) { a0 += w0[k] * lo[o + k]; a1 += w1[k] * hi[o + k]; }
        s0[o] = silu_f(a0); s1[o] = silu_f(a1); }
    LAS unsigned char* base = lds + XT_OFF + nl * LROW + 16 * sg;
    v4u a, c2;
    a.x = pk2(s0[0], s0[1]); a.y = pk2(s0[2], s0[3]); a.z = pk2(s0[4], s0[5]); a.w = pk2(s0[6], s0[7]);
    c2.x = pk2(s1[0], s1[1]); c2.y = pk2(s1[2], s1[3]); c2.z = pk2(s1[4], s1[5]); c2.w = pk2(s1[6], s1[7]);
    *(LAS v4u*)base = a; *(LAS v4u*)(base + LROW) = c2;
}

__device__ __forceinline__ void ssd_local_item(const Args& A, LAS unsigned char* lds, int item, int tid, int wave, int lane) {
    int b, cc, g;
    if (item < NB * 32 * 2) { b = item >> 6; cc = 2 + ((item >> 1) & 31); g = item & 1; }
    else { const int j = item - NB * 32 * 2; b = j >> 2; cc = (j >> 1) & 1; g = j & 1; }
    const bool is_ctx = cc < 2; const int L = is_ctx ? CTXL : SEQ, c = is_ctx ? cc : cc - 2;
    const size_t row0 = is_ctx ? (size_t)T + (size_t)b * CTXL : (size_t)b * SEQ; const int t0 = c * 128;
    float* DT = (float*)(A.ws + WS_DT);
    LAS float* csf = (LAS float*)(lds + SCAL_OFF); LAS float* csb = csf + 128; LAS float* dtf = csf + 256; LAS float* dtb = csf + 384;
    const int fr = lane & 15, fq = lane >> 4;
    __syncthreads();
    ssd_stage_kind(A, lds, 1, 0, g, row0, t0, L, tid);
    if (!is_ctx) ssd_stage_kind(A, lds, 2, 0, g, row0, t0, L, tid);
    __syncthreads();
    if (!is_ctx) {
        v4u cf[4];
#pragma unroll
        for (int ks = 0; ks < 4; ++ks) cf[ks] = *(const LAS v4u*)(lds + CM_OFF + (16 * wave + fr) * LROW + (32 * ks + 8 * fq) * 2);
        pg8::f32x4 acc[8];
#pragma unroll
        for (int j = 0; j < 8; ++j) { acc[j] = (pg8::f32x4){0.f, 0.f, 0.f, 0.f};
#pragma unroll
            for (int ks = 0; ks < 4; ++ks) { const v4u bfv = *(const LAS v4u*)(lds + BM_OFF + (16 * j + fr) * LROW + (32 * ks + 8 * fq) * 2); acc[j] = mfma16(bfv, cf[ks], acc[j]); } }
        __syncthreads();
#pragma unroll
        for (int j = 0; j < 8; ++j) { v2u w; w.x = pk2(acc[j][0], acc[j][1]); w.y = pk2(acc[j][2], acc[j][3]);
            *(LAS v2u*)(lds + BM_OFF + (16 * wave + fr) * LROW + (16 * j + 4 * fq) * 2) = w; }
        bf16* CC = (bf16*)(A.ws + WS_CCONV);
        for (int i = tid; i < 128 * 16; i += 512) { const int r = i >> 4, c8 = i & 15;
            *(v4u*)(CC + (row0 + t0 + r) * 256 + g * 128 + c8 * 8) = *(const LAS v4u*)(lds + CM_OFF + r * LROW + c8 * 16); }
    }
#pragma unroll 1
    for (int hl = 0; hl < 4; ++hl) {
        const int h = 4 * g + hl;
        __syncthreads();
        if (wave == 5) {
            const float Af = -__expf(A.in[I_ALOG][h]);
            const float* dtp = DT + (row0 + t0) * 16 + h;
            const float d0 = dtp[(2 * lane) * 16], d1 = dtp[(2 * lane + 1) * 16];
            const float a0 = d0 * Af, x = a0 + d1 * Af; float incl = x;
#pragma unroll
            for (int o = 1; o < 64; o <<= 1) { const float v = __shfl_up(incl, o); if (lane >= o) incl += v; }
            const float excl = incl - x;
            csf[2 * lane] = excl + a0; csf[2 * lane + 1] = incl; dtf[2 * lane] = d0; dtf[2 * lane + 1] = d1;
            if (lane == 63) ((float*)(A.ws + WS_DEC))[((size_t)(b * NCC + cc) * 8 + h) * 2 + 0] = __expf(incl);
            if (!is_ctx) { float* CS = (float*)(A.ws + WS_CS) + (((size_t)(b * 32 + c) * 8 + h) * 2 + 0) * 128; CS[2 * lane] = excl + a0; CS[2 * lane + 1] = incl; }
        } else if (wave == 6) {
            const float Ab = -__expf(A.in[I_ALOG][8 + h]);
            const float* dtp = DT + (row0 + t0) * 16 + 8 + h;
            const float d0 = dtp[(2 * lane) * 16], d1 = dtp[(2 * lane + 1) * 16];
            const float a1 = d1 * Ab, x = d0 * Ab + a1; float incl = x;
#pragma unroll
            for (int o = 1; o < 64; o <<= 1) { const float v = __shfl_down(incl, o); if (lane + o < 64) incl += v; }
            const float excl = incl - x;
            csb[2 * lane + 1] = excl + a1; csb[2 * lane] = incl; dtb[2 * lane] = d0; dtb[2 * lane + 1] = d1;
            if (lane == 0) ((float*)(A.ws + WS_DEC))[((size_t)(b * NCC + cc) * 8 + h) * 2 + 1] = __expf(incl);
            if (!is_ctx) { float* CS = (float*)(A.ws + WS_CS) + (((size_t)(b * 32 + c) * 8 + h) * 2 + 1) * 128; CS[2 * lane + 1] = excl + a1; CS[2 * lane] = incl; }
        }
        ssd_stage_x(A, lds, h, row0, t0, L, tid);
        __syncthreads();
        if (!is_ctx) {
            const float Dh = A.in[I_SSD][h]; const int l = 16 * wave + fr; const float csfl = csf[l], csbl = csb[l];
            pg8::f32x4 yacc[4];
#pragma unroll
            for (int j = 0; j < 4; ++j) yacc[j] = (pg8::f32x4){0.f, 0.f, 0.f, 0.f};
#pragma unroll 2
            for (int ks = 0; ks < 4; ++ks) { const int s0 = 32 * ks + 8 * fq;
                const v4u g4 = *(const LAS v4u*)(lds + BM_OFF + l * LROW + s0 * 2);
                const f32x4 cfa = *(const LAS f32x4*)(csf + s0), cfb = *(const LAS f32x4*)(csf + s0 + 4), cba = *(const LAS f32x4*)(csb + s0), cbb = *(const LAS f32x4*)(csb + s0 + 4);
                const f32x4 dfa = *(const LAS f32x4*)(dtf + s0), dfb = *(const LAS f32x4*)(dtf + s0 + 4), dba = *(const LAS f32x4*)(dtb + s0), dbb = *(const LAS f32x4*)(dtb + s0 + 4);
                float m[8];
#pragma unroll
                for (int i = 0; i < 8; ++i) { const int s = s0 + i;
                    const float cfs = i < 4 ? cfa[i & 3] : cfb[i & 3], cbs = i < 4 ? cba[i & 3] : cbb[i & 3], dfs = i < 4 ? dfa[i & 3] : dfb[i & 3], dbs = i < 4 ? dba[i & 3] : dbb[i & 3];
                    const float arg = (s < l) ? csfl - cfs : csbl - cbs; const float dtv = (s < l) ? dfs : dbs;
                    float w = __expf(arg) * dtv; w = (s == l) ? dfs + dbs : w;
                    m[i] = bfe(g4, i) * w + ((s == l) ? Dh : 0.f); }
                v4u mf; mf.x = pk2(m[0], m[1]); mf.y = pk2(m[2], m[3]); mf.z = pk2(m[4], m[5]); mf.w = pk2(m[6], m[7]);
#pragma unroll
                for (int j = 0; j < 4; ++j) { const v4u af = *(const LAS v4u*)(lds + XT_OFF + (16 * j + fr) * LROW + s0 * 2); yacc[j] = mfma16(af, mf, yacc[j]); } }
            LAS unsigned char* st = lds + CM_OFF + wave * 4352;
#pragma unroll
            for (int j = 0; j < 4; ++j) { v2u w; w.x = pk2(yacc[j][0], yacc[j][1]); w.y = pk2(yacc[j][2], yacc[j][3]); *(LAS v2u*)(st + fr * 144 + (16 * j + 4 * fq) * 2) = w; }
            bf16* YD = (bf16*)(A.ws + WS_YD) + (row0 + t0 + 16 * wave) * 512 + 64 * h;
#pragma unroll
            for (int q = 0; q < 2; ++q) { const int r = 8 * q + (lane >> 3), ch = lane & 7; *(v4u*)(YD + (size_t)r * 512 + ch * 8) = *(const LAS v4u*)(st + r * 144 + ch * 16); }
        }
        {
            const int dir = wave >> 2, p = 16 * (wave & 3) + fr; LAS float* cs = dir ? csb : csf; LAS float* dtv = dir ? dtb : dtf;
            const float cend = dir ? csb[0] : csf[127];
            pg8::f32x4 sacc[8];
#pragma unroll
            for (int j = 0; j < 8; ++j) sacc[j] = (pg8::f32x4){0.f, 0.f, 0.f, 0.f};
#pragma unroll 2
            for (int ks = 0; ks < 4; ++ks) { const int s0 = 32 * ks + 8 * fq;
                const v4u x4 = *(const LAS v4u*)(lds + XT_OFF + p * LROW + s0 * 2);
                const f32x4 ca = *(const LAS f32x4*)(cs + s0), cb = *(const LAS f32x4*)(cs + s0 + 4), da = *(const LAS f32x4*)(dtv + s0), db = *(const LAS f32x4*)(dtv + s0 + 4);
                float m[8];
#pragma unroll
                for (int i = 0; i < 8; ++i) m[i] = bfe(x4, i) * (__expf(cend - (i < 4 ? ca[i & 3] : cb[i & 3])) * (i < 4 ? da[i & 3] : db[i & 3]));
                v4u xf; xf.x = pk2(m[0], m[1]); xf.y = pk2(m[2], m[3]); xf.z = pk2(m[4], m[5]); xf.w = pk2(m[6], m[7]);
#pragma unroll
                for (int j = 0; j < 8; ++j) { const v4u af = *(const LAS v4u*)(lds + BT_OFF + (16 * j + fr) * LROW + s0 * 2); sacc[j] = mfma16(af, xf, sacc[j]); } }
            LAS unsigned char* st = lds + CM_OFF + wave * 4352;
#pragma unroll
            for (int j = 0; j < 8; ++j) { v2u w; w.x = pk2(sacc[j][0], sacc[j][1]); w.y = pk2(sacc[j][2], sacc[j][3]); *(LAS v2u*)(st + fr * 272 + (16 * j + 4 * fq) * 2) = w; }
            bf16* SL = (bf16*)(A.ws + WS_SLOC) + ((((size_t)(b * NCC + cc) * 8 + h) * 2 + dir) * 64 + 16 * (wave & 3)) * 128;
#pragma unroll
            for (int q = 0; q < 4; ++q) { const int r = 4 * q + (lane >> 4), ch = lane & 15; *(v4u*)(SL + (size_t)r * 128 + ch * 8) = *(const LAS v4u*)(st + r * 272 + ch * 16); }
        }
    }
}

__device__ __forceinline__ void cfm_conv_item(const Args& A, int item, int tid) {
    const int line = item & 63, dir = (item >> 6) & 1, b = item >> 7;
    const int seg = tid >> 7, cp = tid & 127, ch = 256 * dir + 2 * cp;
    const bf16* UG = (const bf16*)(A.ws + WS_UGLU) + (size_t)b * SEQ * 512 + ch;
    const int tstride = dir ? 64 : 1, tbase = dir ? line : line * 64;
    unsigned raw[46];
#pragma unroll
    for (int ii = 0; ii < 46; ++ii) { const int pos = 16 * seg - 15 + ii;
        raw[ii] = (pos >= 0 && pos < 64) ? *(const unsigned*)(UG + (size_t)(tbase + pos * tstride) * 512) : 0u; }
    const float* ccw = A.in[I_CCW] + ch; const float* ccb = A.in[I_CCB] + ch;
    float w0[31], w1[31];
#pragma unroll
    for (int k = 0; k < 31; ++k) { w0[k] = ccw[k * 512]; w1[k] = ccw[k * 512 + 1]; }
    float a0[16], a1[16];
#pragma unroll
    for (int o = 0; o < 16; ++o) { a0[o] = ccb[0]; a1[o] = ccb[1]; }
#pragma unroll
    for (int ii = 0; ii < 46; ++ii) { const float lo = bflo(raw[ii]), hi = bfhi(raw[ii]);
#pragma unroll
        for (int o = 0; o < 16; ++o) { const int k = ii - o; if (k >= 0 && k <= 30) { a0[o] += w0[k] * lo; a1[o] += w1[k] * hi; } } }
    bf16* CO = (bf16*)(A.ws + WS_CONVO) + (size_t)b * SEQ * 512 + ch;
#pragma unroll
    for (int o = 0; o < 16; ++o) *(unsigned*)(CO + (size_t)(tbase + (16 * seg + o) * tstride) * 512) = pk2(a0[o], a1[o]);
}

__device__ __forceinline__ void p4_recur(const Args& A, int tid) {
    bf16* SLOC = (bf16*)(A.ws + WS_SLOC); float* DEC = (float*)(A.ws + WS_DEC);
    const int nthr = gridDim.x * 512;
    for (int idx = blockIdx.x * 512 + tid; idx < NB * 8 * 2 * 64 * 32; idx += nthr) {
        const int n4 = idx & 31, p = (idx >> 5) & 63, dir = (idx >> 11) & 1, h = (idx >> 12) & 7, b = idx >> 15;
        float S0 = 0.f, S1 = 0.f, S2 = 0.f, S3 = 0.f;
#pragma unroll 1
        for (int half = 0; half < 2; ++half) {
            v2u loc[17]; float dec[17];
#pragma unroll
            for (int s = 0; s < 17; ++s) { const int step = 17 * half + s;
                const int cc = dir == 0 ? step : (step < 2 ? 1 - step : 35 - step);
                const size_t slot = ((size_t)(b * NCC + cc) * 8 + h) * 2 + dir;
                loc[s] = *(const v2u*)(SLOC + slot * 8192 + p * 128 + 4 * n4); dec[s] = DEC[slot]; }
#pragma unroll
            for (int s = 0; s < 17; ++s) { const int step = 17 * half + s;
                const int cc = dir == 0 ? step : (step < 2 ? 1 - step : 35 - step);
                const size_t slot = ((size_t)(b * NCC + cc) * 8 + h) * 2 + dir;
                if (cc >= 2) { v2u o; o.x = pk2(S0, S1); o.y = pk2(S2, S3); *(v2u*)(SLOC + slot * 8192 + p * 128 + 4 * n4) = o; }
                S0 = dec[s] * S0 + bflo(loc[s].x); S1 = dec[s] * S1 + bfhi(loc[s].x); S2 = dec[s] * S2 + bflo(loc[s].y); S3 = dec[s] * S3 + bfhi(loc[s].y); }
        }
    }
}
__device__ __forceinline__ void ssd_out_item(const Args& A, LAS unsigned char* lds, int item, int tid, int wave, int lane) {
    const int g = item & 1, c = (item >> 1) & 31, b = item >> 6;
    LAS float* ECS = (LAS float*)(lds + 34816);
    LAS float* RED = (LAS float*)(lds + 38912);
    const size_t row0 = (size_t)b * SEQ + c * 128;
    const int fr = lane & 15, fq = lane >> 4;
    __syncthreads();
    { const bf16* CC = (const bf16*)(A.ws + WS_CCONV);
      for (int i = tid; i < 128 * 16; i += 512) { const int r = i >> 4, c8 = i & 15;
          *(LAS v4u*)(lds + r * LROW + c8 * 16) = *(const v4u*)(CC + (row0 + r) * 256 + g * 128 + c8 * 8); }
      const float* CS = (const float*)(A.ws + WS_CS) + ((size_t)(b * 32 + c) * 8 + 4 * g) * 256;
      for (int i = tid; i < 1024; i += 512) ECS[i] = __expf(CS[i]); }
    __syncthreads();
    const int hl = wave >> 1, ph = wave & 1, h = 4 * g + hl;
    v4u sf[2][2][4];
#pragma unroll
    for (int dir = 0; dir < 2; ++dir) { const bf16* SL = (const bf16*)(A.ws + WS_SLOC) + (((size_t)(b * NCC + c + 2) * 8 + h) * 2 + dir) * 8192;
#pragma unroll
        for (int jt = 0; jt < 2; ++jt)
#pragma unroll
            for (int ks = 0; ks < 4; ++ks) sf[dir][jt][ks] = *(const v4u*)(SL + (32 * ph + 16 * jt + fr) * 128 + 32 * ks + 8 * fq); }
    const bf16* YD = (const bf16*)(A.ws + WS_YD); const bf16* ZS = (const bf16*)(A.ws + WS_ZS);
    const int chb = 256 * g + 64 * hl + 32 * ph + 4 * fq;
    const float* snw = A.in[I_SNW]; bf16* A2 = (bf16*)(A.ws + WS_XN);
    f32x4 nw[2];
#pragma unroll
    for (int jt = 0; jt < 2; ++jt) nw[jt] = *(const f32x4*)(snw + chb + 16 * jt);
#pragma unroll 1
    for (int half = 0; half < 2; ++half) {
        float gv[4][2][4]; float ssq[4];
#pragma unroll
        for (int l4 = 0; l4 < 4; ++l4) { const int lt = 4 * half + l4;
            v4u cfr[4];
#pragma unroll
            for (int ks = 0; ks < 4; ++ks) cfr[ks] = *(const LAS v4u*)(lds + (16 * lt + fr) * LROW + (32 * ks + 8 * fq) * 2);
            pg8::f32x4 af[2], ab[2];
#pragma unroll
            for (int jt = 0; jt < 2; ++jt) { af[jt] = (pg8::f32x4){0.f, 0.f, 0.f, 0.f}; ab[jt] = (pg8::f32x4){0.f, 0.f, 0.f, 0.f};
#pragma unroll
                for (int ks = 0; ks < 4; ++ks) { af[jt] = mfma16(sf[0][jt][ks], cfr[ks], af[jt]); ab[jt] = mfma16(sf[1][jt][ks], cfr[ks], ab[jt]); } }
            const int l = 16 * lt + fr; const float ef = ECS[(hl * 2 + 0) * 128 + l], eb = ECS[(hl * 2 + 1) * 128 + l];
            float sq = 0.f;
#pragma unroll
            for (int jt = 0; jt < 2; ++jt) { const size_t o = (row0 + l) * 512 + chb + 16 * jt;
                const v2u yd = *(const v2u*)(YD + o), zs = *(const v2u*)(ZS + o);
                const float y0 = ef * af[jt][0] + eb * ab[jt][0] + bflo(yd.x), y1 = ef * af[jt][1] + eb * ab[jt][1] + bfhi(yd.x);
                const float y2 = ef * af[jt][2] + eb * ab[jt][2] + bflo(yd.y), y3 = ef * af[jt][3] + eb * ab[jt][3] + bfhi(yd.y);
                gv[l4][jt][0] = y0 * bflo(zs.x); gv[l4][jt][1] = y1 * bfhi(zs.x); gv[l4][jt][2] = y2 * bflo(zs.y); gv[l4][jt][3] = y3 * bfhi(zs.y);
#pragma unroll
                for (int r = 0; r < 4; ++r) sq += gv[l4][jt][r] * gv[l4][jt][r]; }
            sq += __shfl_xor(sq, 16); sq += __shfl_xor(sq, 32); ssq[l4] = sq;
        }
        __syncthreads();
        if (fq == 0) {
#pragma unroll
            for (int l4 = 0; l4 < 4; ++l4) RED[wave * 64 + 16 * l4 + fr] = ssq[l4]; }
        __syncthreads();
#pragma unroll
        for (int l4 = 0; l4 < 4; ++l4) { const int l = 16 * (4 * half + l4) + fr; float tot = 0.f;
#pragma unroll
            for (int w = 0; w < 8; ++w) tot += RED[w * 64 + 16 * l4 + fr];
            const float rstd = rsqrtf(tot * (1.f / 256.f) + EPS);
#pragma unroll
            for (int jt = 0; jt < 2; ++jt) { v2u o; o.x = pk2(gv[l4][jt][0] * rstd * nw[jt][0], gv[l4][jt][1] * rstd * nw[jt][1]); o.y = pk2(gv[l4][jt][2] * rstd * nw[jt][2], gv[l4][jt][3] * rstd * nw[jt][3]);
                *(v2u*)(A2 + (row0 + l) * 1024 + chb + 16 * jt) = o; } }
    }
}
__device__ __forceinline__ void cfm_ln_rows(const Args& A, int wave, int lane) {
    const bf16* CO = (const bf16*)(A.ws + WS_CONVO); bf16* A2 = (bf16*)(A.ws + WS_XN);
    const float* clw = A.in[I_CLW] + 8 * lane; const float* clb = A.in[I_CLB] + 8 * lane;
    const f32x4 w0 = *(const f32x4*)clw, w1 = *(const f32x4*)(clw + 4), b0 = *(const f32x4*)clb, b1 = *(const f32x4*)(clb + 4);
    const int gw = blockIdx.x * 8 + wave, NGW = gridDim.x * 8;
    for (int t = gw; t < T; t += NGW) {
        const v4u raw = *(const v4u*)(CO + (size_t)t * 512 + 8 * lane);
        float v[8]; float s = 0.f;
#pragma unroll
        for (int i = 0; i < 8; ++i) { v[i] = bfe(raw, i); s += v[i]; }
        const float mean = wave_sum(s) * (1.f / 512.f); float s2 = 0.f;
#pragma unroll
        for (int i = 0; i < 8; ++i) { v[i] -= mean; s2 += v[i] * v[i]; }
        const float rstd = rsqrtf(wave_sum(s2) * (1.f / 512.f) + EPS);
        float o[8];
#pragma unroll
        for (int i = 0; i < 8; ++i) o[i] = silu_f(v[i] * rstd * (i < 4 ? w0[i & 3] : w1[i & 3]) + (i < 4 ? b0[i & 3] : b1[i & 3]));
        v4u q; q.x = pk2(o[0], o[1]); q.y = pk2(o[2], o[3]); q.z = pk2(o[4], o[5]); q.w = pk2(o[6], o[7]);
        *(v4u*)(A2 + (size_t)t * 1024 + 512 + 8 * lane) = q;
    }
}

__device__ __forceinline__ void p7_norm2(const Args& A, int wave, int lane) {
    const bf16* X1 = (const bf16*)(A.ws + WS_X1B); const float* n2w = A.in[I_N2W]; float* MODV = (float*)(A.ws + WS_MODV); bf16* XN = (bf16*)(A.ws + WS_XN);
    const int gw = blockIdx.x * 8 + wave, NGW = gridDim.x * 8;
    v4u nx[2];
    if (gw < T) { nx[0] = *(const v4u*)(X1 + (size_t)gw * 1024 + 8 * lane); nx[1] = *(const v4u*)(X1 + (size_t)gw * 1024 + 512 + 8 * lane); }
    for (int row = gw; row < T; row += NGW) {
        const float* mp = MODV + (size_t)(row >> 12) * 6144;
        float v[16]; float ss = 0.f;
#pragma unroll
        for (int j = 0; j < 4; ++j) { v[2 * j] = bflo(nx[0][j]); v[2 * j + 1] = bfhi(nx[0][j]); v[8 + 2 * j] = bflo(nx[1][j]); v[8 + 2 * j + 1] = bfhi(nx[1][j]); }
#pragma unroll
        for (int i = 0; i < 16; ++i) ss += v[i] * v[i];
        { const int rn = row + NGW < T ? row + NGW : row;
          nx[0] = *(const v4u*)(X1 + (size_t)rn * 1024 + 8 * lane); nx[1] = *(const v4u*)(X1 + (size_t)rn * 1024 + 512 + 8 * lane); }
        const float rstd = rsqrtf(wave_sum(ss) * (1.f / 1024.f) + EPS);
#pragma unroll
        for (int hf = 0; hf < 2; ++hf) { const int col = 512 * hf + 8 * lane; float hv[8];
#pragma unroll
            for (int q = 0; q < 2; ++q) { const f32x4 nw = *(const f32x4*)(n2w + col + 4 * q), sh = *(const f32x4*)(mp + 3 * 1024 + col + 4 * q), sc = *(const f32x4*)(mp + 4 * 1024 + col + 4 * q);
#pragma unroll
                for (int i = 0; i < 4; ++i) hv[4 * q + i] = v[8 * hf + 4 * q + i] * rstd * nw[i] * (sc[i] + 1.f) + sh[i]; }
            v4u o; o.x = pk2(hv[0], hv[1]); o.y = pk2(hv[2], hv[3]); o.z = pk2(hv[4], hv[5]); o.w = pk2(hv[6], hv[7]);
            *(v4u*)(XN + (size_t)row * 1024 + col) = o; }
    }
}
constexpr int PEER_RV = PEER_FP8 ? 1 : 2;
__device__ __forceinline__ unsigned fkey(float s) { const unsigned u = __builtin_bit_cast(unsigned, s); return (u & 0x80000000u) ? ~u : (u | 0x80000000u); }
__device__ __forceinline__ float fkey_inv(unsigned k) { const unsigned u = (k & 0x80000000u) ? (k & 0x7fffffffu) : ~k; return __builtin_bit_cast(float, u); }
__device__ __forceinline__ unsigned umax_(unsigned a, unsigned b) { return a > b ? a : b; }
template <int CTRL> __device__ __forceinline__ unsigned dppu(unsigned x) { return (unsigned)__builtin_amdgcn_mov_dpp((int)x, CTRL, 0xf, 0xf, true); }
__device__ __forceinline__ unsigned allmax16(unsigned m) { m = umax_(m, dppu<0xB1>(m)); m = umax_(m, dppu<0x4E>(m)); m = umax_(m, dppu<0x141>(m)); m = umax_(m, dppu<0x140>(m)); return m; }
__device__ __forceinline__ unsigned allmax32(unsigned m) { m = allmax16(m); auto s = __builtin_amdgcn_permlane16_swap(m, m, false, false); const unsigned s0 = s[0], s1 = s[1]; return umax_(s0, s1); }
__device__ __forceinline__ unsigned allmax64(unsigned m) { m = allmax32(m); auto s = __builtin_amdgcn_permlane32_swap(m, m, false, false); const unsigned s0 = s[0], s1 = s[1]; return umax_(s0, s1); }
__device__ __forceinline__ float allmaxf16(float m) { m = fmaxf(m, dppf<0xB1>(m)); m = fmaxf(m, dppf<0x4E>(m)); m = fmaxf(m, dppf<0x141>(m)); m = fmaxf(m, dppf<0x140>(m)); return m; }
__device__ __forceinline__ float dot2bf(unsigned a, unsigned b, float acc) { return __builtin_amdgcn_fdot2_f32_bf16(__builtin_bit_cast(bf16x2_t, a), __builtin_bit_cast(bf16x2_t, b), acc, false); }

struct PeerRow { v4u r[PEER_RV]; };
__device__ __forceinline__ PeerRow peer_load(const unsigned char* tab, unsigned e, int lane) {
    PeerRow o; const unsigned char* p = tab + (size_t)e * (PEER_FP8 ? 1024 : 2048) + 16 * lane;
    o.r[0] = *(const v4u*)p;
    if (!PEER_FP8) o.r[PEER_RV - 1] = *(const v4u*)(p + 1024);
    return o;
}
__device__ __forceinline__ float peer_dot(const PeerRow& w, const unsigned (&xp)[8], const float (&xf)[16]) {
    if (PEER_FP8) {
        f32x2 a0 = {0.f, 0.f}, a1 = {0.f, 0.f};
#pragma unroll
        for (int j = 0; j < 4; ++j) { const f32x2 lo = __builtin_amdgcn_cvt_pk_f32_fp8((int)w.r[0][j], false), hi = __builtin_amdgcn_cvt_pk_f32_fp8((int)w.r[0][j], true);
            a0 += lo * (f32x2){xf[4 * j], xf[4 * j + 1]}; a1 += hi * (f32x2){xf[4 * j + 2], xf[4 * j + 3]}; }
        return (a0.x + a0.y) + (a1.x + a1.y);
    } else {
        float s0 = 0.f, s1 = 0.f;
#pragma unroll
        for (int j = 0; j < 4; ++j) { s0 = dot2bf(w.r[0][j], xp[j], s0); s1 = dot2bf(w.r[PEER_RV - 1][j], xp[4 + j], s1); }
        return s0 + s1;
    }
}
__device__ __forceinline__ void peer_axpy(const PeerRow& w, float c, f32x2 (&acc)[8]) {
    const f32x2 cc = {c, c};
    if (PEER_FP8) {
#pragma unroll
        for (int j = 0; j < 4; ++j) { acc[2 * j] += cc * __builtin_amdgcn_cvt_pk_f32_fp8((int)w.r[0][j], false); acc[2 * j + 1] += cc * __builtin_amdgcn_cvt_pk_f32_fp8((int)w.r[0][j], true); }
    } else {
#pragma unroll
        for (int j = 0; j < 4; ++j) { acc[j] += cc * (f32x2){bflo(w.r[0][j]), bfhi(w.r[0][j])}; acc[4 + j] += cc * (f32x2){bflo(w.r[PEER_RV - 1][j]), bfhi(w.r[PEER_RV - 1][j])}; }
    }
}

__device__ __forceinline__ unsigned umin_(unsigned a, unsigned b) { return a < b ? a : b; }
template <int N> __device__ __forceinline__ void bitonic_sort_desc(unsigned (&a)[N]) {
#pragma unroll
    for (int k = 2; k <= N; k <<= 1)
#pragma unroll
        for (int j = k >> 1; j > 0; j >>= 1)
#pragma unroll
            for (int i = 0; i < N; ++i) { const int l = i ^ j; if (l > i) { const unsigned mx = umax_(a[i], a[l]), mn = umin_(a[i], a[l]); const bool up = (i & k) == 0; a[i] = up ? mx : mn; a[l] = up ? mn : mx; } }
}
template <int N> __device__ __forceinline__ void bitonic_merge_desc(unsigned (&a)[N]) {
#pragma unroll
    for (int j = N >> 1; j > 0; j >>= 1)
#pragma unroll
        for (int i = 0; i < N; ++i) { const int l = i ^ j; if (l > i) { const unsigned mx = umax_(a[i], a[l]), mn = umin_(a[i], a[l]); a[i] = mx; a[l] = mn; } }
}
__device__ __forceinline__ void top16_merge(unsigned (&t)[16], const unsigned (&g)[16]) {
#pragma unroll
    for (int i = 0; i < 16; ++i) t[i] = umax_(t[i], g[15 - i]);
    bitonic_merge_desc<16>(t);
}
__device__ __forceinline__ void top16_of_128(const _Float16* col  , unsigned (&t)[16]) {
    _Float16 nx[16];
#pragma unroll
    for (int i = 0; i < 16; ++i) nx[i] = col[(size_t)i * T];
#pragma unroll 1
    for (int g = 0; g < 8; ++g) { unsigned q[16];
#pragma unroll
        for (int i = 0; i < 16; ++i) q[i] = (fkey((float)nx[i]) & ~127u) | (unsigned)(127 - 16 * g - i);
        { const int gn = g < 7 ? g + 1 : 7;
#pragma unroll
          for (int i = 0; i < 16; ++i) nx[i] = col[(size_t)(16 * gn + i) * T]; }
        bitonic_sort_desc<16>(q);
        if (g == 0) {
#pragma unroll
            for (int i = 0; i < 16; ++i) t[i] = q[i];
        } else top16_merge(t, q); }
}
__host__ __device__ constexpr int stair_r1(int idx) {
    const int th[15] = {16, 24, 29, 33, 36, 38, 40, 42, 43, 44, 45, 46, 47, 48, 49}; int r = 0; for (int i = 0; i < 15; ++i) r += (idx >= th[i]) ? 1 : 0; return r; }
__host__ __device__ constexpr int stair_r2(int idx) {
    const int st[16] = {0, 16, 24, 29, 33, 36, 38, 40, 42, 43, 44, 45, 46, 47, 48, 49}; return idx - st[stair_r1(idx)]; }
__device__ __forceinline__ void p9_select_init(LAS unsigned char* lds, int tid) {
    LAS unsigned* TAB = (LAS unsigned*)(lds + 65536);
    if (tid < 64) { const int idx = tid < 50 ? tid : 49; int r1 = 0; const int th[15] = {16, 24, 29, 33, 36, 38, 40, 42, 43, 44, 45, 46, 47, 48, 49};
#pragma unroll
        for (int i = 0; i < 15; ++i) r1 += (idx >= th[i]) ? 1 : 0;
        const int st[16] = {0, 16, 24, 29, 33, 36, 38, 40, 42, 43, 44, 45, 46, 47, 48, 49}; int s0 = 0;
#pragma unroll
        for (int i = 0; i < 16; ++i) s0 = (r1 == i) ? st[i] : s0;
        TAB[tid] = (unsigned)r1 | ((unsigned)(idx - s0) << 8); }
}
__device__ __forceinline__ void p9_select_one(const Args& A, LAS unsigned char* lds, int tid, int token, int h) {
    const _Float16* SCT = (const _Float16*)(A.ws + WS_SC); unsigned* EIDX = (unsigned*)(A.ws + WS_EIDX); float* GATE = (float*)(A.ws + WS_GATE);
    LAS unsigned* KL = (LAS unsigned*)lds;
    LAS unsigned* TAB = (LAS unsigned*)(lds + 65536);
    {
        unsigned k1[16], k2[16];
        top16_of_128(SCT + (size_t)(2 * h) * 128 * T + token, k1);
        top16_of_128(SCT + (size_t)(2 * h + 1) * 128 * T + token, k2);
        float v1[16], v2[16];
#pragma unroll
        for (int i = 0; i < 16; ++i) { KL[i * 512 + tid] = k1[i]; KL[(16 + i) * 512 + tid] = k2[i]; v1[i] = fkey_inv(k1[i] & ~127u); v2[i] = fkey_inv(k2[i] & ~127u); }
        unsigned c[16], q[16];
#pragma unroll
        for (int i = 0; i < 16; ++i) c[i] = (fkey(v1[stair_r1(i)] + v2[stair_r2(i)]) & ~63u) | (unsigned)(63 - i);
        bitonic_sort_desc<16>(c);
#pragma unroll
        for (int i = 0; i < 16; ++i) q[i] = (fkey(v1[stair_r1(16 + i)] + v2[stair_r2(16 + i)]) & ~63u) | (unsigned)(63 - 16 - i);
        bitonic_sort_desc<16>(q); top16_merge(c, q);
#pragma unroll
        for (int i = 0; i < 16; ++i) q[i] = (fkey(v1[stair_r1(32 + i)] + v2[stair_r2(32 + i)]) & ~63u) | (unsigned)(63 - 32 - i);
        bitonic_sort_desc<16>(q); top16_merge(c, q);
#pragma unroll
        for (int i = 0; i < 16; ++i) q[i] = (i < 2) ? ((fkey(v1[stair_r1(48 + (i < 2 ? i : 0))] + v2[stair_r2(48 + (i < 2 ? i : 0))]) & ~63u) | (unsigned)(63 - 48 - i)) : 0u;
        bitonic_sort_desc<16>(q); top16_merge(c, q);
        unsigned eid[16]; float ex[16]; const float mx = fkey_inv(c[0] & ~63u); float sm = 0.f;
#pragma unroll
        for (int i = 0; i < 16; ++i) { const unsigned rr = TAB[63 - (c[i] & 63u)];
            const unsigned ka = KL[(rr & 255u) * 512 + tid], kb = KL[(16 + (rr >> 8)) * 512 + tid];
            eid[i] = (127u - (ka & 127u)) * 128u + (127u - (kb & 127u));
            ex[i] = __expf(fkey_inv(c[i] & ~63u) - mx); sm += ex[i]; }
        const float inv = 1.f / sm;
        unsigned* ep = EIDX + (size_t)token * 128 + 16 * h; float* gp = GATE + (size_t)token * 128 + 16 * h; float* up = (float*)(A.ws + WS_USA) + (size_t)token * 128 + 16 * h;
        const float* USC = (const float*)(A.ws + WS_USC); const float* VSC = (const float*)(A.ws + WS_VSC);
        float us[16];
#pragma unroll
        for (int i = 0; i < 16; ++i) { us[i] = USC[eid[i]]; ex[i] = ex[i] * inv * VSC[eid[i]]; }
#pragma unroll
        for (int i = 0; i < 4; ++i) { *(v4u*)(ep + 4 * i) = (v4u){eid[4 * i], eid[4 * i + 1], eid[4 * i + 2], eid[4 * i + 3]};
            *(f32x4*)(gp + 4 * i) = (f32x4){ex[4 * i], ex[4 * i + 1], ex[4 * i + 2], ex[4 * i + 3]};
            *(f32x4*)(up + 4 * i) = (f32x4){us[4 * i], us[4 * i + 1], us[4 * i + 2], us[4 * i + 3]}; }
    }
}

#define PEER_LOAD8(buf, tab, ev, lb_) do { _Pragma("unroll") for (int i_ = 0; i_ < 8; ++i_) buf[i_] = peer_load(tab, (unsigned)__builtin_amdgcn_readlane((int)(ev), (lb_) + i_), lane); } while (0)
#define PEER_DOT8(buf, off_) do { _Pragma("unroll") for (int i_ = 0; i_ < 8; ++i_) p[(off_) + i_] = peer_dot(buf[i_], xp, xf); } while (0)
#define PEER_UFIN(hb_) do { wave_tsum16(p, lane); \
            const float d0 = __shfl(p[0], srcl), d1 = __shfl(p[1], srcl); \
            float dot = (i16 & 1) ? d1 : d0; \
            const unsigned eS_ = (hb_) < 4 ? eA : eB; const float gS = (hb_) < 4 ? gA : gB; \
            float wv; if (PEER_FP8) { dot *= USC[eS_]; wv = gS * gelu_f(dot) * VSC[eS_]; } else { wv = gS * gelu_f(dot); } \
            const bool mine = (lane >> 4) == ((hb_) & 3); \
            if ((hb_) < 4) wA = mine ? wv : wA; else wB = mine ? wv : wB; } while (0)
#define PEER_AXPY8(buf, wS_, lb_) do { _Pragma("unroll") for (int i_ = 0; i_ < 8; ++i_) peer_axpy(buf[i_], __builtin_bit_cast(float, __builtin_amdgcn_readlane(__builtin_bit_cast(int, (wS_)), (lb_) + i_)), acc); } while (0)
template <bool DUMMY> __device__ __forceinline__ void p9_peer(const Args& A, int wave, int lane, unsigned emask) {
    unsigned* EIDX = (unsigned*)(A.ws + WS_EIDX); float* GATE = (float*)(A.ws + WS_GATE); const bf16* XN = (const bf16*)(A.ws + WS_XN);
    const unsigned char* U = A.ws + WS_U; const unsigned char* V = A.ws + WS_V;
    const float* USC = (const float*)(A.ws + WS_USC); const float* VSC = (const float*)(A.ws + WS_VSC);
    float* MODV = (float*)(A.ws + WS_MODV); float* OUT = A.out; const float* fnw = A.in[I_FNW];
    const int i16 = lane & 15;
    const int srcl = 32 * ((i16 >> 3) & 1) + 16 * ((i16 >> 2) & 1) + 8 * ((i16 >> 1) & 1);
    const int gw = blockIdx.x * 8 + wave, NGW = gridDim.x * 8;
    PeerRow bufa[8], bufb[8];
    unsigned eA = 0, eB = 0; float gA = 0.f, gB = 0.f;
    if (gw < T) { eA = EIDX[(size_t)gw * 128 + lane] & emask; eB = EIDX[(size_t)gw * 128 + 64 + lane] & emask; gA = GATE[(size_t)gw * 128 + lane]; gB = GATE[(size_t)gw * 128 + 64 + lane];
        PEER_LOAD8(bufa, U, eA, 0); }
    for (int t = gw; t < T; t += NGW) {
        const int tn = (t + NGW < T) ? t + NGW : t;
        unsigned xp[8]; float xf[16];
        if (PEER_FP8) {
            const v4u a = *(const v4u*)(XN + (size_t)t * 1024 + 16 * lane), b2 = *(const v4u*)(XN + (size_t)t * 1024 + 16 * lane + 8);
#pragma unroll
            for (int j = 0; j < 4; ++j) { xf[2 * j] = bflo(a[j]); xf[2 * j + 1] = bfhi(a[j]); xf[8 + 2 * j] = bflo(b2[j]); xf[8 + 2 * j + 1] = bfhi(b2[j]); xp[j] = 0u; xp[4 + j] = 0u; }
        } else {
            const v4u a = *(const v4u*)(XN + (size_t)t * 1024 + 8 * lane), b2 = *(const v4u*)(XN + (size_t)t * 1024 + 512 + 8 * lane);
#pragma unroll
            for (int j = 0; j < 4; ++j) { xp[j] = a[j]; xp[4 + j] = b2[j]; }
#pragma unroll
            for (int j = 0; j < 16; ++j) xf[j] = 0.f;
        }
        float wA = 0.f, wB = 0.f;
#pragma unroll 1
        for (int hb = 0; hb < 8; ++hb) {
            const unsigned eS = hb < 4 ? eA : eB; const int lb = 16 * (hb & 3);
            float p[16];
            PEER_LOAD8(bufb, U, eS, lb + 8);
            PEER_DOT8(bufa, 0);
            if (hb < 7) { const unsigned eN = hb < 3 ? eA : eB; PEER_LOAD8(bufa, U, eN, 16 * ((hb + 1) & 3)); }
            else PEER_LOAD8(bufa, V, eA, 0);
            PEER_DOT8(bufb, 8);
            PEER_UFIN(hb);
        }
        const unsigned eAn = EIDX[(size_t)tn * 128 + lane] & emask;
        f32x2 acc[8];
#pragma unroll
        for (int i = 0; i < 8; ++i) acc[i] = (f32x2){0.f, 0.f};
#pragma unroll 1
        for (int hb = 0; hb < 8; ++hb) {
            const unsigned eS = hb < 4 ? eA : eB; const float wS = hb < 4 ? wA : wB; const int lb = 16 * (hb & 3);
            PEER_LOAD8(bufb, V, eS, lb + 8);
            PEER_AXPY8(bufa, wS, lb);
            if (hb < 7) { const unsigned eN = hb < 3 ? eA : eB; PEER_LOAD8(bufa, V, eN, 16 * ((hb + 1) & 3)); }
            else if (tn != t) PEER_LOAD8(bufa, U, eAn, 0);
            PEER_AXPY8(bufb, wS, lb + 8);
        }
        float* orow = OUT + (size_t)t * 1024; const float* g5 = MODV + (size_t)(t >> 12) * 6144 + 5 * 1024;
        float x2[16]; float ss = 0.f;
#pragma unroll
        for (int q = 0; q < 4; ++q) { const int col = PEER_FP8 ? 16 * lane + 4 * q : (q < 2 ? 8 * lane + 4 * q : 512 + 8 * lane + 4 * (q - 2));
            const f32x4 a = *(const f32x4*)(orow + col), ga = *(const f32x4*)(g5 + col);
            x2[4 * q] = a[0] + ga[0] * acc[2 * q].x; x2[4 * q + 1] = a[1] + ga[1] * acc[2 * q].y; x2[4 * q + 2] = a[2] + ga[2] * acc[2 * q + 1].x; x2[4 * q + 3] = a[3] + ga[3] * acc[2 * q + 1].y; }
#pragma unroll
        for (int i = 0; i < 16; ++i) ss += x2[i] * x2[i];
        const float rstd = rsqrtf(wave_sum(ss) * (1.f / 1024.f) + EPS);
#pragma unroll
        for (int q = 0; q < 4; ++q) { const int col = PEER_FP8 ? 16 * lane + 4 * q : (q < 2 ? 8 * lane + 4 * q : 512 + 8 * lane + 4 * (q - 2));
            const f32x4 wa = *(const f32x4*)(fnw + col); f32x4 oa;
#pragma unroll
            for (int k = 0; k < 4; ++k) oa[k] = x2[4 * q + k] * rstd * wa[k];
            if (!DUMMY || rstd == 123.456f) *(f32x4*)(orow + col) = oa; }
        eA = eAn; eB = EIDX[(size_t)tn * 128 + 64 + lane] & emask; gA = GATE[(size_t)tn * 128 + lane]; gB = GATE[(size_t)tn * 128 + 64 + lane];
    }
}
#if PEER_FP8
constexpr int GL_RSH = 11, GL_KB = 2;
constexpr int GL_TG = 4, GL_NE = 128 * GL_TG, GL_NBT = GL_NE / 8;
constexpr int GL_L = 0, GL_W = 4 * GL_NE, GL_CNT = 8 * GL_NE, GL_OFF = GL_CNT + 256, GL_US = GL_OFF + 256, GL_D = GL_US + 4 * GL_NE, GL_X = GL_D + 4 * GL_NE, GL_WAVE_BYTES = GL_X + 2048 * GL_TG;
constexpr int GL_ACC = GL_US;
static_assert(GL_WAVE_BYTES - GL_ACC >= 4096 * (GL_TG - 1), "parked accumulators fit");
static_assert(8 * GL_WAVE_BYTES <= LDSCTL_OFF && GL_NBT % 4 == 0, "gather LDS map");
__device__ __forceinline__ void gl_axpy(const v4u& w, float c, f32x2 (&acc)[8]) {
    const f32x2 cc = {c, c};
#pragma unroll
    for (int j = 0; j < 4; ++j) { acc[2 * j] += cc * __builtin_amdgcn_cvt_pk_f32_fp8((int)w[j], false); acc[2 * j + 1] += cc * __builtin_amdgcn_cvt_pk_f32_fp8((int)w[j], true); }
}
__device__ __forceinline__ float swapmax16(float a) { auto r = __builtin_amdgcn_permlane16_swap(__builtin_bit_cast(unsigned, a), __builtin_bit_cast(unsigned, a), false, false); const unsigned r0 = r[0], r1 = r[1]; return fmaxf(__uint_as_float(r0), __uint_as_float(r1)); }
__device__ __forceinline__ float swapmax32(float a) { auto r = __builtin_amdgcn_permlane32_swap(__builtin_bit_cast(unsigned, a), __builtin_bit_cast(unsigned, a), false, false); const unsigned r0 = r[0], r1 = r[1]; return fmaxf(__uint_as_float(r0), __uint_as_float(r1)); }
__device__ __forceinline__ float wave_max(float v) { v = fmaxf(v, dppf<0xB1>(v)); v = fmaxf(v, dppf<0x4E>(v)); v = fmaxf(v, dppf<0x141>(v)); v = fmaxf(v, dppf<0x140>(v)); return swapmax32(swapmax16(v)); }
#define GL_WAIT() asm volatile("s_waitcnt lgkmcnt(0)" ::: "memory")
#define GL_RLOAD(buf, tab, bidx) do { const unsigned ent_ = Ls[8 * (bidx) + (lane >> 3)]; \
    _Pragma("unroll") for (int j_ = 0; j_ < 8; ++j_) { const unsigned e_ = (unsigned)__builtin_amdgcn_readlane((int)ent_, 8 * j_) & 0x3fffu; buf[j_] = *(const v4u*)((tab) + (size_t)e_ * 1024 + 16 * lane); } } while (0)
#define GL_UCOMP(buf, bidx) do { const unsigned ent_ = Ls[8 * (bidx) + (lane >> 3)]; float p[8]; \
    _Pragma("unroll") for (int j_ = 0; j_ < 8; ++j_) { const unsigned kk_ = ((unsigned)__builtin_amdgcn_readlane((int)ent_, 8 * j_) >> 14) & 3u; \
        const v4u xq_ = *(const LAS v4u*)(XS + kk_ * 1024 + 16 * lane); int s_ = 0; \
        _Pragma("unroll") for (int w_ = 0; w_ < 4; ++w_) s_ = __builtin_amdgcn_sdot4((int)buf[j_][w_], (int)xq_[w_], s_, false); \
        p[j_] = (float)s_; } \
    _Pragma("unroll") for (int q_ = 0; q_ < 4; ++q_) p[q_] = swapsum32(p[q_], p[q_ + 4]); \
    _Pragma("unroll") for (int q_ = 0; q_ < 2; ++q_) p[q_] = swapsum16(p[q_], p[q_ + 2]); \
    { const bool up_ = (lane & 8) != 0; const float snd_ = up_ ? p[0] : p[1]; const float keep_ = up_ ? p[1] : p[0]; p[0] = keep_ + dppf<0x128>(snd_); } \
    p[0] = allsumf8(p[0]);                                        \
    if ((lane & 7) == 0) Ds[8 * (bidx) + (lane >> 3)] = p[0]; } while (0)
#define GL_VSWITCH(kn_) do { const int s_ = (mapbits >> (2 * (kn_))) & 3; LAS unsigned char* sp_ = ACCS + s_ * 4096 + 64 * lane; \
    const f32x4 t0_ = *(const LAS f32x4*)sp_, t1_ = *(const LAS f32x4*)(sp_ + 16), t2_ = *(const LAS f32x4*)(sp_ + 32), t3_ = *(const LAS f32x4*)(sp_ + 48); \
    *(LAS f32x4*)sp_ = (f32x4){cur[0].x, cur[0].y, cur[1].x, cur[1].y}; *(LAS f32x4*)(sp_ + 16) = (f32x4){cur[2].x, cur[2].y, cur[3].x, cur[3].y}; \
    *(LAS f32x4*)(sp_ + 32) = (f32x4){cur[4].x, cur[4].y, cur[5].x, cur[5].y}; *(LAS f32x4*)(sp_ + 48) = (f32x4){cur[6].x, cur[6].y, cur[7].x, cur[7].y}; \
    cur[0] = (f32x2){t0_[0], t0_[1]}; cur[1] = (f32x2){t0_[2], t0_[3]}; cur[2] = (f32x2){t1_[0], t1_[1]}; cur[3] = (f32x2){t1_[2], t1_[3]}; \
    cur[4] = (f32x2){t2_[0], t2_[1]}; cur[5] = (f32x2){t2_[2], t2_[3]}; cur[6] = (f32x2){t3_[0], t3_[1]}; cur[7] = (f32x2){t3_[2], t3_[3]}; \
    mapbits = (mapbits & ~(3 << (2 * kcur))) | (s_ << (2 * kcur)); kcur = (kn_); } while (0)
#define GL_VCOMP(buf, bidx) do { const unsigned ent_ = Ls[8 * (bidx) + (lane >> 3)]; const float wv_ = Ws[8 * (bidx) + (lane >> 3)]; \
    _Pragma("unroll") for (int j_ = 0; j_ < 8; ++j_) { const int kk_ = (int)(((unsigned)__builtin_amdgcn_readlane((int)ent_, 8 * j_) >> 14) & 3u); \
        const float w_ = __builtin_bit_cast(float, __builtin_amdgcn_readlane(__builtin_bit_cast(int, wv_), 8 * j_)); \
        if (kk_ != kcur) { asm volatile("" ::: "memory"); GL_VSWITCH(kk_); } \
        gl_axpy(buf[j_], w_, cur); } } while (0)
#define GL_SWEEP(tab, COMP) do { GL_RLOAD(buf0, tab, 0); GL_RLOAD(buf1, tab, 1); GL_RLOAD(buf2, tab, 2); \
    _Pragma("unroll 1") for (int b_ = 0; b_ < GL_NBT; b_ += 4) { \
        GL_RLOAD(buf3, tab, b_ + 3); COMP(buf0, b_); \
        GL_RLOAD(buf0, tab, (b_ + 4 < GL_NBT ? b_ + 4 : GL_NBT - 1)); COMP(buf1, b_ + 1); \
        GL_RLOAD(buf1, tab, (b_ + 5 < GL_NBT ? b_ + 5 : GL_NBT - 1)); COMP(buf2, b_ + 2); \
        GL_RLOAD(buf2, tab, (b_ + 6 < GL_NBT ? b_ + 6 : GL_NBT - 1)); COMP(buf3, b_ + 3); } } while (0)

template <bool DUMMY> __device__ __forceinline__ void p10_gather(const Args& A, LAS unsigned char* lds, int wave, int lane, const XcdBarrier& bar, unsigned emask) {
    unsigned* EIDX = (unsigned*)(A.ws + WS_EIDX); float* GATE = (float*)(A.ws + WS_GATE); const bf16* XN = (const bf16*)(A.ws + WS_XN);
    const unsigned char* U = A.ws + WS_U; const unsigned char* V = A.ws + WS_V;
    const float* USC = (const float*)(A.ws + WS_USC); const float* VSC = (const float*)(A.ws + WS_VSC);
    float* MODV = (float*)(A.ws + WS_MODV); float* OUT = A.out; const float* fnw = A.in[I_FNW];
    LAS unsigned char* wl = lds + wave * GL_WAVE_BYTES;
    LAS unsigned* Ls = (LAS unsigned*)(wl + GL_L); LAS float* Ws = (LAS float*)(wl + GL_W); LAS float* USs = (LAS float*)(wl + GL_US); LAS float* Ds = (LAS float*)(wl + GL_D);
    LAS unsigned* CNT = (LAS unsigned*)(wl + GL_CNT); LAS unsigned* OFF = (LAS unsigned*)(wl + GL_OFF); LAS unsigned char* XS = wl + GL_X; LAS unsigned char* ACCS = wl + GL_ACC; LAS float* SXS = (LAS float*)(wl + GL_CNT);
    const int gw = blockIdx.x * 8 + wave, NGW = gridDim.x * 8, NGRP = T / GL_TG;
    (void)bar;
    unsigned e[2 * GL_TG]; float g[2 * GL_TG], us[2 * GL_TG]; const float* USA = (const float*)(A.ws + WS_USA);
#define GL_LOADSEL(E_, G_, U_, grp_) do { _Pragma("unroll") for (int j = 0; j < 2 * GL_TG; ++j) { const size_t o = (size_t)(GL_TG * (grp_) + (j >> 1)) * 128 + (j & 1) * 64 + lane; E_[j] = EIDX[o] & emask; G_[j] = GATE[o]; U_[j] = USA[o]; } } while (0)
    if (gw < NGRP) GL_LOADSEL(e, g, us, gw);
    for (int it = 0; it < (NGRP + NGW - 1) / NGW; ++it) {
        const int gi = gw + it * NGW;
#ifndef GL_GRID_SYNC
#define GL_GRID_SYNC 0
#endif
        if (GL_GRID_SYNC && N_LAUNCHES == 1 && it > 0 && !DUMMY) xcd_barrier(bar); else __syncthreads();
        if (gi < NGRP) {
            const int t0 = GL_TG * gi;
            CNT[lane] = 0u; GL_WAIT();
            unsigned ps[2 * GL_TG];
#pragma unroll
            for (int j = 0; j < 2 * GL_TG; ++j) ps[j] = __hip_atomic_fetch_add(CNT + (((e[j] >> GL_RSH) << GL_KB) | (unsigned)(j >> 1)), 1u, __ATOMIC_RELAXED, __HIP_MEMORY_SCOPE_WORKGROUP);
            GL_WAIT();
            { const unsigned c = CNT[lane]; unsigned incl = c;
#pragma unroll
              for (int o = 1; o < 64; o <<= 1) { const unsigned v = (unsigned)__shfl_up((int)incl, o); if (lane >= o) incl += v; }
              OFF[lane] = incl - c; }
            GL_WAIT();
#pragma unroll
            for (int j = 0; j < 2 * GL_TG; ++j) { const unsigned i2 = OFF[((e[j] >> GL_RSH) << GL_KB) | (unsigned)(j >> 1)] + ps[j];
                Ls[i2] = e[j] | ((unsigned)(j >> 1) << 14); Ws[i2] = g[j]; USs[i2] = us[j]; }
#pragma unroll
            for (int k = 0; k < GL_TG; ++k) { const v4u a = *(const v4u*)(XN + (size_t)(t0 + k) * 1024 + 16 * lane), b2 = *(const v4u*)(XN + (size_t)(t0 + k) * 1024 + 16 * lane + 8);
                float xv[16]; float am = 0.f;
#pragma unroll
                for (int j = 0; j < 4; ++j) { xv[2 * j] = bflo(a[j]); xv[2 * j + 1] = bfhi(a[j]); xv[8 + 2 * j] = bflo(b2[j]); xv[8 + 2 * j + 1] = bfhi(b2[j]); }
#pragma unroll
                for (int j = 0; j < 16; ++j) am = fmaxf(am, fabsf(xv[j]));
                am = wave_max(am); const float inv8 = am > 0.f ? 127.f / am : 0.f;
                v4u qx;
#pragma unroll
                for (int j = 0; j < 4; ++j) qx[j] = ((unsigned)__float2int_rn(xv[4 * j] * inv8) & 255u) | (((unsigned)__float2int_rn(xv[4 * j + 1] * inv8) & 255u) << 8)
                                                  | (((unsigned)__float2int_rn(xv[4 * j + 2] * inv8) & 255u) << 16) | (((unsigned)__float2int_rn(xv[4 * j + 3] * inv8) & 255u) << 24);
                *(LAS v4u*)(XS + k * 1024 + 16 * lane) = qx; if (lane == 0) SXS[k] = am * (1.f / 127.f); }
            GL_WAIT();
            v4u buf0[8], buf1[8], buf2[8], buf3[8];
#ifdef GL_PROBE_NOSWEEP
            if (!DUMMY)
#endif
            GL_SWEEP(U, GL_UCOMP);
            GL_WAIT();
#pragma unroll
            for (int j = 0; j < 2 * GL_TG; ++j) { const int i = lane + 64 * j; Ws[i] = Ws[i] * gelu_f(Ds[i] * USs[i] * SXS[(Ls[i] >> 14) & 3u]); }
            GL_WAIT();
            f32x2 cur[8]; int kcur = 0; int mapbits = (0 << 2) | (1 << 4) | (2 << 6);
            { LAS unsigned char* zp = ACCS + 64 * lane;
#pragma unroll
              for (int q = 0; q < 4 * (GL_TG - 1); ++q) *(LAS f32x4*)(zp + (q >> 2) * 4096 + (q & 3) * 16) = (f32x4){0.f, 0.f, 0.f, 0.f}; }
#pragma unroll
            for (int i = 0; i < 8; ++i) cur[i] = (f32x2){0.f, 0.f};
            GL_WAIT();
            GL_SWEEP(V, GL_VCOMP);
            { const int gn = gi + NGW < NGRP ? gi + NGW : gi; GL_LOADSEL(e, g, us, gn); }
            const float* fnw_ = fnw; asm volatile("" : "+s"(fnw_));
#pragma unroll
            for (int k = 0; k < GL_TG; ++k) { const int t = t0 + k;
                if (k != kcur) { asm volatile("" ::: "memory"); GL_VSWITCH(k); }
                float* orow = OUT + (size_t)t * 1024 + 16 * lane; const float* g5 = MODV + (size_t)(t >> 12) * 6144 + 5 * 1024 + 16 * lane;
                const bf16* x1p = (const bf16*)(A.ws + WS_X1B) + (size_t)t * 1024 + 16 * lane; const v4u xa1 = *(const v4u*)x1p, xb1 = *(const v4u*)(x1p + 8);
                float x2[16]; float ss = 0.f;
#pragma unroll
                for (int q = 0; q < 4; ++q) { const unsigned w0_ = q < 2 ? xa1[2 * q] : xb1[2 * q - 4], w1_ = q < 2 ? xa1[2 * q + 1] : xb1[2 * q - 3];
                    const f32x4 a = {bflo(w0_), bfhi(w0_), bflo(w1_), bfhi(w1_)}, ga = *(const f32x4*)(g5 + 4 * q);
                    x2[4 * q] = a[0] + ga[0] * cur[2 * q].x; x2[4 * q + 1] = a[1] + ga[1] * cur[2 * q].y; x2[4 * q + 2] = a[2] + ga[2] * cur[2 * q + 1].x; x2[4 * q + 3] = a[3] + ga[3] * cur[2 * q + 1].y; }
#pragma unroll
                for (int i = 0; i < 16; ++i) ss += x2[i] * x2[i];
                const float rstd = rsqrtf(wave_sum(ss) * (1.f / 1024.f) + EPS);
#pragma unroll
                for (int q = 0; q < 4; ++q) { const f32x4 wa = *(const f32x4*)(fnw_ + 16 * lane + 4 * q); f32x4 oa;
#pragma unroll
                    for (int i = 0; i < 4; ++i) oa[i] = x2[4 * q + i] * rstd * wa[i];
                    if (!DUMMY || rstd == 123.456f) *(f32x4*)(orow + 4 * q) = oa; } }
        }
    }
}
#endif
__global__ void __launch_bounds__(512, 2) fwd_kernel(Args args) {
    extern __shared__ __attribute__((aligned(16))) unsigned char lds_raw[];
    LAS unsigned char* lds = (LAS unsigned char*)lds_raw;
    volatile LAS unsigned* MISC = (volatile LAS unsigned*)(lds + MISC_OFF);
    const int tid = threadIdx.x, lane = tid & 63, wave = __builtin_amdgcn_readfirstlane(tid >> 6);
    for (int u = tid; u < (LDS_BYTES - LDSCTL_OFF) / 4; u += 512) ((LAS unsigned*)(lds + LDSCTL_OFF))[u] = 0u;
    __syncthreads();
    unsigned* ctl = (unsigned*)(args.ws + WS_CTL);
    XcdBarrier bar; bar.bar = ctl + CW_BAR; bar.x = 0; bar.st = nullptr;
    if (N_LAUNCHES == 1) bar = xcd_barrier_post(ctl + CW_BAR, MISC + 8);
    const int lo = args.ph_lo, hi = args.ph_hi;
#ifndef ONLY_PHASE
#define ONLY_PHASE -1
#endif
#define IN(k) ((ONLY_PHASE < 0 || ONLY_PHASE == (k)) && lo <= (k) && (k) < hi)
#define SEAM(k) do { if (IN(k) && IN((k) + 1)) xcd_barrier(bar); } while (0)
#ifndef DUP_MASK
#define DUP_MASK 0
#endif
#define REP(k) for (int rep_ = 0; rep_ < (((DUP_MASK >> (k)) & 1) ? 2 : 1); ++rep_, (rep_ < (((DUP_MASK >> (k)) & 1) ? 2 : 1) ? xcd_barrier(bar) : (void)0))

    if (IN(0)) REP(0) { p0_mod(args, lds, tid); p0_weights(args, lds, tid, wave, lane); p0_wc(args, lds, tid); }
    SEAM(0);
    if (IN(1)) REP(1) { p1_norm(args, lds, tid, wave, lane, 0); }
    SEAM(1);
    if (IN(2)) REP(2) {
        pg8::Gemm g{(const pg8::bf16_t*)(args.ws + WS_XN), (const pg8::bf16_t*)(args.ws + WS_WIN), MROWS, 2560, 1024};
        InProjOrder S; S.init((int)gridDim.x, (int)blockIdx.x);
        EpiInProj E{(bf16*)(args.ws + WS_ZS), (bf16*)(args.ws + WS_XBC), (bf16*)(args.ws + WS_UGLU)};
        pg8::gemm_phase<EpiInProj, InProjOrder, true, true>(lds, g, S, E);
    }
    SEAM(2);
    if (IN(3)) REP(3) {
        const int G3 = (int)gridDim.x, c3 = (int)blockIdx.x, NSSD = NB * NCC * 2, NCTX = NB * 2 * 2, NCONV = NB * 2 * 64;
        for (int it = c3; it < NSSD; it += G3) ssd_local_item(args, lds, it, tid, wave, lane);
        const bool split = G3 == 256;
        if (!split || c3 >= NCTX) for (int j = split ? c3 - NCTX : c3; j < NCONV; j += split ? G3 - NCTX : G3) cfm_conv_item(args, j, tid);
    }
    SEAM(3);
    if (IN(4)) REP(4) { p4_recur(args, tid); }
    SEAM(4);
    if (IN(5)) REP(5) {
        for (int it = blockIdx.x; it < NB * 32 * 2; it += gridDim.x) ssd_out_item(args, lds, it, tid, wave, lane);
        cfm_ln_rows(args, wave, lane);
    }
    SEAM(5);
    if (IN(6)) REP(6) {
        pg8::Gemm g{(const pg8::bf16_t*)(args.ws + WS_XN), (const pg8::bf16_t*)(args.ws + WS_WOUT), T, 1024, 1024};
        pg8::StaticOrder S; S.init(T, 1024, (int)gridDim.x, (int)blockIdx.x);
        EpiOutProj E{args.in[I_X], (bf16*)(args.ws + WS_X1B), (float*)(args.ws + WS_MODV)};
        pg8::gemm_phase<EpiOutProj, pg8::StaticOrder, true, true>(lds, g, S, E);
    }
    SEAM(6);
    if (IN(7)) REP(7) { p7_norm2(args, wave, lane); }
    SEAM(7);
    if (IN(8)) REP(8) {
        pg8::Gemm g{(const pg8::bf16_t*)(args.ws + WS_WC), (const pg8::bf16_t*)(args.ws + WS_XN), 2048, T, 1024};
        pg8::StaticOrder S; S.init(2048, T, (int)gridDim.x, (int)blockIdx.x);
        EpiScore E{(_Float16*)(args.ws + WS_SC)};
        pg8::gemm_phase<EpiScore, pg8::StaticOrder, true, true>(lds, g, S, E);
    }
    SEAM(8);
    if (IN(9)) REP(9) {
        p9_select_init(lds, tid); __syncthreads();
        for (int item = blockIdx.x; item < 8 * (T / 512); item += gridDim.x) p9_select_one(args, lds, tid, (item >> 3) * 512 + tid, item & 7);
    }
    SEAM(9);
#if PEER_FP8 && !defined(PEER_FLAT)
#ifdef PEER_PROBE_MASK
    if (IN(10)) { p10_gather<true>(args, lds, wave, lane, bar, PEER_PROBE_MASK); }
#endif
    if (IN(10)) REP(10) { p10_gather<false>(args, lds, wave, lane, bar, 0xffffffffu); }
#else
    if (IN(10)) REP(10) { p9_peer<false>(args, wave, lane, 0xffffffffu); }
#endif
#undef IN
#undef SEAM
}

#ifndef HOST_DUP_MASK
#define HOST_DUP_MASK 0
#endif
extern "C" void kernel_launch(void* const* d_in, const int* in_sizes, int n_in, void* d_out, int out_size, void* d_ws, size_t ws_size, hipStream_t stream) {
    static int grid = 0;
    if (grid == 0) {
        if (n_in != 25 || in_sizes[0] != T * D || out_size != T * D || ws_size < WS_END) {
            fprintf(stderr, "kernel_launch: unexpected problem (n_in %d, in0 %d, out %d, ws %zu); nothing launched\n", n_in, n_in > 0 ? in_sizes[0] : -1, out_size, ws_size); grid = -1; return; }
        int dev = 0, cus = 0, per_cu = 0;
        if (hipGetDevice(&dev) != hipSuccess || hipDeviceGetAttribute(&cus, hipDeviceAttributeMultiprocessorCount, dev) != hipSuccess) { grid = -1; return; }
        if (hipFuncSetAttribute((const void*)fwd_kernel, hipFuncAttributeMaxDynamicSharedMemorySize, LDS_BYTES) != hipSuccess) { fprintf(stderr, "kernel_launch: hipFuncSetAttribute failed\n"); grid = -1; return; }
        if (hipOccupancyMaxActiveBlocksPerMultiprocessor(&per_cu, (const void*)fwd_kernel, 512, LDS_BYTES) != hipSuccess || per_cu < 1) { fprintf(stderr, "kernel_launch: occupancy query says %d blocks/CU\n", per_cu); grid = -1; (void)hipGetLastError(); return; }
        (void)hipGetLastError();
        grid = cus;
    }
    if (grid < 0) return;
    (void)hipMemsetAsync((char*)d_ws + WS_CTL, 0, CTL_ZERO_BYTES, stream);
    Args a{};
    for (int i = 0; i < 25; ++i) a.in[i] = (const float*)d_in[i];
    a.out = (float*)d_out; a.ws = (unsigned char*)d_ws;
    if (N_LAUNCHES == 1) {
        a.ph_lo = 0; a.ph_hi = NPHASE; a.li = 0;
        hipLaunchKernelGGL(fwd_kernel, dim3(grid), dim3(512), LDS_BYTES, stream, a);
    } else {
        for (int li = 0; li < NPHASE; ++li) { a.ph_lo = li; a.ph_hi = li + 1; a.li = li;
            for (int r = 0; r < (((HOST_DUP_MASK >> li) & 1) ? 2 : 1); ++r) hipLaunchKernelGGL(fwd_kernel, dim3(grid), dim3(512), LDS_BYTES, stream, a); }
    }
}
```

```cpp
#include <hip/hip_runtime.h>
#include <cstdio>
#include <cstdint>
namespace pg8 {
#define PG8_LAS __attribute__((address_space(3)))
typedef unsigned short bf16_t;
typedef short bf16x8 __attribute__((ext_vector_type(8)));
typedef float f32x4 __attribute__((ext_vector_type(4)));
typedef unsigned u32x4 __attribute__((ext_vector_type(4)));
constexpr int BM = 256, BK = 64, HALF = 128, HTB = HALF * BK * 2  , STAGE_BYTES = 8 * HTB, NXCD = 8, WGM = 8;

__host__ __device__ __forceinline__ int lds_byte(int r, int c) { const int st = (r >> 4) * 2 + (c >> 5), rr = r & 15, cc = c & 31, ob = rr * 64 + cc * 2; return st * 1024 + (ob ^ (((ob >> 9) & 1) << 5)); }
__host__ __device__ __forceinline__ void stage_rc(int b, int& R, int& C) { const int st = b / 1024, sb = b % 1024, swz = sb ^ (((sb >> 9) & 1) << 5); R = (st >> 1) * 16 + swz / 64; C = (st & 1) * 32 + (swz % 64) / 2; }
__host__ __device__ __forceinline__ int perm32(int rho) { const int n = rho >> 4, i = rho & 15; return 8 * (i >> 2) + 4 * n + (i & 3); }

struct Unit { int pm, pn; };
struct Gemm { const bf16_t* A; const bf16_t* Bt; int M, N, K; };

struct StaticOrder {
    int nM, nN, nwg, G, c;
    __host__ __device__ void init(int M, int N, int G_, int c_) { nM = M / BM; nN = N / BM; nwg = nM * nN; G = G_; c = c_; }
    __host__ __device__ bool next(int i, Unit& u) const {
        const long L = (long)i * G + c; if (L >= nwg) return false;
        int wgid = (int)L; { const int q = nwg / NXCD, r = nwg % NXCD, xcd = wgid % NXCD, off = wgid / NXCD; wgid = (xcd < r ? xcd * (q + 1) : r * (q + 1) + (xcd - r) * q) + off; }
        const int nig = WGM * nN, gid = wgid / nig, fm = gid * WGM, gsz = (nM - fm) < WGM ? (nM - fm) : WGM;
        u.pm = fm + ((wgid % nig) % gsz); u.pn = (wgid % nig) / gsz; return true;
    }
    __device__ __forceinline__ void a_ready(const Unit&) const {}
    __device__ __forceinline__ void done(const Unit&) const {}
};

__device__ __forceinline__ unsigned cvt_pk_bf16(float lo, float hi) { unsigned r; asm volatile("v_cvt_pk_bf16_f32 %0, %1, %2" : "=v"(r) : "v"(lo), "v"(hi)); return r; }
template <class Epi, class Sched, bool ALIGN_EPI = false, bool SP2 = false>
__device__ __forceinline__ void gemm_phase(PG8_LAS unsigned char* lds, const Gemm g, const Sched& S, const Epi& E) {
    const int tid = threadIdx.x, wid = __builtin_amdgcn_readfirstlane(tid >> 6), lane = tid & 63, wr = wid >> 2, wc = wid & 3, fr = lane & 15, fq = lane >> 4;
    const int K = g.K, nt = K / BK;
    unsigned voffA[2], voffB[2];
#pragma unroll
    for (int i = 0; i < 2; ++i) { int R, C; stage_rc(tid * 16 + i * 8192, R, C); const int Rb = Epi::PERM ? ((R & ~31) + perm32(R & 31)) : R;
        voffA[i] = (unsigned)(R * K + C) * 2u; voffB[i] = (unsigned)(Rb * K + C) * 2u; }
    const size_t kstep = (size_t)(BK * 2);
    const size_t hstep = (size_t)HALF * K * 2;
    const size_t tstep = 2 * hstep;
    const unsigned ldsw = (unsigned)wid * 1024u;
    const int aoff = lds_byte(wr * 64 + fr, fq * 8), boff = lds_byte(wc * 32 + fr, fq * 8);
#define PG8_SA(b, h) (((b) * 2 + (h)) * HTB)
#define PG8_SB(b, h) ((4 + (b) * 2 + (h)) * HTB)
#define PG8_STAGE(bufoff, gbase, voff) do { _Pragma("unroll") for (int _i = 0; _i < 2; ++_i) \
        __builtin_amdgcn_global_load_lds((const unsigned*)((const char*)(gbase) + (voff)[_i]), (PG8_LAS unsigned*)(lds + (bufoff) + ldsw + _i * 8192), 16, 0, 0); } while (0)
#define PG8_LDA(dst, b, h) do { _Pragma("unroll") for (int m = 0; m < 4; ++m) _Pragma("unroll") for (int k = 0; k < 2; ++k) dst[m][k] = *(const PG8_LAS bf16x8*)(lds + PG8_SA(b, h) + aoff + m * 2048 + k * 1024); } while (0)
#define PG8_LDB(dst, b, h) do { _Pragma("unroll") for (int n = 0; n < 2; ++n) _Pragma("unroll") for (int k = 0; k < 2; ++k) dst[n][k] = *(const PG8_LAS bf16x8*)(lds + PG8_SB(b, h) + boff + n * 2048 + k * 1024); } while (0)
#define PG8_MMA(ai, bj, At, Bt) do { __builtin_amdgcn_s_setprio(1); _Pragma("unroll") for (int m = 0; m < 4; ++m) _Pragma("unroll") for (int n = 0; n < 2; ++n) _Pragma("unroll") for (int k = 0; k < 2; ++k) \
        acc[ai][bj][m][n] = __builtin_amdgcn_mfma_f32_16x16x32_bf16(Bt[n][k], At[m][k], acc[ai][bj][m][n], 0, 0, 0); __builtin_amdgcn_s_setprio(0); } while (0)
#define PG8_WAIT_V(n) asm volatile("s_waitcnt vmcnt(" #n ")" ::: "memory")
#define PG8_WAIT_L(n) asm volatile("s_waitcnt lgkmcnt(" #n ")" ::: "memory")
#define PG8_BAR __builtin_amdgcn_s_barrier()
#define PG8_SCHED __builtin_amdgcn_sched_barrier(0)
    Unit cur, nxt; int ui = 0;
    if (!S.next(0, cur)) return;
    f32x4 acc[2][2][4][2];
#pragma unroll
    for (int a = 0; a < 2; ++a)
#pragma unroll
        for (int b = 0; b < 2; ++b)
#pragma unroll
            for (int m = 0; m < 4; ++m)
#pragma unroll
                for (int n = 0; n < 2; ++n) acc[a][b][m][n] = (f32x4){0.f, 0.f, 0.f, 0.f};
    bf16x8 At[4][2], B0[2][2], B1[2][2];
    const char* cA = (const char*)g.A + (size_t)cur.pm * tstep; const char* cB = (const char*)g.Bt + (size_t)cur.pn * tstep;
    S.a_ready(cur);
    if constexpr (SP2) {
        PG8_STAGE(PG8_SB(0, 0), cB, voffB); PG8_STAGE(PG8_SB(0, 1), cB + hstep, voffB); PG8_STAGE(PG8_SA(0, 0), cA, voffA); PG8_STAGE(PG8_SA(0, 1), cA + hstep, voffA);
        if (wr == 1) PG8_BAR;
        PG8_WAIT_V(2); PG8_BAR;
        PG8_STAGE(PG8_SB(1, 0), cB + kstep, voffB); PG8_STAGE(PG8_SA(1, 0), cA + kstep, voffA); PG8_STAGE(PG8_SB(1, 1), cB + hstep + kstep, voffB);
        PG8_WAIT_V(6); PG8_BAR;
    } else {
        PG8_STAGE(PG8_SB(0, 0), cB, voffB); PG8_STAGE(PG8_SA(0, 0), cA, voffA); PG8_STAGE(PG8_SB(0, 1), cB + hstep, voffB); PG8_STAGE(PG8_SA(0, 1), cA + hstep, voffA);
        if (wr == 1) PG8_BAR;
        PG8_WAIT_V(4); PG8_BAR;
        PG8_STAGE(PG8_SB(1, 0), cB + kstep, voffB); PG8_STAGE(PG8_SA(1, 0), cA + kstep, voffA); PG8_STAGE(PG8_SB(1, 1), cB + hstep + kstep, voffB);
        PG8_WAIT_V(6); PG8_BAR;
    }
    for (;;) {
        const bool has_next = S.next(ui + 1, nxt);
        const char* nA = has_next ? (const char*)g.A + (size_t)nxt.pm * tstep : cA; const char* nB = has_next ? (const char*)g.Bt + (size_t)nxt.pn * tstep : cB;
        for (int t = 0; t < nt; t += 2) {
            const bool last = (t == nt - 2);
            const char* a1 = cA + (size_t)(t + 1) * kstep;
            const char* a2 = last ? nA : cA + (size_t)(t + 2) * kstep; const char* b2 = last ? nB : cB + (size_t)(t + 2) * kstep;
            const char* a3 = a2 + kstep; const char* b3 = b2 + kstep;
            if (last && has_next) S.a_ready(nxt);
            if constexpr (SP2) {
            PG8_LDB(B0, 0, 0); PG8_LDB(B1, 0, 1); PG8_SCHED; PG8_LDA(At, 0, 0); PG8_STAGE(PG8_SA(1, 1), a1 + hstep, voffA);
            PG8_WAIT_V(8); PG8_WAIT_L(0); PG8_BAR; PG8_MMA(0, 0, At, B0); PG8_MMA(0, 1, At, B1); PG8_BAR; PG8_SCHED;
            PG8_LDA(At, 0, 1); PG8_STAGE(PG8_SB(0, 0), b2, voffB); PG8_STAGE(PG8_SB(0, 1), b2 + hstep, voffB); PG8_STAGE(PG8_SA(0, 0), a2, voffA);
            PG8_WAIT_V(8); PG8_WAIT_L(0); PG8_BAR; PG8_MMA(1, 0, At, B0); PG8_MMA(1, 1, At, B1); PG8_BAR; PG8_SCHED;
            PG8_LDB(B0, 1, 0); PG8_LDB(B1, 1, 1); PG8_SCHED; PG8_LDA(At, 1, 0); PG8_STAGE(PG8_SA(0, 1), a2 + hstep, voffA);
            PG8_WAIT_V(8); PG8_WAIT_L(0); PG8_BAR; PG8_MMA(0, 0, At, B0); PG8_MMA(0, 1, At, B1); PG8_BAR; PG8_SCHED;
            PG8_LDA(At, 1, 1); PG8_STAGE(PG8_SB(1, 0), b3, voffB); PG8_STAGE(PG8_SB(1, 1), b3 + hstep, voffB); PG8_STAGE(PG8_SA(1, 0), a3, voffA);
            PG8_WAIT_V(8); PG8_WAIT_L(0); PG8_BAR; PG8_MMA(1, 0, At, B0); PG8_MMA(1, 1, At, B1); PG8_BAR; PG8_SCHED;
            } else {
            PG8_LDB(B0, 0, 0); PG8_SCHED; PG8_LDA(At, 0, 0); PG8_STAGE(PG8_SA(1, 1), a1 + hstep, voffA);
            PG8_WAIT_L(8); PG8_BAR; PG8_WAIT_L(0); PG8_MMA(0, 0, At, B0); PG8_BAR; PG8_SCHED;
            PG8_LDB(B1, 0, 1); PG8_STAGE(PG8_SB(0, 0), b2, voffB);
            PG8_BAR; PG8_WAIT_L(0); PG8_MMA(0, 1, At, B1); PG8_BAR;
            PG8_LDA(At, 0, 1); PG8_STAGE(PG8_SA(0, 0), a2, voffA);
            PG8_BAR; PG8_WAIT_L(0); PG8_MMA(1, 0, At, B0); PG8_BAR; PG8_SCHED;
            PG8_STAGE(PG8_SB(0, 1), b2 + hstep, voffB);
            PG8_WAIT_V(6); PG8_BAR; PG8_MMA(1, 1, At, B1); PG8_BAR;
            PG8_LDB(B0, 1, 0); PG8_SCHED; PG8_LDA(At, 1, 0); PG8_STAGE(PG8_SA(0, 1), a2 + hstep, voffA);
            PG8_WAIT_L(8); PG8_BAR; PG8_WAIT_L(0); PG8_MMA(0, 0, At, B0); PG8_BAR; PG8_SCHED;
            PG8_LDB(B1, 1, 1); PG8_STAGE(PG8_SB(1, 0), b3, voffB);
            PG8_BAR; PG8_WAIT_L(0); PG8_MMA(0, 1, At, B1); PG8_BAR;
            PG8_LDA(At, 1, 1); PG8_STAGE(PG8_SA(1, 0), a3, voffA);
            PG8_BAR; PG8_WAIT_L(0); PG8_MMA(1, 0, At, B0); PG8_BAR; PG8_SCHED;
            PG8_STAGE(PG8_SB(1, 1), b3 + hstep, voffB);
            PG8_WAIT_V(6); PG8_BAR; PG8_MMA(1, 1, At, B1); PG8_BAR;
            }
        }
        if constexpr (ALIGN_EPI) { if (wr == 0) PG8_BAR; }
        if constexpr (!Epi::AFTER_DRAIN) { E(acc, cur, wr, wc, fr, fq); S.done(cur); }
        if (!has_next) break;
#pragma unroll
        for (int a = 0; a < 2; ++a)
#pragma unroll
            for (int b = 0; b < 2; ++b)
#pragma unroll
                for (int m = 0; m < 4; ++m)
#pragma unroll
                    for (int n = 0; n < 2; ++n) acc[a][b][m][n] = (f32x4){0.f, 0.f, 0.f, 0.f};
        cur = nxt; cA = nA; cB = nB; ++ui;
        if constexpr (ALIGN_EPI) { if (wr == 1) PG8_BAR; }
    }
    PG8_WAIT_V(0);
    if constexpr (!ALIGN_EPI) { if (wr == 0) PG8_BAR; }
    PG8_BAR;
    if constexpr (Epi::AFTER_DRAIN) { E.fused(acc, cur, wr, wc, fr, fq, lds, wid, lane); S.done(cur); }
#undef PG8_SA
#undef PG8_SB
#undef PG8_STAGE
#undef PG8_LDA
#undef PG8_LDB
#undef PG8_MMA
#undef PG8_WAIT_V
#undef PG8_WAIT_L
#undef PG8_BAR
#undef PG8_SCHED
}
}
#ifndef PEER_FP8
#define PEER_FP8 1
#endif
#ifndef MK_N_LAUNCHES
#define MK_N_LAUNCHES 1
#endif
constexpr int NPHASE = 11;
constexpr int N_LAUNCHES = MK_N_LAUNCHES;

constexpr int NB = 8, SEQ = 4096, D = 1024, T = NB * SEQ, CTXL = 256, TC = NB * CTXL, MROWS = T + TC;
constexpr int NCC = 34;
constexpr int IN_COLS = 2576, DT_COL0 = 1536, GLU_COL0 = 1552;
constexpr int NEXP = 16384;
constexpr float EPS = 1e-6f;

constexpr size_t MiB = 1u << 20;
constexpr size_t WS_CTL = 0, CTL_ZERO_BYTES = 64 * 1024;
constexpr size_t WS_MODV = 1 * MiB;
constexpr size_t WS_CS = 2 * MiB;
constexpr size_t WS_DEC = 4 * MiB;
constexpr size_t WS_DT = 5 * MiB;
constexpr size_t WS_USC = 7 * MiB + 256 * 1024, WS_VSC = 7 * MiB + 512 * 1024;
constexpr size_t WS_WIN = 8 * MiB;
constexpr size_t WS_WOUT = 13 * MiB;
constexpr size_t WS_WC = 15 * MiB;
constexpr size_t WS_U = 20 * MiB, WS_V = 52 * MiB;
constexpr size_t WS_XN = 84 * MiB;
constexpr size_t WS_XBC = 152 * MiB;
constexpr size_t WS_ZS = 220 * MiB;
constexpr size_t WS_UGLU = 252 * MiB;
constexpr size_t WS_YD = 284 * MiB;
constexpr size_t WS_SLOC = 316 * MiB;
constexpr size_t WS_CONVO = 384 * MiB;
constexpr size_t WS_CCONV = 416 * MiB;
constexpr size_t WS_SC = 152 * MiB;
constexpr size_t WS_X1B = 284 * MiB;
constexpr size_t WS_EIDX = 432 * MiB;
constexpr size_t WS_GATE = 448 * MiB;
constexpr size_t WS_USA = 464 * MiB;
constexpr size_t WS_END = 480 * MiB;
constexpr int CW_BAR = 4096;

constexpr int RING_BYTES = 131072, LDSCTL_OFF = 143360, MISC_OFF = LDSCTL_OFF + 320, LDS_BYTES = 147456;

#define GAS __attribute__((address_space(1)))
#define LAS __attribute__((address_space(3)))
typedef unsigned short bf16;
typedef unsigned v4u __attribute__((ext_vector_type(4)));
typedef unsigned v2u __attribute__((ext_vector_type(2)));
typedef float f32x4 __attribute__((ext_vector_type(4)));
typedef float f32x2 __attribute__((ext_vector_type(2)));
typedef short bf16x8 __attribute__((ext_vector_type(8)));
typedef GAS unsigned gu32;
#define RLX_AGENT __ATOMIC_RELAXED, __HIP_MEMORY_SCOPE_AGENT
__device__ __forceinline__ unsigned f2bf(float f) { unsigned u = __builtin_bit_cast(unsigned, f); return (u + 0x7fffu + ((u >> 16) & 1u)) >> 16; }
typedef __bf16 bf16x2_t __attribute__((ext_vector_type(2)));
__device__ __forceinline__ unsigned pk2(float lo, float hi) { const f32x2 v = {lo, hi}; return __builtin_bit_cast(unsigned, __builtin_convertvector(v, bf16x2_t)); }
__device__ __forceinline__ float bflo(unsigned u) { return __builtin_bit_cast(float, u << 16); }
__device__ __forceinline__ float bfhi(unsigned u) { return __builtin_bit_cast(float, u & 0xffff0000u); }
template <int CTRL> __device__ __forceinline__ float dppf(float x) { return __builtin_bit_cast(float, __builtin_amdgcn_mov_dpp(__builtin_bit_cast(int, x), CTRL, 0xf, 0xf, true)); }
__device__ __forceinline__ float swapsum32(float a, float b) { auto r = __builtin_amdgcn_permlane32_swap(__builtin_bit_cast(unsigned, a), __builtin_bit_cast(unsigned, b), false, false); const unsigned r0 = r[0], r1 = r[1]; return __uint_as_float(r0) + __uint_as_float(r1); }
__device__ __forceinline__ float swapsum16(float a, float b) { auto r = __builtin_amdgcn_permlane16_swap(__builtin_bit_cast(unsigned, a), __builtin_bit_cast(unsigned, b), false, false); const unsigned r0 = r[0], r1 = r[1]; return __uint_as_float(r0) + __uint_as_float(r1); }
__device__ __forceinline__ float allsumf8(float m) { m += dppf<0xB1>(m); m += dppf<0x4E>(m); m += dppf<0x141>(m); return m; }
__device__ __forceinline__ float allsumf16(float m) { m = allsumf8(m); m += dppf<0x140>(m); return m; }
__device__ __forceinline__ float wave_sum(float v) { v = allsumf16(v); v = swapsum16(v, v); return swapsum32(v, v); }
__device__ __forceinline__ void wave_tsum16(float (&p)[16], int lane) {
#pragma unroll
    for (int k = 0; k < 8; ++k) p[k] = swapsum32(p[k], p[k + 8]);
#pragma unroll
    for (int k = 0; k < 4; ++k) p[k] = swapsum16(p[k], p[k + 4]);
    const bool up = (lane & 8) != 0;
#pragma unroll
    for (int k = 0; k < 2; ++k) { const float snd = up ? p[k] : p[k + 2]; const float keep = up ? p[k + 2] : p[k]; p[k] = keep + dppf<0x128>(snd); }
    p[0] = allsumf8(p[0]); p[1] = allsumf8(p[1]);
}
__device__ __forceinline__ size_t x1b_off(int r, int c) { return ((size_t)(r >> 4) * 32 + (c >> 5)) * 512 + (r & 15) * 32 + (c & 31); }
__device__ __forceinline__ float silu_f(float x) { return x * __builtin_amdgcn_rcpf(1.f + __expf(-x)); }
__device__ __forceinline__ float sigmoid_f(float x) { return __builtin_amdgcn_rcpf(1.f + __expf(-x)); }
__device__ __forceinline__ float softplus_f(float x) { return fmaxf(x, 0.f) + log1pf(__expf(-fabsf(x))); }
__device__ __forceinline__ float gelu_f(float x) { return 0.5f * x * (1.f + erff(x * 0.70710678118654752f)); }

#define XB_TMO      128
#define XB_XCNT(j)  (256  + 64 * (j))
#define XB_XSUB(j)  (1280 + 64 * (j))
#define XB_XGEN(j)  (2304 + 64 * (j))
#define XB_TOP      3328
#define XB_TOPGEN   3392
#define XCD_BAR_WORDS 3456
#define XB_SPIN_CAP (1u << 22)
__device__ __forceinline__ unsigned xb_ld(unsigned* p)              { return __hip_atomic_load(p, __ATOMIC_RELAXED, __HIP_MEMORY_SCOPE_AGENT); }
__device__ __forceinline__ unsigned xb_add(unsigned* p, unsigned v) { return __hip_atomic_fetch_add(p, v, __ATOMIC_RELAXED, __HIP_MEMORY_SCOPE_AGENT); }
__device__ __forceinline__ unsigned xb_xcc_id() { return (unsigned)__builtin_amdgcn_s_getreg((3 << 11) | 20) & 0xFu; }
#define XB_SPIN(cond, bar) do { unsigned _sp = 0; while (cond) { __builtin_amdgcn_s_sleep(1); \
    if ((++_sp & 255u) == 0u) { if (xb_ld(&(bar)[XB_TMO])) break; if (_sp > XB_SPIN_CAP) { atomicAdd(&(bar)[XB_TMO], 1u); break; } } } } while (0)

struct XcdBarrier {
    unsigned* bar; unsigned x;
    volatile LAS unsigned* st;
};

__device__ __forceinline__ XcdBarrier xcd_barrier_post(unsigned* bar, volatile LAS unsigned* st) {
    XcdBarrier b; b.bar = bar; b.x = xb_xcc_id(); b.st = st;
    if (threadIdx.x == 0) (void)xb_add(&bar[XB_XCNT(b.x)], 1u);
    return b;
}
__device__ __forceinline__ void xcd_barrier_complete(unsigned* bar, unsigned x, unsigned& nloc, unsigned& nx) {
    const unsigned G = gridDim.x * gridDim.y * gridDim.z;
    unsigned sum, cnt, mine, sp = 0u;
    for (;;) {
        sum = 0u; cnt = 0u; mine = 0u;
#pragma unroll
        for (unsigned j = 0; j < 16; ++j) { const unsigned c = xb_ld(&bar[XB_XCNT(j)]); sum += c; cnt += (c > 0u) ? 1u : 0u; mine = (j == x) ? c : mine; }
        if (sum == G) break;
        __builtin_amdgcn_s_sleep(1);
        if ((++sp & 255u) == 0u) { if (xb_ld(&bar[XB_TMO])) break; if (sp > XB_SPIN_CAP) { atomicAdd(&bar[XB_TMO], 1u); break; } }
    }
    nloc = mine > 0u ? mine : 1u; nx = cnt > 0u ? cnt : 1u;
}

__device__ __forceinline__ void xcd_barrier(const XcdBarrier& b) {
    asm volatile("s_waitcnt vmcnt(0)" ::: "memory");
    __syncthreads();
    if (threadIdx.x == 0) {
        unsigned* bar = b.bar;
        __builtin_amdgcn_s_waitcnt(0);
        unsigned nloc = b.st[0], nx = b.st[1];
        if (nloc == 0u) { xcd_barrier_complete(bar, b.x, nloc, nx); b.st[0] = nloc; b.st[1] = nx; }
        const unsigned old = xb_add(&bar[XB_XSUB(b.x)], 1u);
        const unsigned gen = old / nloc;
        if (old + 1u == (gen + 1u) * nloc) {
            __builtin_amdgcn_fence(__ATOMIC_RELEASE, "agent");
            asm volatile("s_waitcnt vmcnt(0)" ::: "memory");
            const unsigned og = xb_add(&bar[XB_TOP], 1u);
            const unsigned tg = og / nx;
            if (og + 1u == (tg + 1u) * nx) xb_add(&bar[XB_TOPGEN], 1u);
            else XB_SPIN(xb_ld(&bar[XB_TOPGEN]) == tg, bar);
            __builtin_amdgcn_fence(__ATOMIC_ACQUIRE, "agent");
            xb_add(&bar[XB_XGEN(b.x)], 1u);
            asm volatile("s_waitcnt vmcnt(0)" ::: "memory");
        } else {
            XB_SPIN(xb_ld(&bar[XB_XGEN(b.x)]) == gen, bar);
            __builtin_amdgcn_fence(__ATOMIC_ACQUIRE, "agent");
            asm volatile("s_waitcnt vmcnt(0)" ::: "memory");
        }
    }
    __syncthreads();
}
struct EpiInProj {
    static constexpr bool PERM = true, AFTER_DRAIN = false;
    bf16* ZS; bf16* XBC; bf16* UG;
    __device__ __forceinline__ void operator()(const pg8::f32x4 (&acc)[2][2][4][2], const pg8::Unit& u, int wr, int wc, int fr, int fq) const {
        const int row0 = u.pm * 256 + wr * 64 + fr, cl0 = wc * 32 + 8 * fq;
        if (u.pn < 2) {
#pragma unroll
            for (int ai = 0; ai < 2; ++ai)
#pragma unroll
                for (int m = 0; m < 4; ++m) { bf16* rowp = ZS + (size_t)(row0 + ai * 128 + m * 16) * 512 + u.pn * 256 + cl0;
#pragma unroll
                    for (int bj = 0; bj < 2; ++bj) { const pg8::f32x4 a = acc[ai][bj][m][0], b = acc[ai][bj][m][1]; v4u w;
                        w.x = pk2(silu_f(a[0]), silu_f(a[1])); w.y = pk2(silu_f(a[2]), silu_f(a[3])); w.z = pk2(silu_f(b[0]), silu_f(b[1])); w.w = pk2(silu_f(b[2]), silu_f(b[3]));
                        *(v4u*)(rowp + bj * 128) = w; } }
        } else if (u.pn < 6) {
#pragma unroll
            for (int ai = 0; ai < 2; ++ai)
#pragma unroll
                for (int m = 0; m < 4; ++m) { bf16* rowp = XBC + (size_t)(row0 + ai * 128 + m * 16) * 1024 + (u.pn - 2) * 256 + cl0;
#pragma unroll
                    for (int bj = 0; bj < 2; ++bj) { const pg8::f32x4 a = acc[ai][bj][m][0], b = acc[ai][bj][m][1]; v4u w;
                        w.x = pk2(a[0], a[1]); w.y = pk2(a[2], a[3]); w.z = pk2(b[0], b[1]); w.w = pk2(b[2], b[3]);
                        *(v4u*)(rowp + bj * 128) = w; } }
        } else {
            const int ch0 = 128 * (u.pn - 6) + 16 * wc + 4 * fq;
#pragma unroll
            for (int ai = 0; ai < 2; ++ai)
#pragma unroll
                for (int m = 0; m < 4; ++m) { bf16* rowp = UG + (size_t)(row0 + ai * 128 + m * 16) * 512 + ch0;
#pragma unroll
                    for (int bj = 0; bj < 2; ++bj) { const pg8::f32x4 a = acc[ai][bj][m][0], g = acc[ai][bj][m][1]; v2u w;
                        w.x = pk2(a[0] * sigmoid_f(g[0]), a[1] * sigmoid_f(g[1])); w.y = pk2(a[2] * sigmoid_f(g[2]), a[3] * sigmoid_f(g[3]));
                        *(v2u*)(rowp + bj * 64) = w; } }
        }
    }
};
struct EpiOutProj {
    static constexpr bool PERM = true, AFTER_DRAIN = false;
    const float* X; bf16* X1; float* MODV;
    __device__ __forceinline__ void operator()(const pg8::f32x4 (&acc)[2][2][4][2], const pg8::Unit& u, int wr, int wc, int fr, int fq) const {
        const int row0 = u.pm * 256 + wr * 64 + fr, col0 = u.pn * 256 + wc * 32 + 8 * fq;
        const float* gp = MODV + (size_t)(row0 >> 12) * 6144 + 2 * 1024 + col0;
        pg8::f32x4 g[2][2];
#pragma unroll
        for (int bj = 0; bj < 2; ++bj) { g[bj][0] = *(const pg8::f32x4*)(gp + bj * 128); g[bj][1] = *(const pg8::f32x4*)(gp + bj * 128 + 4); }
#pragma unroll
        for (int ai = 0; ai < 2; ++ai) {
            pg8::f32x4 xv[4][2][2];
#pragma unroll
            for (int m = 0; m < 4; ++m) { const size_t o = (size_t)(row0 + ai * 128 + m * 16) * 1024 + col0;
#pragma unroll
                for (int bj = 0; bj < 2; ++bj) { xv[m][bj][0] = *(const pg8::f32x4*)(X + o + bj * 128); xv[m][bj][1] = *(const pg8::f32x4*)(X + o + bj * 128 + 4); } }
#pragma unroll
            for (int m = 0; m < 4; ++m) { const size_t o = (size_t)(row0 + ai * 128 + m * 16) * 1024 + col0;
#pragma unroll
                for (int bj = 0; bj < 2; ++bj) {
                    const pg8::f32x4 y0 = xv[m][bj][0] + g[bj][0] * acc[ai][bj][m][0], y1 = xv[m][bj][1] + g[bj][1] * acc[ai][bj][m][1];
                    v4u w; w.x = pk2(y0[0], y0[1]); w.y = pk2(y0[2], y0[3]); w.z = pk2(y1[0], y1[1]); w.w = pk2(y1[2], y1[3]);
                    *(v4u*)(X1 + ((size_t)(u.pm * 16 + ai * 8 + wr * 4 + m) * 32 + u.pn * 8 + bj * 4 + wc) * 512 + fr * 32 + 8 * fq) = w; } } }
    }
};
struct EpiScore {
    static constexpr bool PERM = true, AFTER_DRAIN = false;
    _Float16* SC;
    __device__ __forceinline__ void operator()(const pg8::f32x4 (&acc)[2][2][4][2], const pg8::Unit& u, int wr, int wc, int fr, int fq) const {
        const int row0 = u.pm * 256 + wr * 64 + fr, col0 = u.pn * 256 + wc * 32 + 8 * fq;
        typedef _Float16 h8 __attribute__((ext_vector_type(8)));
#pragma unroll
        for (int ai = 0; ai < 2; ++ai)
#pragma unroll
            for (int m = 0; m < 4; ++m) { const int rb = u.pm * 16 + ai * 8 + wr * 4 + m;
#pragma unroll
                for (int bj = 0; bj < 2; ++bj) { const pg8::f32x4 a = acc[ai][bj][m][0], b = acc[ai][bj][m][1]; const int cb = u.pn * 8 + bj * 4 + wc;
                    h8 o = {(_Float16)a[0], (_Float16)a[1], (_Float16)a[2], (_Float16)a[3], (_Float16)b[0], (_Float16)b[1], (_Float16)b[2], (_Float16)b[3]};
                    *(h8*)(SC + ((size_t)rb * (T / 32) + cb) * 512 + fr * 32 + 8 * fq) = o; } }
    }
};
struct InProjOrder {
    pg8::StaticOrder S; int G, c;
    __device__ void init(int G_, int c_) { S.init(T, 2560, G_, c_); G = G_; c = c_; }
    __device__ bool next(int i, pg8::Unit& u) const {
        const long L = (long)i * G + c;
        if (L < 1280) return S.next(i, u);
        if (L >= 1312) return false;
        const int l2 = (int)L - 1280; u.pm = 128 + (l2 >> 2); u.pn = 2 + (l2 & 3); return true;
    }
    __device__ __forceinline__ void a_ready(const pg8::Unit&) const {}
    __device__ __forceinline__ void done(const pg8::Unit&) const {}
};
struct Args { const float* in[25]; float* out; unsigned char* ws; int ph_lo, ph_hi, li, pad; };
enum { I_X = 0, I_C, I_CTX, I_CCTX, I_ADAW, I_ADAB, I_N1W, I_N2W, I_WIN, I_SCW, I_SCB, I_DTB, I_ALOG, I_SSD, I_SNW, I_CCW, I_CCB, I_CLW, I_CLB, I_WOUT, I_WQ, I_SK, I_PU, I_PV, I_FNW };

__device__ __forceinline__ void p0_mod(const Args& A, LAS unsigned char* lds, int tid) {
    LAS float* s = (LAS float*)lds;
    LAS float* red = (LAS float*)(lds + 36864);
    const float* c = A.in[I_C]; const float* cctx = A.in[I_CCTX]; const float* adaw = A.in[I_ADAW]; const float* adab = A.in[I_ADAB];
    float* MODV = (float*)(A.ws + WS_MODV);
    for (int item = blockIdx.x; item < 192; item += gridDim.x) {
        for (int i = tid; i < 9 * 1024; i += 512) { const int b = i >> 10, k = i & 1023; const float v = (b < 8) ? c[b * 1024 + k] : cctx[k]; s[i] = silu_f(v); }
        __syncthreads();
        const int chunk = tid & 7, rg = tid >> 3, col = item * 32 + chunk * 4;
        f32x4 acc[9];
#pragma unroll
        for (int b = 0; b < 9; ++b) acc[b] = (f32x4){0.f, 0.f, 0.f, 0.f};
#pragma unroll 4
        for (int i = 0; i < 16; ++i) { const int r = rg + 64 * i; const f32x4 w = *(const f32x4*)(adaw + (size_t)r * 6144 + col);
#pragma unroll
            for (int b = 0; b < 9; ++b) acc[b] += w * s[b * 1024 + r]; }
#pragma unroll
        for (int b = 0; b < 9; ++b) *(LAS f32x4*)(red + (rg * 9 + b) * 32 + chunk * 4) = acc[b];
        __syncthreads();
        if (tid < 288) { const int b = tid >> 5, cc = tid & 31; float sum = 0.f;
            for (int r2 = 0; r2 < 64; ++r2) sum += red[(r2 * 9 + b) * 32 + cc];
            MODV[b * 6144 + item * 32 + cc] = sum + adab[item * 32 + cc]; }
        __syncthreads();
    }
}
__device__ __forceinline__ int win_dest(int n) {
    if (n < 1536) return n;
    int ch = n - GLU_COL0;
    if (ch < 512) return 1536 + 8 * (ch >> 2) + (ch & 3);
    ch -= 512; return 1536 + 8 * (ch >> 2) + 4 + (ch & 3);
}
template <int MODE>
__device__ __forceinline__ void transpose_item(const float* W, int ldw, int k0, int n0, bf16* WT, LAS float* scr, int lane) {
#pragma unroll 8
    for (int i = 0; i < 32; ++i) { const int kk = 2 * i + (lane >> 5); scr[kk * 33 + (lane & 31)] = W[(size_t)(k0 + kk) * ldw + n0 + (lane & 31)]; }
    asm volatile("s_waitcnt lgkmcnt(0)" ::: "memory");
    const int c = lane & 7;
#pragma unroll
    for (int j = 0; j < 4; ++j) { const int n = (lane >> 3) + 8 * j; const LAS float* sp = scr + (8 * c) * 33 + n;
        v4u o; o.x = pk2(sp[0 * 33], sp[1 * 33]); o.y = pk2(sp[2 * 33], sp[3 * 33]); o.z = pk2(sp[4 * 33], sp[5 * 33]); o.w = pk2(sp[6 * 33], sp[7 * 33]);
        const int row = (MODE == 1) ? win_dest(n0 + n) : (n0 + n);
        *(v4u*)(WT + (size_t)row * 1024 + k0 + 8 * c) = o; }
    asm volatile("s_waitcnt lgkmcnt(0)" ::: "memory");
}
__device__ __forceinline__ void p0_weights(const Args& A, LAS unsigned char* lds, int tid, int wave, int lane) {
    LAS float* scr = (LAS float*)(lds + wave * 16384);
    const int gw = blockIdx.x * 8 + wave, NGW = gridDim.x * 8;
    bf16* WIN = (bf16*)(A.ws + WS_WIN); bf16* WOUT = (bf16*)(A.ws + WS_WOUT);
    for (int it = gw; it < 80 * 16 + 32 * 16; it += NGW) {
        if (it < 80 * 16) { const int nb = it >> 4, kb = it & 15; const int n0 = nb < 48 ? 32 * nb : GLU_COL0 + 32 * (nb - 48);
            transpose_item<1>(A.in[I_WIN], IN_COLS, 64 * kb, n0, WIN, scr, lane); }
        else { const int r = it - 80 * 16; transpose_item<0>(A.in[I_WOUT], 1024, 64 * (r & 15), 32 * (r >> 4), WOUT, scr, lane); }
    }
    const float* pu = A.in[I_PU]; const float* pv = A.in[I_PV];
#if PEER_FP8
    for (int row = gw; row < 2 * NEXP; row += NGW) {
        const int r = row & (NEXP - 1); const bool isv = row >= NEXP;
        const float* src = (isv ? pv : pu) + (size_t)r * 1024 + 4 * lane;
        f32x4 v[4]; float am = 0.f;
#pragma unroll
        for (int j = 0; j < 4; ++j) { v[j] = *(const f32x4*)(src + 256 * j); am = fmaxf(am, fmaxf(fmaxf(fabsf(v[j][0]), fabsf(v[j][1])), fmaxf(fabsf(v[j][2]), fabsf(v[j][3])))); }
#pragma unroll
        for (int o = 1; o < 64; o <<= 1) am = fmaxf(am, __shfl_xor(am, o));
        const float inv = am > 0.f ? 440.f / am : 0.f;
        unsigned char* dst = A.ws + (isv ? WS_V : WS_U) + (size_t)r * 1024 + 4 * lane;
        if (isv) {
#pragma unroll
            for (int j = 0; j < 4; ++j) { int w = __builtin_amdgcn_cvt_pk_fp8_f32(v[j][0] * inv, v[j][1] * inv, 0, false); w = __builtin_amdgcn_cvt_pk_fp8_f32(v[j][2] * inv, v[j][3] * inv, w, true);
                *(unsigned*)(dst + 256 * j) = (unsigned)w; }
            if (lane == 0) ((float*)(A.ws + WS_VSC))[r] = am * (1.f / 440.f);
        } else {
            const float inv8 = am > 0.f ? 127.f / am : 0.f;
#pragma unroll
            for (int j = 0; j < 4; ++j) { const unsigned w = ((unsigned)__float2int_rn(v[j][0] * inv8) & 255u) | (((unsigned)__float2int_rn(v[j][1] * inv8) & 255u) << 8)
                                                        | (((unsigned)__float2int_rn(v[j][2] * inv8) & 255u) << 16) | (((unsigned)__float2int_rn(v[j][3] * inv8) & 255u) << 24);
                *(unsigned*)(dst + 256 * j) = w; }
            if (lane == 0) ((float*)(A.ws + WS_USC))[r] = am * (1.f / 127.f);
        }
    }
#else
    bf16* U = (bf16*)(A.ws + WS_U); bf16* V = (bf16*)(A.ws + WS_V);
    const size_t nthr = (size_t)gridDim.x * 512, gt = (size_t)blockIdx.x * 512 + tid;
    for (size_t i = gt; i < (size_t)NEXP * 1024 / 8; i += nthr) {
        const f32x4 a = *(const f32x4*)(pu + i * 8), b = *(const f32x4*)(pu + i * 8 + 4);
        v4u o; o.x = pk2(a[0], a[1]); o.y = pk2(a[2], a[3]); o.z = pk2(b[0], b[1]); o.w = pk2(b[2], b[3]); *(v4u*)(U + i * 8) = o;
        const f32x4 c2 = *(const f32x4*)(pv + i * 8), d2 = *(const f32x4*)(pv + i * 8 + 4);
        v4u q; q.x = pk2(c2[0], c2[1]); q.y = pk2(c2[2], c2[3]); q.z = pk2(d2[0], d2[1]); q.w = pk2(d2[2], d2[3]); *(v4u*)(V + i * 8) = q;
    }
#endif
}
__device__ __forceinline__ void p0_wc(const Args& A, LAS unsigned char* lds, int tid) {
    LAS float* wqs = (LAS float*)lds;
    LAS float* sks = (LAS float*)(lds + 32768);
    const float* wq = A.in[I_WQ]; const float* sk = A.in[I_SK]; bf16* WC = (bf16*)(A.ws + WS_WC);
    for (int item = blockIdx.x; item < 256; item += gridDim.x) {
        const int hp = item >> 4, k0 = (item & 15) * 64;
        __syncthreads();
        for (int i = tid; i < 64 * 32; i += 512) { const int kk = i >> 5, d4 = i & 31; *(LAS f32x4*)(wqs + kk * 128 + 4 * d4) = *(const f32x4*)(wq + (size_t)(k0 + kk) * 2048 + hp * 128 + 4 * d4); }
        for (int i = tid; i < 128 * 32; i += 512) { const int j = i >> 5, d4 = i & 31; *(LAS f32x4*)(sks + j * 132 + 4 * d4) = *(const f32x4*)(sk + (size_t)(hp * 128 + j) * 128 + 4 * d4); }
        __syncthreads();
        const int j = tid & 127, kq = tid >> 7;
        float acc[16];
#pragma unroll
        for (int i = 0; i < 16; ++i) acc[i] = 0.f;
        for (int d4 = 0; d4 < 32; ++d4) { const f32x4 sv = *(LAS f32x4*)(sks + j * 132 + 4 * d4);
#pragma unroll
            for (int i = 0; i < 16; ++i) { const f32x4 wv = *(LAS f32x4*)(wqs + (kq * 16 + i) * 128 + 4 * d4); acc[i] += sv[0] * wv[0] + sv[1] * wv[1] + sv[2] * wv[2] + sv[3] * wv[3]; } }
        v4u o0, o1; o0.x = pk2(acc[0], acc[1]); o0.y = pk2(acc[2], acc[3]); o0.z = pk2(acc[4], acc[5]); o0.w = pk2(acc[6], acc[7]);
        o1.x = pk2(acc[8], acc[9]); o1.y = pk2(acc[10], acc[11]); o1.z = pk2(acc[12], acc[13]); o1.w = pk2(acc[14], acc[15]);
        bf16* dst = WC + (size_t)(hp * 128 + j) * 1024 + k0 + kq * 16;
        *(v4u*)dst = o0; *(v4u*)(dst + 8) = o1;
    }
}

__device__ __forceinline__ void p1_norm(const Args& A, LAS unsigned char* lds, int tid, int wave, int lane, int wg0) {
    LAS float* wdt = (LAS float*)lds;
    const float* win = A.in[I_WIN];
    for (int i = tid; i < 16384; i += 512) { const int k = i >> 4, c = i & 15; wdt[c * 1024 + k] = win[(size_t)k * IN_COLS + DT_COL0 + c]; }
    __syncthreads();
    const float* x = A.in[I_X]; const float* ctx = A.in[I_CTX]; const float* n1w = A.in[I_N1W]; const float* dtb = A.in[I_DTB];
    float* MODV = (float*)(A.ws + WS_MODV); bf16* XN = (bf16*)(A.ws + WS_XN); float* DT = (float*)(A.ws + WS_DT);
    const int gw = ((int)blockIdx.x - wg0) * 8 + wave, NGW = ((int)gridDim.x - wg0) * 8;
    f32x4 nx[4];
    if (gw < MROWS) { const float* xr = gw < T ? x + (size_t)gw * 1024 : ctx + (size_t)(gw - T) * 1024;
#pragma unroll
        for (int j = 0; j < 4; ++j) nx[j] = *(const f32x4*)(xr + 4 * lane + 256 * j); }
    const int myc = 8 * ((lane >> 5) & 1) + 4 * ((lane >> 4) & 1) + 2 * ((lane >> 3) & 1) + (lane & 1);
    const float mybias = dtb[myc];
    for (int row = gw; row < MROWS; row += NGW) {
        const float* mp = MODV + (size_t)(row < T ? (row >> 12) : 8) * 6144;
        f32x4 v[4]; float ss = 0.f;
#pragma unroll
        for (int j = 0; j < 4; ++j) { v[j] = nx[j]; ss += v[j][0] * v[j][0] + v[j][1] * v[j][1] + v[j][2] * v[j][2] + v[j][3] * v[j][3]; }
        { const int rn = row + NGW < MROWS ? row + NGW : row;
          const float* xr = rn < T ? x + (size_t)rn * 1024 : ctx + (size_t)(rn - T) * 1024;
#pragma unroll
          for (int j = 0; j < 4; ++j) nx[j] = *(const f32x4*)(xr + 4 * lane + 256 * j); }
        const float rstd = rsqrtf(wave_sum(ss) * (1.f / 1024.f) + EPS);
#pragma unroll
        for (int j = 0; j < 4; ++j) { const int col = 4 * lane + 256 * j;
            const f32x4 nw = *(const f32x4*)(n1w + col), sh = *(const f32x4*)(mp + col), sc = *(const f32x4*)(mp + 1024 + col);
            v[j] = v[j] * rstd * nw * (sc + 1.f) + sh;
            v2u o; o.x = pk2(v[j][0], v[j][1]); o.y = pk2(v[j][2], v[j][3]); *(v2u*)(XN + (size_t)row * 1024 + col) = o; }
        float p[16];
#pragma unroll
        for (int c = 0; c < 16; ++c) { float q = 0.f;
            if ((c & 3) == 0) asm volatile("" ::: "memory");
#pragma unroll
            for (int j = 0; j < 4; ++j) { const f32x4 w4 = *(LAS f32x4*)(wdt + c * 1024 + 4 * lane + 256 * j); q += v[j][0] * w4[0] + v[j][1] * w4[1] + v[j][2] * w4[2] + v[j][3] * w4[3]; }
            p[c] = q; }
        wave_tsum16(p, lane);
        if ((lane & 6) == 0) DT[(size_t)row * 16 + myc] = softplus_f(((lane & 1) ? p[1] : p[0]) + mybias);
    }
}
constexpr int LROW = 272;
constexpr int XT_OFF = 0, BM_OFF = 17408, BT_OFF = 52224, CM_OFF = 87040, SCAL_OFF = 121856;
__device__ __forceinline__ float bfe(const v4u& v, int i) { const unsigned w = v[i >> 1]; return (i & 1) ? bfhi(w) : bflo(w); }
__device__ __forceinline__ pg8::f32x4 mfma16(const v4u& a, const v4u& b, const pg8::f32x4& c) {
    return __builtin_amdgcn_mfma_f32_16x16x32_bf16(__builtin_bit_cast(bf16x8, a), __builtin_bit_cast(bf16x8, b), c, 0, 0, 0); }

__device__ __forceinline__ void ssd_stage_kind(const Args& A, LAS unsigned char* lds, int kind, int h, int g, size_t row0, int t0, int L, int tid) {
    if (kind == 0 && tid >= 256) return;
    const bf16* XBC = (const bf16*)(A.ws + WS_XBC);
    const int pair = kind == 0 ? (tid & 31) : (tid & 63), sg = kind == 0 ? (tid >> 5) : (tid >> 6);
    const int nl = 2 * pair;
    const int gch = (kind == 0 ? 64 * h : (kind == 1 ? 512 + 128 * g : 768 + 128 * g)) + nl;
    const float* scw = A.in[I_SCW] + gch; const float* scb = A.in[I_SCB] + gch;
    float w0[5], w1[5];
#pragma unroll
    for (int k = 0; k < 5; ++k) { w0[k] = scw[k * 1024]; w1[k] = scw[k * 1024 + 1]; }
    const float b0 = scb[0], b1 = scb[1];
    float lo[20], hi[20];
#pragma unroll
    for (int i = 0; i < 20; ++i) { const int tl = t0 + 16 * sg - 2 + i;
        const unsigned raw = (tl >= 0 && tl < L) ? *(const unsigned*)(XBC + (row0 + tl) * 1024 + gch) : 0u;
        lo[i] = bflo(raw); hi[i] = bfhi(raw); }
    float s0[16], s1[16];
#pragma unroll
    for (int o = 0; o < 16; ++o) { float a0 = b0, a1 = b1;
#pragma unroll
        for (int k = 0; k < 5; ++k) { a0 += w0[k] * lo[o + k]; a1 += w1[k] * hi[o + k]; }
        s0[o] = silu_f(a0); s1[o] = silu_f(a1); }
    if (kind != 2) {
        LAS unsigned char* base = lds + (kind == 0 ? XT_OFF : BT_OFF) + nl * LROW + 32 * sg;
        v4u a, bb, c2, d2;
        a.x = pk2(s0[0], s0[1]); a.y = pk2(s0[2], s0[3]); a.z = pk2(s0[4], s0[5]); a.w = pk2(s0[6], s0[7]);
        bb.x = pk2(s0[8], s0[9]); bb.y = pk2(s0[10], s0[11]); bb.z = pk2(s0[12], s0[13]); bb.w = pk2(s0[14], s0[15]);
        c2.x = pk2(s1[0], s1[1]); c2.y = pk2(s1[2], s1[3]); c2.z = pk2(s1[4], s1[5]); c2.w = pk2(s1[6], s1[7]);
        d2.x = pk2(s1[8], s1[9]); d2.y = pk2(s1[10], s1[11]); d2.z = pk2(s1[12], s1[13]); d2.w = pk2(s1[14], s1[15]);
        *(LAS v4u*)base = a; *(LAS v4u*)(base + 16) = bb; *(LAS v4u*)(base + LROW) = c2; *(LAS v4u*)(base + LROW + 16) = d2;
    }
    if (kind != 0) {
        LAS unsigned char* base = lds + (kind == 1 ? BM_OFF : CM_OFF) + (16 * sg) * LROW + nl * 2;
#pragma unroll
        for (int o = 0; o < 16; ++o) *(LAS unsigned*)(base + o * LROW) = pk2(s0[o], s1[o]);
    }
}

__device__ __forceinline__ void ssd_stage_x(const Args& A, LAS unsigned char* lds, int h, size_t row0, int t0, int L, int tid) {
    const bf16* XBC = (const bf16*)(A.ws + WS_XBC);
    const int pair = tid & 31, sg = tid >> 5, nl = 2 * pair, gch = 64 * h + nl;
    const float* scw = A.in[I_SCW] + gch; const float* scb = A.in[I_SCB] + gch;
    float w0[5], w1[5];
#pragma unroll
    for (int k = 0; k < 5; ++k) { w0[k] = scw[k * 1024]; w1[k] = scw[k * 1024 + 1]; }
    const float b0 = scb[0], b1 = scb[1];
    float lo[12], hi[12];
#pragma unroll
    for (int i = 0; i < 12; ++i) { const int tl = t0 + 8 * sg - 2 + i;
        const unsigned raw = (tl >= 0 && tl < L) ? *(const unsigned*)(XBC + (row0 + tl) * 1024 + gch) : 0u;
        lo[i] = bflo(raw); hi[i] = bfhi(raw); }
    float s0[8], s1[8];
#pragma unroll
    for (int o = 0; o < 8; ++o) { float a0 = b0, a1 = b1;
#pragma unroll
        for (int k = 0; k < 5; ++k) { a0 += w0[k] * lo[o + k]; a1 += w1[k] * hi[o + k]; }
        s0[o] = silu_f(a0); s1[o] = silu_f(a1); }
    LAS unsigned char* base = lds + XT_OFF + nl * LROW + 16 * sg;
    v4u a, c2;
    a.x = pk2(s0[0], s0[1]); a.y = pk2(s0[2], s0[3]); a.z = pk2(s0[4], s0[5]); a.w = pk2(s0[6], s0[7]);
    c2.x = pk2(s1[0], s1[1]); c2.y = pk2(s1[2], s1[3]); c2.z = pk2(s1[4], s1[5]); c2.w = pk2(s1[6], s1[7]);
    *(LAS v4u*)base = a; *(LAS v4u*)(base + LROW) = c2;
}

__device__ __forceinline__ void ssd_local_item(const Args& A, LAS unsigned char* lds, int item, int tid, int wave, int lane) {
    int b, cc, g;
    if (item < NB * 32 * 2) { b = item >> 6; cc = 2 + ((item >> 1) & 31); g = item & 1; }
    else { const int j = item - NB * 32 * 2; b = j >> 2; cc = (j >> 1) & 1; g = j & 1; }
    const bool is_ctx = cc < 2; const int L = is_ctx ? CTXL : SEQ, c = is_ctx ? cc : cc - 2;
    const size_t row0 = is_ctx ? (size_t)T + (size_t)b * CTXL : (size_t)b * SEQ; const int t0 = c * 128;
    float* DT = (float*)(A.ws + WS_DT);
    LAS float* csf = (LAS float*)(lds + SCAL_OFF); LAS float* csb = csf + 128; LAS float* dtf = csf + 256; LAS float* dtb = csf + 384;
    const int fr = lane & 15, fq = lane >> 4;
    __syncthreads();
    ssd_stage_kind(A, lds, 1, 0, g, row0, t0, L, tid);
    if (!is_ctx) ssd_stage_kind(A, lds, 2, 0, g, row0, t0, L, tid);
    __syncthreads();
    if (!is_ctx) {
        v4u cf[4];
#pragma unroll
        for (int ks = 0; ks < 4; ++ks) cf[ks] = *(const LAS v4u*)(lds + CM_OFF + (16 * wave + fr) * LROW + (32 * ks + 8 * fq) * 2);
        pg8::f32x4 acc[8];
#pragma unroll
        for (int j = 0; j < 8; ++j) { acc[j] = (pg8::f32x4){0.f, 0.f, 0.f, 0.f};
#pragma unroll
            for (int ks = 0; ks < 4; ++ks) { const v4u bfv = *(const LAS v4u*)(lds + BM_OFF + (16 * j + fr) * LROW + (32 * ks + 8 * fq) * 2); acc[j] = mfma16(bfv, cf[ks], acc[j]); } }
        __syncthreads();
#pragma unroll
        for (int j = 0; j < 8; ++j) { v2u w; w.x = pk2(acc[j][0], acc[j][1]); w.y = pk2(acc[j][2], acc[j][3]);
            *(LAS v2u*)(lds + BM_OFF + (16 * wave + fr) * LROW + (16 * j + 4 * fq) * 2) = w; }
        bf16* CC = (bf16*)(A.ws + WS_CCONV);
        for (int i = tid; i < 128 * 16; i += 512) { const int r = i >> 4, c8 = i & 15;
            *(v4u*)(CC + (row0 + t0 + r) * 256 + g * 128 + c8 * 8) = *(const LAS v4u*)(lds + CM_OFF + r * LROW + c8 * 16); }
    }
#pragma unroll 1
    for (int hl = 0; hl < 4; ++hl) {
        const int h = 4 * g + hl;
        __syncthreads();
        if (wave == 5) {
            const float Af = -__expf(A.in[I_ALOG][h]);
            const float* dtp = DT + (row0 + t0) * 16 + h;
            const float d0 = dtp[(2 * lane) * 16], d1 = dtp[(2 * lane + 1) * 16];
            const float a0 = d0 * Af, x = a0 + d1 * Af; float incl = x;
#pragma unroll
            for (int o = 1; o < 64; o <<= 1) { const float v = __shfl_up(incl, o); if (lane >= o) incl += v; }
            const float excl = incl - x;
            csf[2 * lane] = excl + a0; csf[2 * lane + 1] = incl; dtf[2 * lane] = d0; dtf[2 * lane + 1] = d1;
            if (lane == 63) ((float*)(A.ws + WS_DEC))[((size_t)(b * NCC + cc) * 8 + h) * 2 + 0] = __expf(incl);
            if (!is_ctx) { float* CS = (float*)(A.ws + WS_CS) + (((size_t)(b * 32 + c) * 8 + h) * 2 + 0) * 128; CS[2 * lane] = excl + a0; CS[2 * lane + 1] = incl; }
        } else if (wave == 6) {
            const float Ab = -__expf(A.in[I_ALOG][8 + h]);
            const float* dtp = DT + (row0 + t0) * 16 + 8 + h;
            const float d0 = dtp[(2 * lane) * 16], d1 = dtp[(2 * lane + 1) * 16];
            const float a1 = d1 * Ab, x = d0 * Ab + a1; float incl = x;
#pragma unroll
            for (int o = 1; o < 64; o <<= 1) { const float v = __shfl_down(incl, o); if (lane + o < 64) incl += v; }
            const float excl = incl - x;
            csb[2 * lane + 1] = excl + a1; csb[2 * lane] = incl; dtb[2 * lane] = d0; dtb[2 * lane + 1] = d1;
            if (lane == 0) ((float*)(A.ws + WS_DEC))[((size_t)(b * NCC + cc) * 8 + h) * 2 + 1] = __expf(incl);
            if (!is_ctx) { float* CS = (float*)(A.ws + WS_CS) + (((size_t)(b * 32 + c) * 8 + h) * 2 + 1) * 128; CS[2 * lane + 1] = excl + a1; CS[2 * lane] = incl; }
        }
        ssd_stage_x(A, lds, h, row0, t0, L, tid);
        __syncthreads();
        if (!is_ctx) {
            const float Dh = A.in[I_SSD][h]; const int l = 16 * wave + fr; const float csfl = csf[l], csbl = csb[l];
            pg8::f32x4 yacc[4];
#pragma unroll
            for (int j = 0; j < 4; ++j) yacc[j] = (pg8::f32x4){0.f, 0.f, 0.f, 0.f};
#pragma unroll 2
            for (int ks = 0; ks < 4; ++ks) { const int s0 = 32 * ks + 8 * fq;
                const v4u g4 = *(const LAS v4u*)(lds + BM_OFF + l * LROW + s0 * 2);
                const f32x4 cfa = *(const LAS f32x4*)(csf + s0), cfb = *(const LAS f32x4*)(csf + s0 + 4), cba = *(const LAS f32x4*)(csb + s0), cbb = *(const LAS f32x4*)(csb + s0 + 4);
                const f32x4 dfa = *(const LAS f32x4*)(dtf + s0), dfb = *(const LAS f32x4*)(dtf + s0 + 4), dba = *(const LAS f32x4*)(dtb + s0), dbb = *(const LAS f32x4*)(dtb + s0 + 4);
                float m[8];
#pragma unroll
                for (int i = 0; i < 8; ++i) { const int s = s0 + i;
                    const float cfs = i < 4 ? cfa[i & 3] : cfb[i & 3], cbs = i < 4 ? cba[i & 3] : cbb[i & 3], dfs = i < 4 ? dfa[i & 3] : dfb[i & 3], dbs = i < 4 ? dba[i & 3] : dbb[i & 3];
                    const float arg = (s < l) ? csfl - cfs : csbl - cbs; const float dtv = (s < l) ? dfs : dbs;
                    float w = __expf(arg) * dtv; w = (s == l) ? dfs + dbs : w;
                    m[i] = bfe(g4, i) * w + ((s == l) ? Dh : 0.f); }
                v4u mf; mf.x = pk2(m[0], m[1]); mf.y = pk2(m[2], m[3]); mf.z = pk2(m[4], m[5]); mf.w = pk2(m[6], m[7]);
#pragma unroll
                for (int j = 0; j < 4; ++j) { const v4u af = *(const LAS v4u*)(lds + XT_OFF + (16 * j + fr) * LROW + s0 * 2); yacc[j] = mfma16(af, mf, yacc[j]); } }
            LAS unsigned char* st = lds + CM_OFF + wave * 4352;
#pragma unroll
            for (int j = 0; j < 4; ++j) { v2u w; w.x = pk2(yacc[j][0], yacc[j][1]); w.y = pk2(yacc[j][2], yacc[j][3]); *(LAS v2u*)(st + fr * 144 + (16 * j + 4 * fq) * 2) = w; }
            bf16* YD = (bf16*)(A.ws + WS_YD) + (row0 + t0 + 16 * wave) * 512 + 64 * h;
#pragma unroll
            for (int q = 0; q < 2; ++q) { const int r = 8 * q + (lane >> 3), ch = lane & 7; *(v4u*)(YD + (size_t)r * 512 + ch * 8) = *(const LAS v4u*)(st + r * 144 + ch * 16); }
        }
        {
            const int dir = wave >> 2, p = 16 * (wave & 3) + fr; LAS float* cs = dir ? csb : csf; LAS float* dtv = dir ? dtb : dtf;
            const float cend = dir ? csb[0] : csf[127];
            pg8::f32x4 sacc[8];
#pragma unroll
            for (int j = 0; j < 8; ++j) sacc[j] = (pg8::f32x4){0.f, 0.f, 0.f, 0.f};
#pragma unroll 2
            for (int ks = 0; ks < 4; ++ks) { const int s0 = 32 * ks + 8 * fq;
                const v4u x4 = *(const LAS v4u*)(lds + XT_OFF + p * LROW + s0 * 2);
                const f32x4 ca = *(const LAS f32x4*)(cs + s0), cb = *(const LAS f32x4*)(cs + s0 + 4), da = *(const LAS f32x4*)(dtv + s0), db = *(const LAS f32x4*)(dtv + s0 + 4);
                float m[8];
#pragma unroll
                for (int i = 0; i < 8; ++i) m[i] = bfe(x4, i) * (__expf(cend - (i < 4 ? ca[i & 3] : cb[i & 3])) * (i < 4 ? da[i & 3] : db[i & 3]));
                v4u xf; xf.x = pk2(m[0], m[1]); xf.y = pk2(m[2], m[3]); xf.z = pk2(m[4], m[5]); xf.w = pk2(m[6], m[7]);
#pragma unroll
                for (int j = 0; j < 8; ++j) { const v4u af = *(const LAS v4u*)(lds + BT_OFF + (16 * j + fr) * LROW + s0 * 2); sacc[j] = mfma16(af, xf, sacc[j]); } }
            LAS unsigned char* st = lds + CM_OFF + wave * 4352;
#pragma unroll
            for (int j = 0; j < 8; ++j) { v2u w; w.x = pk2(sacc[j][0], sacc[j][1]); w.y = pk2(sacc[j][2], sacc[j][3]); *(LAS v2u*)(st + fr * 272 + (16 * j + 4 * fq) * 2) = w; }
            bf16* SL = (bf16*)(A.ws + WS_SLOC) + ((((size_t)(b * NCC + cc) * 8 + h) * 2 + dir) * 64 + 16 * (wave & 3)) * 128;
#pragma unroll
            for (int q = 0; q < 4; ++q) { const int r = 4 * q + (lane >> 4), ch = lane & 15; *(v4u*)(SL + (size_t)r * 128 + ch * 8) = *(const LAS v4u*)(st + r * 272 + ch * 16); }
        }
    }
}

__device__ __forceinline__ void cfm_conv_item(const Args& A, int item, int tid) {
    const int line = item & 63, dir = (item >> 6) & 1, b = item >> 7;
    const int seg = tid >> 7, cp = tid & 127, ch = 256 * dir + 2 * cp;
    const bf16* UG = (const bf16*)(A.ws + WS_UGLU) + (size_t)b * SEQ * 512 + ch;
    const int tstride = dir ? 64 : 1, tbase = dir ? line : line * 64;
    unsigned raw[46];
#pragma unroll
    for (int ii = 0; ii < 46; ++ii) { const int pos = 16 * seg - 15 + ii;
        raw[ii] = (pos >= 0 && pos < 64) ? *(const unsigned*)(UG + (size_t)(tbase + pos * tstride) * 512) : 0u; }
    const float* ccw = A.in[I_CCW] + ch; const float* ccb = A.in[I_CCB] + ch;
    float w0[31], w1[31];
#pragma unroll
    for (int k = 0; k < 31; ++k) { w0[k] = ccw[k * 512]; w1[k] = ccw[k * 512 + 1]; }
    float a0[16], a1[16];
#pragma unroll
    for (int o = 0; o < 16; ++o) { a0[o] = ccb[0]; a1[o] = ccb[1]; }
#pragma unroll
    for (int ii = 0; ii < 46; ++ii) { const float lo = bflo(raw[ii]), hi = bfhi(raw[ii]);
#pragma unroll
        for (int o = 0; o < 16; ++o) { const int k = ii - o; if (k >= 0 && k <= 30) { a0[o] += w0[k] * lo; a1[o] += w1[k] * hi; } } }
    bf16* CO = (bf16*)(A.ws + WS_CONVO) + (size_t)b * SEQ * 512 + ch;
#pragma unroll
    for (int o = 0; o < 16; ++o) *(unsigned*)(CO + (size_t)(tbase + (16 * seg + o) * tstride) * 512) = pk2(a0[o], a1[o]);
}

__device__ __forceinline__ void p4_recur(const Args& A, int tid) {
    bf16* SLOC = (bf16*)(A.ws + WS_SLOC); float* DEC = (float*)(A.ws + WS_DEC);
    const int nthr = gridDim.x * 512;
    for (int idx = blockIdx.x * 512 + tid; idx < NB * 8 * 2 * 64 * 32; idx += nthr) {
        const int n4 = idx & 31, p = (idx >> 5) & 63, dir = (idx >> 11) & 1, h = (idx >> 12) & 7, b = idx >> 15;
        float S0 = 0.f, S1 = 0.f, S2 = 0.f, S3 = 0.f;
#pragma unroll 1
        for (int half = 0; half < 2; ++half) {
            v2u loc[17]; float dec[17];
#pragma unroll
            for (int s = 0; s < 17; ++s) { const int step = 17 * half + s;
                const int cc = dir == 0 ? step : (step < 2 ? 1 - step : 35 - step);
                const size_t slot = ((size_t)(b * NCC + cc) * 8 + h) * 2 + dir;
                loc[s] = *(const v2u*)(SLOC + slot * 8192 + p * 128 + 4 * n4); dec[s] = DEC[slot]; }
#pragma unroll
            for (int s = 0; s < 17; ++s) { const int step = 17 * half + s;
                const int cc = dir == 0 ? step : (step < 2 ? 1 - step : 35 - step);
                const size_t slot = ((size_t)(b * NCC + cc) * 8 + h) * 2 + dir;
                if (cc >= 2) { v2u o; o.x = pk2(S0, S1); o.y = pk2(S2, S3); *(v2u*)(SLOC + slot * 8192 + p * 128 + 4 * n4) = o; }
                S0 = dec[s] * S0 + bflo(loc[s].x); S1 = dec[s] * S1 + bfhi(loc[s].x); S2 = dec[s] * S2 + bflo(loc[s].y); S3 = dec[s] * S3 + bfhi(loc[s].y); }
        }
    }
}
__device__ __forceinline__ void ssd_out_item(const Args& A, LAS unsigned char* lds, int item, int tid, int wave, int lane) {
    const int g = item & 1, c = (item >> 1) & 31, b = item >> 6;
    LAS float* ECS = (LAS float*)(lds + 34816);
    LAS float* RED = (LAS float*)(lds + 38912);
    const size_t row0 = (size_t)b * SEQ + c * 128;
    const int fr = lane & 15, fq = lane >> 4;
    __syncthreads();
    { const bf16* CC = (const bf16*)(A.ws + WS_CCONV);
      for (int i = tid; i < 128 * 16; i += 512) { const int r = i >> 4, c8 = i & 15;
          *(LAS v4u*)(lds + r * LROW + c8 * 16) = *(const v4u*)(CC + (row0 + r) * 256 + g * 128 + c8 * 8); }
      const float* CS = (const float*)(A.ws + WS_CS) + ((size_t)(b * 32 + c) * 8 + 4 * g) * 256;
      for (int i = tid; i < 1024; i += 512) ECS[i] = __expf(CS[i]); }
    __syncthreads();
    const int hl = wave >> 1, ph = wave & 1, h = 4 * g + hl;
    v4u sf[2][2][4];
#pragma unroll
    for (int dir = 0; dir < 2; ++dir) { const bf16* SL = (const bf16*)(A.ws + WS_SLOC) + (((size_t)(b * NCC + c + 2) * 8 + h) * 2 + dir) * 8192;
#pragma unroll
        for (int jt = 0; jt < 2; ++jt)
#pragma unroll
            for (int ks = 0; ks < 4; ++ks) sf[dir][jt][ks] = *(const v4u*)(SL + (32 * ph + 16 * jt + fr) * 128 + 32 * ks + 8 * fq); }
    const bf16* YD = (const bf16*)(A.ws + WS_YD); const bf16* ZS = (const bf16*)(A.ws + WS_ZS);
    const int chb = 256 * g + 64 * hl + 32 * ph + 4 * fq;
    const float* snw = A.in[I_SNW]; bf16* A2 = (bf16*)(A.ws + WS_XN);
    f32x4 nw[2];
#pragma unroll
    for (int jt = 0; jt < 2; ++jt) nw[jt] = *(const f32x4*)(snw + chb + 16 * jt);
#pragma unroll 1
    for (int half = 0; half < 2; ++half) {
        float gv[4][2][4]; float ssq[4];
#pragma unroll
        for (int l4 = 0; l4 < 4; ++l4) { const int lt = 4 * half + l4;
            v4u cfr[4];
#pragma unroll
            for (int ks = 0; ks < 4; ++ks) cfr[ks] = *(const LAS v4u*)(lds + (16 * lt + fr) * LROW + (32 * ks + 8 * fq) * 2);
            pg8::f32x4 af[2], ab[2];
#pragma unroll
            for (int jt = 0; jt < 2; ++jt) { af[jt] = (pg8::f32x4){0.f, 0.f, 0.f, 0.f}; ab[jt] = (pg8::f32x4){0.f, 0.f, 0.f, 0.f};
#pragma unroll
                for (int ks = 0; ks < 4; ++ks) { af[jt] = mfma16(sf[0][jt][ks], cfr[ks], af[jt]); ab[jt] = mfma16(sf[1][jt][ks], cfr[ks], ab[jt]); } }
            const int l = 16 * lt + fr; const float ef = ECS[(hl * 2 + 0) * 128 + l], eb = ECS[(hl * 2 + 1) * 128 + l];
            float sq = 0.f;
#pragma unroll
            for (int jt = 0; jt < 2; ++jt) { const size_t o = (row0 + l) * 512 + chb + 16 * jt;
                const v2u yd = *(const v2u*)(YD + o), zs = *(const v2u*)(ZS + o);
                const float y0 = ef * af[jt][0] + eb * ab[jt][0] + bflo(yd.x), y1 = ef * af[jt][1] + eb * ab[jt][1] + bfhi(yd.x);
                const float y2 = ef * af[jt][2] + eb * ab[jt][2] + bflo(yd.y), y3 = ef * af[jt][3] + eb * ab[jt][3] + bfhi(yd.y);
                gv[l4][jt][0] = y0 * bflo(zs.x); gv[l4][jt][1] = y1 * bfhi(zs.x); gv[l4][jt][2] = y2 * bflo(zs.y); gv[l4][jt][3] = y3 * bfhi(zs.y);
#pragma unroll
                for (int r = 0; r < 4; ++r) sq += gv[l4][jt][r] * gv[l4][jt][r]; }
            sq += __shfl_xor(sq, 16); sq += __shfl_xor(sq, 32); ssq[l4] = sq;
        }
        __syncthreads();
        if (fq == 0) {
#pragma unroll
            for (int l4 = 0; l4 < 4; ++l4) RED[wave * 64 + 16 * l4 + fr] = ssq[l4]; }
        __syncthreads();
#pragma unroll
        for (int l4 = 0; l4 < 4; ++l4) { const int l = 16 * (4 * half + l4) + fr; float tot = 0.f;
#pragma unroll
            for (int w = 0; w < 8; ++w) tot += RED[w * 64 + 16 * l4 + fr];
            const float rstd = rsqrtf(tot * (1.f / 256.f) + EPS);
#pragma unroll
            for (int jt = 0; jt < 2; ++jt) { v2u o; o.x = pk2(gv[l4][jt][0] * rstd * nw[jt][0], gv[l4][jt][1] * rstd * nw[jt][1]); o.y = pk2(gv[l4][jt][2] * rstd * nw[jt][2], gv[l4][jt][3] * rstd * nw[jt][3]);
                *(v2u*)(A2 + (row0 + l) * 1024 + chb + 16 * jt) = o; } }
    }
}
__device__ __forceinline__ void cfm_ln_rows(const Args& A, int wave, int lane) {
    const bf16* CO = (const bf16*)(A.ws + WS_CONVO); bf16* A2 = (bf16*)(A.ws + WS_XN);
    const float* clw = A.in[I_CLW] + 8 * lane; const float* clb = A.in[I_CLB] + 8 * lane;
    const f32x4 w0 = *(const f32x4*)clw, w1 = *(const f32x4*)(clw + 4), b0 = *(const f32x4*)clb, b1 = *(const f32x4*)(clb + 4);
    const int gw = blockIdx.x * 8 + wave, NGW = gridDim.x * 8;
    for (int t = gw; t < T; t += NGW) {
        const v4u raw = *(const v4u*)(CO + (size_t)t * 512 + 8 * lane);
        float v[8]; float s = 0.f;
#pragma unroll
        for (int i = 0; i < 8; ++i) { v[i] = bfe(raw, i); s += v[i]; }
        const float mean = wave_sum(s) * (1.f / 512.f); float s2 = 0.f;
#pragma unroll
        for (int i = 0; i < 8; ++i) { v[i] -= mean; s2 += v[i] * v[i]; }
        const float rstd = rsqrtf(wave_sum(s2) * (1.f / 512.f) + EPS);
        float o[8];
#pragma unroll
        for (int i = 0; i < 8; ++i) o[i] = silu_f(v[i] * rstd * (i < 4 ? w0[i & 3] : w1[i & 3]) + (i < 4 ? b0[i & 3] : b1[i & 3]));
        v4u q; q.x = pk2(o[0], o[1]); q.y = pk2(o[2], o[3]); q.z = pk2(o[4], o[5]); q.w = pk2(o[6], o[7]);
        *(v4u*)(A2 + (size_t)t * 1024 + 512 + 8 * lane) = q;
    }
}

__device__ __forceinline__ void p7_norm2(const Args& A, int wave, int lane) {
    const bf16* X1 = (const bf16*)(A.ws + WS_X1B); const float* n2w = A.in[I_N2W]; float* MODV = (float*)(A.ws + WS_MODV); bf16* XN = (bf16*)(A.ws + WS_XN);
    const int gw = blockIdx.x * 8 + wave, NGW = gridDim.x * 8;
    v4u nx[2];
    if (gw < T) { nx[0] = *(const v4u*)(X1 + x1b_off(gw, 8 * lane)); nx[1] = *(const v4u*)(X1 + x1b_off(gw, 512 + 8 * lane)); }
    for (int row = gw; row < T; row += NGW) {
        const float* mp = MODV + (size_t)(row >> 12) * 6144;
        float v[16]; float ss = 0.f;
#pragma unroll
        for (int j = 0; j < 4; ++j) { v[2 * j] = bflo(nx[0][j]); v[2 * j + 1] = bfhi(nx[0][j]); v[8 + 2 * j] = bflo(nx[1][j]); v[8 + 2 * j + 1] = bfhi(nx[1][j]); }
#pragma unroll
        for (int i = 0; i < 16; ++i) ss += v[i] * v[i];
        { const int rn = row + NGW < T ? row + NGW : row;
          nx[0] = *(const v4u*)(X1 + x1b_off(rn, 8 * lane)); nx[1] = *(const v4u*)(X1 + x1b_off(rn, 512 + 8 * lane)); }
        const float rstd = rsqrtf(wave_sum(ss) * (1.f / 1024.f) + EPS);
#pragma unroll
        for (int hf = 0; hf < 2; ++hf) { const int col = 512 * hf + 8 * lane; float hv[8];
#pragma unroll
            for (int q = 0; q < 2; ++q) { const f32x4 nw = *(const f32x4*)(n2w + col + 4 * q), sh = *(const f32x4*)(mp + 3 * 1024 + col + 4 * q), sc = *(const f32x4*)(mp + 4 * 1024 + col + 4 * q);
#pragma unroll
                for (int i = 0; i < 4; ++i) hv[4 * q + i] = v[8 * hf + 4 * q + i] * rstd * nw[i] * (sc[i] + 1.f) + sh[i]; }
            v4u o; o.x = pk2(hv[0], hv[1]); o.y = pk2(hv[2], hv[3]); o.z = pk2(hv[4], hv[5]); o.w = pk2(hv[6], hv[7]);
            *(v4u*)(XN + (size_t)row * 1024 + col) = o; }
    }
}
constexpr int PEER_RV = PEER_FP8 ? 1 : 2;
__device__ __forceinline__ unsigned fkey(float s) { const unsigned u = __builtin_bit_cast(unsigned, s); return (u & 0x80000000u) ? ~u : (u | 0x80000000u); }
__device__ __forceinline__ float fkey_inv(unsigned k) { const unsigned u = (k & 0x80000000u) ? (k & 0x7fffffffu) : ~k; return __builtin_bit_cast(float, u); }
__device__ __forceinline__ unsigned umax_(unsigned a, unsigned b) { return a > b ? a : b; }
template <int CTRL> __device__ __forceinline__ unsigned dppu(unsigned x) { return (unsigned)__builtin_amdgcn_mov_dpp((int)x, CTRL, 0xf, 0xf, true); }
__device__ __forceinline__ unsigned allmax16(unsigned m) { m = umax_(m, dppu<0xB1>(m)); m = umax_(m, dppu<0x4E>(m)); m = umax_(m, dppu<0x141>(m)); m = umax_(m, dppu<0x140>(m)); return m; }
__device__ __forceinline__ unsigned allmax32(unsigned m) { m = allmax16(m); auto s = __builtin_amdgcn_permlane16_swap(m, m, false, false); const unsigned s0 = s[0], s1 = s[1]; return umax_(s0, s1); }
__device__ __forceinline__ unsigned allmax64(unsigned m) { m = allmax32(m); auto s = __builtin_amdgcn_permlane32_swap(m, m, false, false); const unsigned s0 = s[0], s1 = s[1]; return umax_(s0, s1); }
__device__ __forceinline__ float allmaxf16(float m) { m = fmaxf(m, dppf<0xB1>(m)); m = fmaxf(m, dppf<0x4E>(m)); m = fmaxf(m, dppf<0x141>(m)); m = fmaxf(m, dppf<0x140>(m)); return m; }
__device__ __forceinline__ float dot2bf(unsigned a, unsigned b, float acc) { return __builtin_amdgcn_fdot2_f32_bf16(__builtin_bit_cast(bf16x2_t, a), __builtin_bit_cast(bf16x2_t, b), acc, false); }

struct PeerRow { v4u r[PEER_RV]; };
__device__ __forceinline__ PeerRow peer_load(const unsigned char* tab, unsigned e, int lane) {
    PeerRow o; const unsigned char* p = tab + (size_t)e * (PEER_FP8 ? 1024 : 2048) + 16 * lane;
    o.r[0] = *(const v4u*)p;
    if (!PEER_FP8) o.r[PEER_RV - 1] = *(const v4u*)(p + 1024);
    return o;
}
__device__ __forceinline__ float peer_dot(const PeerRow& w, const unsigned (&xp)[8], const float (&xf)[16]) {
    if (PEER_FP8) {
        f32x2 a0 = {0.f, 0.f}, a1 = {0.f, 0.f};
#pragma unroll
        for (int j = 0; j < 4; ++j) { const f32x2 lo = __builtin_amdgcn_cvt_pk_f32_fp8((int)w.r[0][j], false), hi = __builtin_amdgcn_cvt_pk_f32_fp8((int)w.r[0][j], true);
            a0 += lo * (f32x2){xf[4 * j], xf[4 * j + 1]}; a1 += hi * (f32x2){xf[4 * j + 2], xf[4 * j + 3]}; }
        return (a0.x + a0.y) + (a1.x + a1.y);
    } else {
        float s0 = 0.f, s1 = 0.f;
#pragma unroll
        for (int j = 0; j < 4; ++j) { s0 = dot2bf(w.r[0][j], xp[j], s0); s1 = dot2bf(w.r[PEER_RV - 1][j], xp[4 + j], s1); }
        return s0 + s1;
    }
}
__device__ __forceinline__ void peer_axpy(const PeerRow& w, float c, f32x2 (&acc)[8]) {
    const f32x2 cc = {c, c};
    if (PEER_FP8) {
#pragma unroll
        for (int j = 0; j < 4; ++j) { acc[2 * j] += cc * __builtin_amdgcn_cvt_pk_f32_fp8((int)w.r[0][j], false); acc[2 * j + 1] += cc * __builtin_amdgcn_cvt_pk_f32_fp8((int)w.r[0][j], true); }
    } else {
#pragma unroll
        for (int j = 0; j < 4; ++j) { acc[j] += cc * (f32x2){bflo(w.r[0][j]), bfhi(w.r[0][j])}; acc[4 + j] += cc * (f32x2){bflo(w.r[PEER_RV - 1][j]), bfhi(w.r[PEER_RV - 1][j])}; }
    }
}

__device__ __forceinline__ unsigned umin_(unsigned a, unsigned b) { return a < b ? a : b; }
template <int N> __device__ __forceinline__ void bitonic_sort_desc(unsigned (&a)[N]) {
#pragma unroll
    for (int k = 2; k <= N; k <<= 1)
#pragma unroll
        for (int j = k >> 1; j > 0; j >>= 1)
#pragma unroll
            for (int i = 0; i < N; ++i) { const int l = i ^ j; if (l > i) { const unsigned mx = umax_(a[i], a[l]), mn = umin_(a[i], a[l]); const bool up = (i & k) == 0; a[i] = up ? mx : mn; a[l] = up ? mn : mx; } }
}
template <int N> __device__ __forceinline__ void bitonic_merge_desc(unsigned (&a)[N]) {
#pragma unroll
    for (int j = N >> 1; j > 0; j >>= 1)
#pragma unroll
        for (int i = 0; i < N; ++i) { const int l = i ^ j; if (l > i) { const unsigned mx = umax_(a[i], a[l]), mn = umin_(a[i], a[l]); a[i] = mx; a[l] = mn; } }
}
__device__ __forceinline__ void top16_merge(unsigned (&t)[16], const unsigned (&g)[16]) {
#pragma unroll
    for (int i = 0; i < 16; ++i) t[i] = umax_(t[i], g[15 - i]);
    bitonic_merge_desc<16>(t);
}
__device__ __forceinline__ void top16_of_128(const _Float16* col  , unsigned (&t)[16]) {
    _Float16 nx[16];
#pragma unroll
    for (int i = 0; i < 16; ++i) nx[i] = col[i * 32];
#pragma unroll 1
    for (int g = 0; g < 8; ++g) { unsigned q[16];
#pragma unroll
        for (int i = 0; i < 16; ++i) q[i] = (fkey((float)nx[i]) & ~127u) | (unsigned)(127 - 16 * g - i);
        { const int gn = g < 7 ? g + 1 : 7;
#pragma unroll
          for (int i = 0; i < 16; ++i) nx[i] = col[(size_t)gn * (T / 32) * 512 + i * 32]; }
        bitonic_sort_desc<16>(q);
        if (g == 0) {
#pragma unroll
            for (int i = 0; i < 16; ++i) t[i] = q[i];
        } else top16_merge(t, q); }
}
__host__ __device__ constexpr int stair_r1(int idx) {
    const int th[15] = {16, 24, 29, 33, 36, 38, 40, 42, 43, 44, 45, 46, 47, 48, 49}; int r = 0; for (int i = 0; i < 15; ++i) r += (idx >= th[i]) ? 1 : 0; return r; }
__host__ __device__ constexpr int stair_r2(int idx) {
    const int st[16] = {0, 16, 24, 29, 33, 36, 38, 40, 42, 43, 44, 45, 46, 47, 48, 49}; return idx - st[stair_r1(idx)]; }
__device__ __forceinline__ void p9_select_init(LAS unsigned char* lds, int tid) {
    LAS unsigned* TAB = (LAS unsigned*)(lds + 65536);
    if (tid < 64) { const int idx = tid < 50 ? tid : 49; int r1 = 0; const int th[15] = {16, 24, 29, 33, 36, 38, 40, 42, 43, 44, 45, 46, 47, 48, 49};
#pragma unroll
        for (int i = 0; i < 15; ++i) r1 += (idx >= th[i]) ? 1 : 0;
        const int st[16] = {0, 16, 24, 29, 33, 36, 38, 40, 42, 43, 44, 45, 46, 47, 48, 49}; int s0 = 0;
#pragma unroll
        for (int i = 0; i < 16; ++i) s0 = (r1 == i) ? st[i] : s0;
        TAB[tid] = (unsigned)r1 | ((unsigned)(idx - s0) << 8); }
}
__device__ __forceinline__ void p9_select_one(const Args& A, LAS unsigned char* lds, int tid, int token, int h) {
    const _Float16* SCT = (const _Float16*)(A.ws + WS_SC); unsigned* EIDX = (unsigned*)(A.ws + WS_EIDX); float* GATE = (float*)(A.ws + WS_GATE);
    LAS unsigned* KL = (LAS unsigned*)lds;
    LAS unsigned* TAB = (LAS unsigned*)(lds + 65536);
    {
        unsigned k1[16], k2[16];
        top16_of_128(SCT + ((size_t)(2 * h) * 8 * (T / 32) + (token >> 5)) * 512 + (token & 31), k1);
        top16_of_128(SCT + ((size_t)(2 * h + 1) * 8 * (T / 32) + (token >> 5)) * 512 + (token & 31), k2);
        float v1[16], v2[16];
#pragma unroll
        for (int i = 0; i < 16; ++i) { KL[i * 512 + tid] = k1[i]; KL[(16 + i) * 512 + tid] = k2[i]; v1[i] = fkey_inv(k1[i] & ~127u); v2[i] = fkey_inv(k2[i] & ~127u); }
        unsigned c[16], q[16];
#pragma unroll
        for (int i = 0; i < 16; ++i) c[i] = (fkey(v1[stair_r1(i)] + v2[stair_r2(i)]) & ~63u) | (unsigned)(63 - i);
        bitonic_sort_desc<16>(c);
#pragma unroll
        for (int i = 0; i < 16; ++i) q[i] = (fkey(v1[stair_r1(16 + i)] + v2[stair_r2(16 + i)]) & ~63u) | (unsigned)(63 - 16 - i);
        bitonic_sort_desc<16>(q); top16_merge(c, q);
#pragma unroll
        for (int i = 0; i < 16; ++i) q[i] = (fkey(v1[stair_r1(32 + i)] + v2[stair_r2(32 + i)]) & ~63u) | (unsigned)(63 - 32 - i);
        bitonic_sort_desc<16>(q); top16_merge(c, q);
#pragma unroll
        for (int i = 0; i < 16; ++i) q[i] = (i < 2) ? ((fkey(v1[stair_r1(48 + (i < 2 ? i : 0))] + v2[stair_r2(48 + (i < 2 ? i : 0))]) & ~63u) | (unsigned)(63 - 48 - i)) : 0u;
        bitonic_sort_desc<16>(q); top16_merge(c, q);
        unsigned eid[16]; float ex[16]; const float mx = fkey_inv(c[0] & ~63u); float sm = 0.f;
#pragma unroll
        for (int i = 0; i < 16; ++i) { const unsigned rr = TAB[63 - (c[i] & 63u)];
            const unsigned ka = KL[(rr & 255u) * 512 + tid], kb = KL[(16 + (rr >> 8)) * 512 + tid];
            eid[i] = (127u - (ka & 127u)) * 128u + (127u - (kb & 127u));
            ex[i] = __expf(fkey_inv(c[i] & ~63u) - mx); sm += ex[i]; }
        const float inv = 1.f / sm;
        unsigned* ep = EIDX + (size_t)token * 128 + 16 * h; float* gp = GATE + (size_t)token * 128 + 16 * h; float* up = (float*)(A.ws + WS_USA) + (size_t)token * 128 + 16 * h;
        const float* USC = (const float*)(A.ws + WS_USC); const float* VSC = (const float*)(A.ws + WS_VSC);
        float us[16];
#pragma unroll
        for (int i = 0; i < 16; ++i) { us[i] = USC[eid[i]]; ex[i] = ex[i] * inv * VSC[eid[i]]; }
#pragma unroll
        for (int i = 0; i < 4; ++i) { *(v4u*)(ep + 4 * i) = (v4u){eid[4 * i], eid[4 * i + 1], eid[4 * i + 2], eid[4 * i + 3]};
            *(f32x4*)(gp + 4 * i) = (f32x4){ex[4 * i], ex[4 * i + 1], ex[4 * i + 2], ex[4 * i + 3]};
            *(f32x4*)(up + 4 * i) = (f32x4){us[4 * i], us[4 * i + 1], us[4 * i + 2], us[4 * i + 3]}; }
    }
}

#define PEER_LOAD8(buf, tab, ev, lb_) do { _Pragma("unroll") for (int i_ = 0; i_ < 8; ++i_) buf[i_] = peer_load(tab, (unsigned)__builtin_amdgcn_readlane((int)(ev), (lb_) + i_), lane); } while (0)
#define PEER_DOT8(buf, off_) do { _Pragma("unroll") for (int i_ = 0; i_ < 8; ++i_) p[(off_) + i_] = peer_dot(buf[i_], xp, xf); } while (0)
#define PEER_UFIN(hb_) do { wave_tsum16(p, lane); \
            const float d0 = __shfl(p[0], srcl), d1 = __shfl(p[1], srcl); \
            float dot = (i16 & 1) ? d1 : d0; \
            const unsigned eS_ = (hb_) < 4 ? eA : eB; const float gS = (hb_) < 4 ? gA : gB; \
            float wv; if (PEER_FP8) { dot *= USC[eS_]; wv = gS * gelu_f(dot) * VSC[eS_]; } else { wv = gS * gelu_f(dot); } \
            const bool mine = (lane >> 4) == ((hb_) & 3); \
            if ((hb_) < 4) wA = mine ? wv : wA; else wB = mine ? wv : wB; } while (0)
#define PEER_AXPY8(buf, wS_, lb_) do { _Pragma("unroll") for (int i_ = 0; i_ < 8; ++i_) peer_axpy(buf[i_], __builtin_bit_cast(float, __builtin_amdgcn_readlane(__builtin_bit_cast(int, (wS_)), (lb_) + i_)), acc); } while (0)
template <bool DUMMY> __device__ __forceinline__ void p9_peer(const Args& A, int wave, int lane, unsigned emask) {
    unsigned* EIDX = (unsigned*)(A.ws + WS_EIDX); float* GATE = (float*)(A.ws + WS_GATE); const bf16* XN = (const bf16*)(A.ws + WS_XN);
    const unsigned char* U = A.ws + WS_U; const unsigned char* V = A.ws + WS_V;
    const float* USC = (const float*)(A.ws + WS_USC); const float* VSC = (const float*)(A.ws + WS_VSC);
    float* MODV = (float*)(A.ws + WS_MODV); float* OUT = A.out; const float* fnw = A.in[I_FNW];
    const int i16 = lane & 15;
    const int srcl = 32 * ((i16 >> 3) & 1) + 16 * ((i16 >> 2) & 1) + 8 * ((i16 >> 1) & 1);
    const int gw = blockIdx.x * 8 + wave, NGW = gridDim.x * 8;
    PeerRow bufa[8], bufb[8];
    unsigned eA = 0, eB = 0; float gA = 0.f, gB = 0.f;
    if (gw < T) { eA = EIDX[(size_t)gw * 128 + lane] & emask; eB = EIDX[(size_t)gw * 128 + 64 + lane] & emask; gA = GATE[(size_t)gw * 128 + lane]; gB = GATE[(size_t)gw * 128 + 64 + lane];
        PEER_LOAD8(bufa, U, eA, 0); }
    for (int t = gw; t < T; t += NGW) {
        const int tn = (t + NGW < T) ? t + NGW : t;
        unsigned xp[8]; float xf[16];
        if (PEER_FP8) {
            const v4u a = *(const v4u*)(XN + (size_t)t * 1024 + 16 * lane), b2 = *(const v4u*)(XN + (size_t)t * 1024 + 16 * lane + 8);
#pragma unroll
            for (int j = 0; j < 4; ++j) { xf[2 * j] = bflo(a[j]); xf[2 * j + 1] = bfhi(a[j]); xf[8 + 2 * j] = bflo(b2[j]); xf[8 + 2 * j + 1] = bfhi(b2[j]); xp[j] = 0u; xp[4 + j] = 0u; }
        } else {
            const v4u a = *(const v4u*)(XN + (size_t)t * 1024 + 8 * lane), b2 = *(const v4u*)(XN + (size_t)t * 1024 + 512 + 8 * lane);
#pragma unroll
            for (int j = 0; j < 4; ++j) { xp[j] = a[j]; xp[4 + j] = b2[j]; }
#pragma unroll
            for (int j = 0; j < 16; ++j) xf[j] = 0.f;
        }
        float wA = 0.f, wB = 0.f;
#pragma unroll 1
        for (int hb = 0; hb < 8; ++hb) {
            const unsigned eS = hb < 4 ? eA : eB; const int lb = 16 * (hb & 3);
            float p[16];
            PEER_LOAD8(bufb, U, eS, lb + 8);
            PEER_DOT8(bufa, 0);
            if (hb < 7) { const unsigned eN = hb < 3 ? eA : eB; PEER_LOAD8(bufa, U, eN, 16 * ((hb + 1) & 3)); }
            else PEER_LOAD8(bufa, V, eA, 0);
            PEER_DOT8(bufb, 8);
            PEER_UFIN(hb);
        }
        const unsigned eAn = EIDX[(size_t)tn * 128 + lane] & emask;
        f32x2 acc[8];
#pragma unroll
        for (int i = 0; i < 8; ++i) acc[i] = (f32x2){0.f, 0.f};
#pragma unroll 1
        for (int hb = 0; hb < 8; ++hb) {
            const unsigned eS = hb < 4 ? eA : eB; const float wS = hb < 4 ? wA : wB; const int lb = 16 * (hb & 3);
            PEER_LOAD8(bufb, V, eS, lb + 8);
            PEER_AXPY8(bufa, wS, lb);
            if (hb < 7) { const unsigned eN = hb < 3 ? eA : eB; PEER_LOAD8(bufa, V, eN, 16 * ((hb + 1) & 3)); }
            else if (tn != t) PEER_LOAD8(bufa, U, eAn, 0);
            PEER_AXPY8(bufb, wS, lb + 8);
        }
        float* orow = OUT + (size_t)t * 1024; const float* g5 = MODV + (size_t)(t >> 12) * 6144 + 5 * 1024;
        float x2[16]; float ss = 0.f;
#pragma unroll
        for (int q = 0; q < 4; ++q) { const int col = PEER_FP8 ? 16 * lane + 4 * q : (q < 2 ? 8 * lane + 4 * q : 512 + 8 * lane + 4 * (q - 2));
            const f32x4 a = *(const f32x4*)(orow + col), ga = *(const f32x4*)(g5 + col);
            x2[4 * q] = a[0] + ga[0] * acc[2 * q].x; x2[4 * q + 1] = a[1] + ga[1] * acc[2 * q].y; x2[4 * q + 2] = a[2] + ga[2] * acc[2 * q + 1].x; x2[4 * q + 3] = a[3] + ga[3] * acc[2 * q + 1].y; }
#pragma unroll
        for (int i = 0; i < 16; ++i) ss += x2[i] * x2[i];
        const float rstd = rsqrtf(wave_sum(ss) * (1.f / 1024.f) + EPS);
#pragma unroll
        for (int q = 0; q < 4; ++q) { const int col = PEER_FP8 ? 16 * lane + 4 * q : (q < 2 ? 8 * lane + 4 * q : 512 + 8 * lane + 4 * (q - 2));
            const f32x4 wa = *(const f32x4*)(fnw + col); f32x4 oa;
#pragma unroll
            for (int k = 0; k < 4; ++k) oa[k] = x2[4 * q + k] * rstd * wa[k];
            if (!DUMMY || rstd == 123.456f) *(f32x4*)(orow + col) = oa; }
        eA = eAn; eB = EIDX[(size_t)tn * 128 + 64 + lane] & emask; gA = GATE[(size_t)tn * 128 + lane]; gB = GATE[(size_t)tn * 128 + 64 + lane];
    }
}
#if PEER_FP8
constexpr int GL_RSH = 11, GL_KB = 2;
constexpr int GL_TG = 4, GL_NE = 128 * GL_TG, GL_NBT = GL_NE / 8;
constexpr int GL_L = 0, GL_W = 4 * GL_NE, GL_CNT = 8 * GL_NE, GL_OFF = GL_CNT + 256, GL_US = GL_OFF + 256, GL_D = GL_US + 4 * GL_NE, GL_X = GL_D + 4 * GL_NE, GL_WAVE_BYTES = GL_X + 2048 * GL_TG;
constexpr int GL_ACC = GL_US;
static_assert(GL_WAVE_BYTES - GL_ACC >= 4096 * (GL_TG - 1), "parked accumulators fit");
static_assert(8 * GL_WAVE_BYTES <= LDSCTL_OFF && GL_NBT % 4 == 0, "gather LDS map");
__device__ __forceinline__ void gl_axpy(const v4u& w, float c, f32x2 (&acc)[8]) {
    const f32x2 cc = {c, c};
#pragma unroll
    for (int j = 0; j < 4; ++j) { acc[2 * j] += cc * __builtin_amdgcn_cvt_pk_f32_fp8((int)w[j], false); acc[2 * j + 1] += cc * __builtin_amdgcn_cvt_pk_f32_fp8((int)w[j], true); }
}
__device__ __forceinline__ float swapmax16(float a) { auto r = __builtin_amdgcn_permlane16_swap(__builtin_bit_cast(unsigned, a), __builtin_bit_cast(unsigned, a), false, false); const unsigned r0 = r[0], r1 = r[1]; return fmaxf(__uint_as_float(r0), __uint_as_float(r1)); }
__device__ __forceinline__ float swapmax32(float a) { auto r = __builtin_amdgcn_permlane32_swap(__builtin_bit_cast(unsigned, a), __builtin_bit_cast(unsigned, a), false, false); const unsigned r0 = r[0], r1 = r[1]; return fmaxf(__uint_as_float(r0), __uint_as_float(r1)); }
__device__ __forceinline__ float wave_max(float v) { v = fmaxf(v, dppf<0xB1>(v)); v = fmaxf(v, dppf<0x4E>(v)); v = fmaxf(v, dppf<0x141>(v)); v = fmaxf(v, dppf<0x140>(v)); return swapmax32(swapmax16(v)); }
#define GL_WAIT() asm volatile("s_waitcnt lgkmcnt(0)" ::: "memory")
#define GL_RLOAD(buf, tab, bidx) do { const unsigned ent_ = Ls[8 * (bidx) + (lane >> 3)]; \
    _Pragma("unroll") for (int j_ = 0; j_ < 8; ++j_) { const unsigned e_ = (unsigned)__builtin_amdgcn_readlane((int)ent_, 8 * j_) & 0x3fffu; buf[j_] = *(const v4u*)((tab) + (size_t)e_ * 1024 + 16 * lane); } } while (0)
#define GL_UCOMP(buf, bidx) do { const unsigned ent_ = Ls[8 * (bidx) + (lane >> 3)]; float p[8]; \
    _Pragma("unroll") for (int j_ = 0; j_ < 8; ++j_) { const unsigned kk_ = ((unsigned)__builtin_amdgcn_readlane((int)ent_, 8 * j_) >> 14) & 3u; \
        const v4u xq_ = *(const LAS v4u*)(XS + kk_ * 1024 + 16 * lane); int s_ = 0; \
        _Pragma("unroll") for (int w_ = 0; w_ < 4; ++w_) s_ = __builtin_amdgcn_sdot4((int)buf[j_][w_], (int)xq_[w_], s_, false); \
        p[j_] = (float)s_; } \
    _Pragma("unroll") for (int q_ = 0; q_ < 4; ++q_) p[q_] = swapsum32(p[q_], p[q_ + 4]); \
    _Pragma("unroll") for (int q_ = 0; q_ < 2; ++q_) p[q_] = swapsum16(p[q_], p[q_ + 2]); \
    { const bool up_ = (lane & 8) != 0; const float snd_ = up_ ? p[0] : p[1]; const float keep_ = up_ ? p[1] : p[0]; p[0] = keep_ + dppf<0x128>(snd_); } \
    p[0] = allsumf8(p[0]);                                        \
    if ((lane & 7) == 0) Ds[8 * (bidx) + (lane >> 3)] = p[0]; } while (0)
#define GL_VSWITCH(kn_) do { const int s_ = (mapbits >> (2 * (kn_))) & 3; LAS unsigned char* sp_ = ACCS + s_ * 4096 + 64 * lane; \
    const f32x4 t0_ = *(const LAS f32x4*)sp_, t1_ = *(const LAS f32x4*)(sp_ + 16), t2_ = *(const LAS f32x4*)(sp_ + 32), t3_ = *(const LAS f32x4*)(sp_ + 48); \
    *(LAS f32x4*)sp_ = (f32x4){cur[0].x, cur[0].y, cur[1].x, cur[1].y}; *(LAS f32x4*)(sp_ + 16) = (f32x4){cur[2].x, cur[2].y, cur[3].x, cur[3].y}; \
    *(LAS f32x4*)(sp_ + 32) = (f32x4){cur[4].x, cur[4].y, cur[5].x, cur[5].y}; *(LAS f32x4*)(sp_ + 48) = (f32x4){cur[6].x, cur[6].y, cur[7].x, cur[7].y}; \
    cur[0] = (f32x2){t0_[0], t0_[1]}; cur[1] = (f32x2){t0_[2], t0_[3]}; cur[2] = (f32x2){t1_[0], t1_[1]}; cur[3] = (f32x2){t1_[2], t1_[3]}; \
    cur[4] = (f32x2){t2_[0], t2_[1]}; cur[5] = (f32x2){t2_[2], t2_[3]}; cur[6] = (f32x2){t3_[0], t3_[1]}; cur[7] = (f32x2){t3_[2], t3_[3]}; \
    mapbits = (mapbits & ~(3 << (2 * kcur))) | (s_ << (2 * kcur)); kcur = (kn_); } while (0)
#define GL_VCOMP(buf, bidx) do { const unsigned ent_ = Ls[8 * (bidx) + (lane >> 3)]; const float wv_ = Ws[8 * (bidx) + (lane >> 3)]; \
    _Pragma("unroll") for (int j_ = 0; j_ < 8; ++j_) { const int kk_ = (int)(((unsigned)__builtin_amdgcn_readlane((int)ent_, 8 * j_) >> 14) & 3u); \
        const float w_ = __builtin_bit_cast(float, __builtin_amdgcn_readlane(__builtin_bit_cast(int, wv_), 8 * j_)); \
        if (kk_ != kcur) { asm volatile("" ::: "memory"); GL_VSWITCH(kk_); } \
        gl_axpy(buf[j_], w_, cur); } } while (0)
#define GL_SWEEP(tab, COMP) do { GL_RLOAD(buf0, tab, 0); GL_RLOAD(buf1, tab, 1); GL_RLOAD(buf2, tab, 2); \
    _Pragma("unroll 1") for (int b_ = 0; b_ < GL_NBT; b_ += 4) { \
        GL_RLOAD(buf3, tab, b_ + 3); COMP(buf0, b_); \
        GL_RLOAD(buf0, tab, (b_ + 4 < GL_NBT ? b_ + 4 : GL_NBT - 1)); COMP(buf1, b_ + 1); \
        GL_RLOAD(buf1, tab, (b_ + 5 < GL_NBT ? b_ + 5 : GL_NBT - 1)); COMP(buf2, b_ + 2); \
        GL_RLOAD(buf2, tab, (b_ + 6 < GL_NBT ? b_ + 6 : GL_NBT - 1)); COMP(buf3, b_ + 3); } } while (0)

template <bool DUMMY> __device__ __forceinline__ void p10_gather(const Args& A, LAS unsigned char* lds, int wave, int lane, const XcdBarrier& bar, unsigned emask) {
    unsigned* EIDX = (unsigned*)(A.ws + WS_EIDX); float* GATE = (float*)(A.ws + WS_GATE); const bf16* XN = (const bf16*)(A.ws + WS_XN);
    const unsigned char* U = A.ws + WS_U; const unsigned char* V = A.ws + WS_V;
    const float* USC = (const float*)(A.ws + WS_USC); const float* VSC = (const float*)(A.ws + WS_VSC);
    float* MODV = (float*)(A.ws + WS_MODV); float* OUT = A.out; const float* fnw = A.in[I_FNW];
    LAS unsigned char* wl = lds + wave * GL_WAVE_BYTES;
    LAS unsigned* Ls = (LAS unsigned*)(wl + GL_L); LAS float* Ws = (LAS float*)(wl + GL_W); LAS float* USs = (LAS float*)(wl + GL_US); LAS float* Ds = (LAS float*)(wl + GL_D);
    LAS unsigned* CNT = (LAS unsigned*)(wl + GL_CNT); LAS unsigned* OFF = (LAS unsigned*)(wl + GL_OFF); LAS unsigned char* XS = wl + GL_X; LAS unsigned char* ACCS = wl + GL_ACC; LAS float* SXS = (LAS float*)(wl + GL_CNT);
    const int gw = blockIdx.x * 8 + wave, NGW = gridDim.x * 8, NGRP = T / GL_TG;
    (void)bar;
    unsigned e[2 * GL_TG]; float g[2 * GL_TG], us[2 * GL_TG]; const float* USA = (const float*)(A.ws + WS_USA);
#define GL_LOADSEL(E_, G_, U_, grp_) do { _Pragma("unroll") for (int j = 0; j < 2 * GL_TG; ++j) { const size_t o = (size_t)(GL_TG * (grp_) + (j >> 1)) * 128 + (j & 1) * 64 + lane; E_[j] = EIDX[o] & emask; G_[j] = GATE[o]; U_[j] = USA[o]; } } while (0)
    if (gw < NGRP) GL_LOADSEL(e, g, us, gw);
    for (int it = 0; it < (NGRP + NGW - 1) / NGW; ++it) {
        const int gi = gw + it * NGW;
#ifndef GL_GRID_SYNC
#define GL_GRID_SYNC 0
#endif
        if (GL_GRID_SYNC && N_LAUNCHES == 1 && it > 0 && !DUMMY) xcd_barrier(bar); else __syncthreads();
        if (gi < NGRP) {
            const int t0 = GL_TG * gi;
            CNT[lane] = 0u; GL_WAIT();
            unsigned ps[2 * GL_TG];
#pragma unroll
            for (int j = 0; j < 2 * GL_TG; ++j) ps[j] = __hip_atomic_fetch_add(CNT + (((e[j] >> GL_RSH) << GL_KB) | (unsigned)(j >> 1)), 1u, __ATOMIC_RELAXED, __HIP_MEMORY_SCOPE_WORKGROUP);
            GL_WAIT();
            { const unsigned c = CNT[lane]; unsigned incl = c;
#pragma unroll
              for (int o = 1; o < 64; o <<= 1) { const unsigned v = (unsigned)__shfl_up((int)incl, o); if (lane >= o) incl += v; }
              OFF[lane] = incl - c; }
            GL_WAIT();
#pragma unroll
            for (int j = 0; j < 2 * GL_TG; ++j) { const unsigned i2 = OFF[((e[j] >> GL_RSH) << GL_KB) | (unsigned)(j >> 1)] + ps[j];
                Ls[i2] = e[j] | ((unsigned)(j >> 1) << 14); Ws[i2] = g[j]; USs[i2] = us[j]; }
#pragma unroll
            for (int k = 0; k < GL_TG; ++k) { const v4u a = *(const v4u*)(XN + (size_t)(t0 + k) * 1024 + 16 * lane), b2 = *(const v4u*)(XN + (size_t)(t0 + k) * 1024 + 16 * lane + 8);
                float xv[16]; float am = 0.f;
#pragma unroll
                for (int j = 0; j < 4; ++j) { xv[2 * j] = bflo(a[j]); xv[2 * j + 1] = bfhi(a[j]); xv[8 + 2 * j] = bflo(b2[j]); xv[8 + 2 * j + 1] = bfhi(b2[j]); }
#pragma unroll
                for (int j = 0; j < 16; ++j) am = fmaxf(am, fabsf(xv[j]));
                am = wave_max(am); const float inv8 = am > 0.f ? 127.f / am : 0.f;
                v4u qx;
#pragma unroll
                for (int j = 0; j < 4; ++j) qx[j] = ((unsigned)__float2int_rn(xv[4 * j] * inv8) & 255u) | (((unsigned)__float2int_rn(xv[4 * j + 1] * inv8) & 255u) << 8)
                                                  | (((unsigned)__float2int_rn(xv[4 * j + 2] * inv8) & 255u) << 16) | (((unsigned)__float2int_rn(xv[4 * j + 3] * inv8) & 255u) << 24);
                *(LAS v4u*)(XS + k * 1024 + 16 * lane) = qx; if (lane == 0) SXS[k] = am * (1.f / 127.f); }
            GL_WAIT();
            v4u buf0[8], buf1[8], buf2[8], buf3[8];
#ifdef GL_PROBE_NOSWEEP
            if (!DUMMY)
#endif
            GL_SWEEP(U, GL_UCOMP);
            GL_WAIT();
#pragma unroll
            for (int j = 0; j < 2 * GL_TG; ++j) { const int i = lane + 64 * j; Ws[i] = Ws[i] * gelu_f(Ds[i] * USs[i] * SXS[(Ls[i] >> 14) & 3u]); }
            GL_WAIT();
            f32x2 cur[8]; int kcur = 0; int mapbits = (0 << 2) | (1 << 4) | (2 << 6);
            { LAS unsigned char* zp = ACCS + 64 * lane;
#pragma unroll
              for (int q = 0; q < 4 * (GL_TG - 1); ++q) *(LAS f32x4*)(zp + (q >> 2) * 4096 + (q & 3) * 16) = (f32x4){0.f, 0.f, 0.f, 0.f}; }
#pragma unroll
            for (int i = 0; i < 8; ++i) cur[i] = (f32x2){0.f, 0.f};
            GL_WAIT();
            GL_SWEEP(V, GL_VCOMP);
            { const int gn = gi + NGW < NGRP ? gi + NGW : gi; GL_LOADSEL(e, g, us, gn); }
            const float* fnw_ = fnw; asm volatile("" : "+s"(fnw_));
#pragma unroll
            for (int k = 0; k < GL_TG; ++k) { const int t = t0 + k;
                if (k != kcur) { asm volatile("" ::: "memory"); GL_VSWITCH(k); }
                float* orow = OUT + (size_t)t * 1024 + 16 * lane; const float* g5 = MODV + (size_t)(t >> 12) * 6144 + 5 * 1024 + 16 * lane;
                const bf16* x1p = (const bf16*)(A.ws + WS_X1B) + x1b_off(t, 16 * lane); const v4u xa1 = *(const v4u*)x1p, xb1 = *(const v4u*)(x1p + 8);
                float x2[16]; float ss = 0.f;
#pragma unroll
                for (int q = 0; q < 4; ++q) { const unsigned w0_ = q < 2 ? xa1[2 * q] : xb1[2 * q - 4], w1_ = q < 2 ? xa1[2 * q + 1] : xb1[2 * q - 3];
                    const f32x4 a = {bflo(w0_), bfhi(w0_), bflo(w1_), bfhi(w1_)}, ga = *(const f32x4*)(g5 + 4 * q);
                    x2[4 * q] = a[0] + ga[0] * cur[2 * q].x; x2[4 * q + 1] = a[1] + ga[1] * cur[2 * q].y; x2[4 * q + 2] = a[2] + ga[2] * cur[2 * q + 1].x; x2[4 * q + 3] = a[3] + ga[3] * cur[2 * q + 1].y; }
#pragma unroll
                for (int i = 0; i < 16; ++i) ss += x2[i] * x2[i];
                const float rstd = rsqrtf(wave_sum(ss) * (1.f / 1024.f) + EPS);
#pragma unroll
                for (int q = 0; q < 4; ++q) { const f32x4 wa = *(const f32x4*)(fnw_ + 16 * lane + 4 * q); f32x4 oa;
#pragma unroll
                    for (int i = 0; i < 4; ++i) oa[i] = x2[4 * q + i] * rstd * wa[i];
                    if (!DUMMY || rstd == 123.456f) *(f32x4*)(orow + 4 * q) = oa; } }
        }
    }
}
#endif
__global__ void __launch_bounds__(512, 2) fwd_kernel(Args args) {
    extern __shared__ __attribute__((aligned(16))) unsigned char lds_raw[];
    LAS unsigned char* lds = (LAS unsigned char*)lds_raw;
    volatile LAS unsigned* MISC = (volatile LAS unsigned*)(lds + MISC_OFF);
    const int tid = threadIdx.x, lane = tid & 63, wave = __builtin_amdgcn_readfirstlane(tid >> 6);
    for (int u = tid; u < (LDS_BYTES - LDSCTL_OFF) / 4; u += 512) ((LAS unsigned*)(lds + LDSCTL_OFF))[u] = 0u;
    __syncthreads();
    unsigned* ctl = (unsigned*)(args.ws + WS_CTL);
    XcdBarrier bar; bar.bar = ctl + CW_BAR; bar.x = 0; bar.st = nullptr;
    if (N_LAUNCHES == 1) bar = xcd_barrier_post(ctl + CW_BAR, MISC + 8);
    const int lo = args.ph_lo, hi = args.ph_hi;
#ifndef ONLY_PHASE
#define ONLY_PHASE -1
#endif
#define IN(k) ((ONLY_PHASE < 0 || ONLY_PHASE == (k)) && lo <= (k) && (k) < hi)
#define SEAM(k) do { if (IN(k) && IN((k) + 1)) xcd_barrier(bar); } while (0)
#ifndef DUP_MASK
#define DUP_MASK 0
#endif
#define REP(k) for (int rep_ = 0; rep_ < (((DUP_MASK >> (k)) & 1) ? 2 : 1); ++rep_, (rep_ < (((DUP_MASK >> (k)) & 1) ? 2 : 1) ? xcd_barrier(bar) : (void)0))

    if (IN(0)) REP(0) { p0_mod(args, lds, tid); p0_weights(args, lds, tid, wave, lane); p0_wc(args, lds, tid); }
    SEAM(0);
    if (IN(1)) REP(1) { p1_norm(args, lds, tid, wave, lane, 0); }
    SEAM(1);
    if (IN(2)) REP(2) {
        pg8::Gemm g{(const pg8::bf16_t*)(args.ws + WS_XN), (const pg8::bf16_t*)(args.ws + WS_WIN), MROWS, 2560, 1024};
        InProjOrder S; S.init((int)gridDim.x, (int)blockIdx.x);
        EpiInProj E{(bf16*)(args.ws + WS_ZS), (bf16*)(args.ws + WS_XBC), (bf16*)(args.ws + WS_UGLU)};
        pg8::gemm_phase<EpiInProj, InProjOrder, true, true>(lds, g, S, E);
    }
    SEAM(2);
    if (IN(3)) REP(3) {
        const int G3 = (int)gridDim.x, c3 = (int)blockIdx.x, NSSD = NB * NCC * 2, NCTX = NB * 2 * 2, NCONV = NB * 2 * 64;
        for (int it = c3; it < NSSD; it += G3) ssd_local_item(args, lds, it, tid, wave, lane);
        const bool split = G3 == 256;
        if (!split || c3 >= NCTX) for (int j = split ? c3 - NCTX : c3; j < NCONV; j += split ? G3 - NCTX : G3) cfm_conv_item(args, j, tid);
    }
    SEAM(3);
    if (IN(4)) REP(4) { p4_recur(args, tid); }
    SEAM(4);
    if (IN(5)) REP(5) {
        for (int it = blockIdx.x; it < NB * 32 * 2; it += gridDim.x) ssd_out_item(args, lds, it, tid, wave, lane);
        cfm_ln_rows(args, wave, lane);
    }
    SEAM(5);
    if (IN(6)) REP(6) {
        pg8::Gemm g{(const pg8::bf16_t*)(args.ws + WS_XN), (const pg8::bf16_t*)(args.ws + WS_WOUT), T, 1024, 1024};
        pg8::StaticOrder S; S.init(T, 1024, (int)gridDim.x, (int)blockIdx.x);
        EpiOutProj E{args.in[I_X], (bf16*)(args.ws + WS_X1B), (float*)(args.ws + WS_MODV)};
        pg8::gemm_phase<EpiOutProj, pg8::StaticOrder, true, true>(lds, g, S, E);
    }
    SEAM(6);
    if (IN(7)) REP(7) { p7_norm2(args, wave, lane); }
    SEAM(7);
    if (IN(8)) REP(8) {
        pg8::Gemm g{(const pg8::bf16_t*)(args.ws + WS_WC), (const pg8::bf16_t*)(args.ws + WS_XN), 2048, T, 1024};
        pg8::StaticOrder S; S.init(2048, T, (int)gridDim.x, (int)blockIdx.x);
        EpiScore E{(_Float16*)(args.ws + WS_SC)};
        pg8::gemm_phase<EpiScore, pg8::StaticOrder, true, true>(lds, g, S, E);
    }
    SEAM(8);
    if (IN(9)) REP(9) {
        p9_select_init(lds, tid); __syncthreads();
        for (int item = blockIdx.x; item < 8 * (T / 512); item += gridDim.x) p9_select_one(args, lds, tid, (item >> 3) * 512 + tid, item & 7);
    }
    SEAM(9);
#if PEER_FP8 && !defined(PEER_FLAT)
#ifdef PEER_PROBE_MASK
    if (IN(10)) { p10_gather<true>(args, lds, wave, lane, bar, PEER_PROBE_MASK); }
#endif
    if (IN(10)) REP(10) { p10_gather<false>(args, lds, wave, lane, bar, 0xffffffffu); }
#else
    if (IN(10)) REP(10) { p9_peer<false>(args, wave, lane, 0xffffffffu); }
#endif
#undef IN
#undef SEAM
}

#ifndef HOST_DUP_MASK
#define HOST_DUP_MASK 0
#endif
extern "C" void kernel_launch(void* const* d_in, const int* in_sizes, int n_in, void* d_out, int out_size, void* d_ws, size_t ws_size, hipStream_t stream) {
    static int grid = 0;
    if (grid == 0) {
        if (n_in != 25 || in_sizes[0] != T * D || out_size != T * D || ws_size < WS_END) {
            fprintf(stderr, "kernel_launch: unexpected problem (n_in %d, in0 %d, out %d, ws %zu); nothing launched\n", n_in, n_in > 0 ? in_sizes[0] : -1, out_size, ws_size); grid = -1; return; }
        int dev = 0, cus = 0, per_cu = 0;
        if (hipGetDevice(&dev) != hipSuccess || hipDeviceGetAttribute(&cus, hipDeviceAttributeMultiprocessorCount, dev) != hipSuccess) { grid = -1; return; }
        if (hipFuncSetAttribute((const void*)fwd_kernel, hipFuncAttributeMaxDynamicSharedMemorySize, LDS_BYTES) != hipSuccess) { fprintf(stderr, "kernel_launch: hipFuncSetAttribute failed\n"); grid = -1; return; }
        if (hipOccupancyMaxActiveBlocksPerMultiprocessor(&per_cu, (const void*)fwd_kernel, 512, LDS_BYTES) != hipSuccess || per_cu < 1) { fprintf(stderr, "kernel_launch: occupancy query says %d blocks/CU\n", per_cu); grid = -1; (void)hipGetLastError(); return; }
        (void)hipGetLastError();
        grid = cus;
    }
    if (grid < 0) return;
    (void)hipMemsetAsync((char*)d_ws + WS_CTL, 0, CTL_ZERO_BYTES, stream);
    Args a{};
    for (int i = 0; i < 25; ++i) a.in[i] = (const float*)d_in[i];
    a.out = (float*)d_out; a.ws = (unsigned char*)d_ws;
    if (N_LAUNCHES == 1) {
        a.ph_lo = 0; a.ph_hi = NPHASE; a.li = 0;
        hipLaunchKernelGGL(fwd_kernel, dim3(grid), dim3(512), LDS_BYTES, stream, a);
    } else {
        for (int li = 0; li < NPHASE; ++li) { a.ph_lo = li; a.ph_hi = li + 1; a.li = li;
            for (int r = 0; r < (((HOST_DUP_MASK >> li) & 1) ? 2 : 1); ++r) hipLaunchKernelGGL(fwd_kernel, dim3(grid), dim3(512), LDS_BYTES, stream, a); }
    }
}
```

```cpp
#include <hip/hip_runtime.h>
#include <cstdio>
#include <cstdint>
namespace pg8 {
#define PG8_LAS __attribute__((address_space(3)))
typedef unsigned short bf16_t;
typedef short bf16x8 __attribute__((ext_vector_type(8)));
typedef float f32x4 __attribute__((ext_vector_type(4)));
typedef unsigned u32x4 __attribute__((ext_vector_type(4)));
constexpr int BM = 256, BK = 64, HALF = 128, HTB = HALF * BK * 2  , STAGE_BYTES = 8 * HTB, NXCD = 8, WGM = 8;

__host__ __device__ __forceinline__ int lds_byte(int r, int c) { const int st = (r >> 4) * 2 + (c >> 5), rr = r & 15, cc = c & 31, ob = rr * 64 + cc * 2; return st * 1024 + (ob ^ (((ob >> 9) & 1) << 5)); }
__host__ __device__ __forceinline__ void stage_rc(int b, int& R, int& C) { const int st = b / 1024, sb = b % 1024, swz = sb ^ (((sb >> 9) & 1) << 5); R = (st >> 1) * 16 + swz / 64; C = (st & 1) * 32 + (swz % 64) / 2; }
__host__ __device__ __forceinline__ int perm32(int rho) { const int n = rho >> 4, i = rho & 15; return 8 * (i >> 2) + 4 * n + (i & 3); }

struct Unit { int pm, pn; };
struct Gemm { const bf16_t* A; const bf16_t* Bt; int M, N, K; };

struct StaticOrder {
    int nM, nN, nwg, G, c;
    __host__ __device__ void init(int M, int N, int G_, int c_) { nM = M / BM; nN = N / BM; nwg = nM * nN; G = G_; c = c_; }
    __host__ __device__ bool next(int i, Unit& u) const {
        const long L = (long)i * G + c; if (L >= nwg) return false;
        int wgid = (int)L; { const int q = nwg / NXCD, r = nwg % NXCD, xcd = wgid % NXCD, off = wgid / NXCD; wgid = (xcd < r ? xcd * (q + 1) : r * (q + 1) + (xcd - r) * q) + off; }
        const int nig = WGM * nN, gid = wgid / nig, fm = gid * WGM, gsz = (nM - fm) < WGM ? (nM - fm) : WGM;
        u.pm = fm + ((wgid % nig) % gsz); u.pn = (wgid % nig) / gsz; return true;
    }
    __device__ __forceinline__ void a_ready(const Unit&) const {}
    __device__ __forceinline__ void done(const Unit&) const {}
};

__device__ __forceinline__ unsigned cvt_pk_bf16(float lo, float hi) { unsigned r; asm volatile("v_cvt_pk_bf16_f32 %0, %1, %2" : "=v"(r) : "v"(lo), "v"(hi)); return r; }
template <class Epi, class Sched, bool ALIGN_EPI = false, bool SP2 = false>
__device__ __forceinline__ void gemm_phase(PG8_LAS unsigned char* lds, const Gemm g, const Sched& S, const Epi& E) {
    const int tid = threadIdx.x, wid = __builtin_amdgcn_readfirstlane(tid >> 6), lane = tid & 63, wr = wid >> 2, wc = wid & 3, fr = lane & 15, fq = lane >> 4;
    const int K = g.K, nt = K / BK;
    unsigned voffA[2], voffB[2];
#pragma unroll
    for (int i = 0; i < 2; ++i) { int R, C; stage_rc(tid * 16 + i * 8192, R, C); const int Rb = Epi::PERM ? ((R & ~31) + perm32(R & 31)) : R;
        voffA[i] = (unsigned)(R * K + C) * 2u; voffB[i] = (unsigned)(Rb * K + C) * 2u; }
    const size_t kstep = (size_t)(BK * 2);
    const size_t hstep = (size_t)HALF * K * 2;
    const size_t tstep = 2 * hstep;
    const unsigned ldsw = (unsigned)wid * 1024u;
    const int aoff = lds_byte(wr * 64 + fr, fq * 8), boff = lds_byte(wc * 32 + fr, fq * 8);
#define PG8_SA(b, h) (((b) * 2 + (h)) * HTB)
#define PG8_SB(b, h) ((4 + (b) * 2 + (h)) * HTB)
#define PG8_STAGE(bufoff, gbase, voff) do { _Pragma("unroll") for (int _i = 0; _i < 2; ++_i) \
        __builtin_amdgcn_global_load_lds((const unsigned*)((const char*)(gbase) + (voff)[_i]), (PG8_LAS unsigned*)(lds + (bufoff) + ldsw + _i * 8192), 16, 0, 0); } while (0)
#define PG8_LDA(dst, b, h) do { _Pragma("unroll") for (int m = 0; m < 4; ++m) _Pragma("unroll") for (int k = 0; k < 2; ++k) dst[m][k] = *(const PG8_LAS bf16x8*)(lds + PG8_SA(b, h) + aoff + m * 2048 + k * 1024); } while (0)
#define PG8_LDB(dst, b, h) do { _Pragma("unroll") for (int n = 0; n < 2; ++n) _Pragma("unroll") for (int k = 0; k < 2; ++k) dst[n][k] = *(const PG8_LAS bf16x8*)(lds + PG8_SB(b, h) + boff + n * 2048 + k * 1024); } while (0)
#define PG8_MMA(ai, bj, At, Bt) do { __builtin_amdgcn_s_setprio(1); _Pragma("unroll") for (int m = 0; m < 4; ++m) _Pragma("unroll") for (int n = 0; n < 2; ++n) _Pragma("unroll") for (int k = 0; k < 2; ++k) \
        acc[ai][bj][m][n] = __builtin_amdgcn_mfma_f32_16x16x32_bf16(Bt[n][k], At[m][k], acc[ai][bj][m][n], 0, 0, 0); __builtin_amdgcn_s_setprio(0); } while (0)
#define PG8_WAIT_V(n) asm volatile("s_waitcnt vmcnt(" #n ")" ::: "memory")
#define PG8_WAIT_L(n) asm volatile("s_waitcnt lgkmcnt(" #n ")" ::: "memory")
#define PG8_BAR __builtin_amdgcn_s_barrier()
#define PG8_SCHED __builtin_amdgcn_sched_barrier(0)
    Unit cur, nxt; int ui = 0;
    if (!S.next(0, cur)) return;
    f32x4 acc[2][2][4][2];
#pragma unroll
    for (int a = 0; a < 2; ++a)
#pragma unroll
        for (int b = 0; b < 2; ++b)
#pragma unroll
            for (int m = 0; m < 4; ++m)
#pragma unroll
                for (int n = 0; n < 2; ++n) acc[a][b][m][n] = (f32x4){0.f, 0.f, 0.f, 0.f};
    bf16x8 At[4][2], B0[2][2], B1[2][2];
    const char* cA = (const char*)g.A + (size_t)cur.pm * tstep; const char* cB = (const char*)g.Bt + (size_t)cur.pn * tstep;
    S.a_ready(cur);
    if constexpr (SP2) {
        PG8_STAGE(PG8_SB(0, 0), cB, voffB); PG8_STAGE(PG8_SB(0, 1), cB + hstep, voffB); PG8_STAGE(PG8_SA(0, 0), cA, voffA); PG8_STAGE(PG8_SA(0, 1), cA + hstep, voffA);
        if (wr == 1) PG8_BAR;
        PG8_WAIT_V(2); PG8_BAR;
        PG8_STAGE(PG8_SB(1, 0), cB + kstep, voffB); PG8_STAGE(PG8_SA(1, 0), cA + kstep, voffA); PG8_STAGE(PG8_SB(1, 1), cB + hstep + kstep, voffB);
        PG8_WAIT_V(6); PG8_BAR;
    } else {
        PG8_STAGE(PG8_SB(0, 0), cB, voffB); PG8_STAGE(PG8_SA(0, 0), cA, voffA); PG8_STAGE(PG8_SB(0, 1), cB + hstep, voffB); PG8_STAGE(PG8_SA(0, 1), cA + hstep, voffA);
        if (wr == 1) PG8_BAR;
        PG8_WAIT_V(4); PG8_BAR;
        PG8_STAGE(PG8_SB(1, 0), cB + kstep, voffB); PG8_STAGE(PG8_SA(1, 0), cA + kstep, voffA); PG8_STAGE(PG8_SB(1, 1), cB + hstep + kstep, voffB);
        PG8_WAIT_V(6); PG8_BAR;
    }
    for (;;) {
        const bool has_next = S.next(ui + 1, nxt);
        const char* nA = has_next ? (const char*)g.A + (size_t)nxt.pm * tstep : cA; const char* nB = has_next ? (const char*)g.Bt + (size_t)nxt.pn * tstep : cB;
        for (int t = 0; t < nt; t += 2) {
            const bool last = (t == nt - 2);
            const char* a1 = cA + (size_t)(t + 1) * kstep;
            const char* a2 = last ? nA : cA + (size_t)(t + 2) * kstep; const char* b2 = last ? nB : cB + (size_t)(t + 2) * kstep;
            const char* a3 = a2 + kstep; const char* b3 = b2 + kstep;
            if (last && has_next) S.a_ready(nxt);
            if constexpr (SP2) {
            PG8_LDB(B0, 0, 0); PG8_LDB(B1, 0, 1); PG8_SCHED; PG8_LDA(At, 0, 0); PG8_STAGE(PG8_SA(1, 1), a1 + hstep, voffA);
            PG8_WAIT_V(8); PG8_WAIT_L(0); PG8_BAR; PG8_MMA(0, 0, At, B0); PG8_MMA(0, 1, At, B1); PG8_BAR; PG8_SCHED;
            PG8_LDA(At, 0, 1); PG8_STAGE(PG8_SB(0, 0), b2, voffB); PG8_STAGE(PG8_SB(0, 1), b2 + hstep, voffB); PG8_STAGE(PG8_SA(0, 0), a2, voffA);
            PG8_WAIT_V(8); PG8_WAIT_L(0); PG8_BAR; PG8_MMA(1, 0, At, B0); PG8_MMA(1, 1, At, B1); PG8_BAR; PG8_SCHED;
            PG8_LDB(B0, 1, 0); PG8_LDB(B1, 1, 1); PG8_SCHED; PG8_LDA(At, 1, 0); PG8_STAGE(PG8_SA(0, 1), a2 + hstep, voffA);
            PG8_WAIT_V(8); PG8_WAIT_L(0); PG8_BAR; PG8_MMA(0, 0, At, B0); PG8_MMA(0, 1, At, B1); PG8_BAR; PG8_SCHED;
            PG8_LDA(At, 1, 1); PG8_STAGE(PG8_SB(1, 0), b3, voffB); PG8_STAGE(PG8_SB(1, 1), b3 + hstep, voffB); PG8_STAGE(PG8_SA(1, 0), a3, voffA);
            PG8_WAIT_V(8); PG8_WAIT_L(0); PG8_BAR; PG8_MMA(1, 0, At, B0); PG8_MMA(1, 1, At, B1); PG8_BAR; PG8_SCHED;
            } else {
            PG8_LDB(B0, 0, 0); PG8_SCHED; PG8_LDA(At, 0, 0); PG8_STAGE(PG8_SA(1, 1), a1 + hstep, voffA);
            PG8_WAIT_L(8); PG8_BAR; PG8_WAIT_L(0); PG8_MMA(0, 0, At, B0); PG8_BAR; PG8_SCHED;
            PG8_LDB(B1, 0, 1); PG8_STAGE(PG8_SB(0, 0), b2, voffB);
            PG8_BAR; PG8_WAIT_L(0); PG8_MMA(0, 1, At, B1); PG8_BAR;
            PG8_LDA(At, 0, 1); PG8_STAGE(PG8_SA(0, 0), a2, voffA);
            PG8_BAR; PG8_WAIT_L(0); PG8_MMA(1, 0, At, B0); PG8_BAR; PG8_SCHED;
            PG8_STAGE(PG8_SB(0, 1), b2 + hstep, voffB);
            PG8_WAIT_V(6); PG8_BAR; PG8_MMA(1, 1, At, B1); PG8_BAR;
            PG8_LDB(B0, 1, 0); PG8_SCHED; PG8_LDA(At, 1, 0); PG8_STAGE(PG8_SA(0, 1), a2 + hstep, voffA);
            PG8_WAIT_L(8); PG8_BAR; PG8_WAIT_L(0); PG8_MMA(0, 0, At, B0); PG8_BAR; PG8_SCHED;
            PG8_LDB(B1, 1, 1); PG8_STAGE(PG8_SB(1, 0), b3, voffB);
            PG8_BAR; PG8_WAIT_L(0); PG8_MMA(0, 1, At, B1); PG8_BAR;
            PG8_LDA(At, 1, 1); PG8_STAGE(PG8_SA(1, 0), a3, voffA);
            PG8_BAR; PG8_WAIT_L(0); PG8_MMA(1, 0, At, B0); PG8_BAR; PG8_SCHED;
            PG8_STAGE(PG8_SB(1, 1), b3 + hstep, voffB);
            PG8_WAIT_V(6); PG8_BAR; PG8_MMA(1, 1, At, B1); PG8_BAR;
            }
        }
        if constexpr (ALIGN_EPI) { if (wr == 0) PG8_BAR; }
        if constexpr (!Epi::AFTER_DRAIN) { E(acc, cur, wr, wc, fr, fq); S.done(cur); }
        if (!has_next) break;
#pragma unroll
        for (int a = 0; a < 2; ++a)
#pragma unroll
            for (int b = 0; b < 2; ++b)
#pragma unroll
                for (int m = 0; m < 4; ++m)
#pragma unroll
                    for (int n = 0; n < 2; ++n) acc[a][b][m][n] = (f32x4){0.f, 0.f, 0.f, 0.f};
        cur = nxt; cA = nA; cB = nB; ++ui;
        if constexpr (ALIGN_EPI) { if (wr == 1) PG8_BAR; }
    }
    PG8_WAIT_V(0);
    if constexpr (!ALIGN_EPI) { if (wr == 0) PG8_BAR; }
    PG8_BAR;
    if constexpr (Epi::AFTER_DRAIN) { E.fused(acc, cur, wr, wc, fr, fq, lds, wid, lane); S.done(cur); }
#undef PG8_SA
#undef PG8_SB
#undef PG8_STAGE
#undef PG8_LDA
#undef PG8_LDB
#undef PG8_MMA
#undef PG8_WAIT_V
#undef PG8_WAIT_L
#undef PG8_BAR
#undef PG8_SCHED
}
}
#ifndef PEER_FP8
#define PEER_FP8 1
#endif
#ifndef MK_N_LAUNCHES
#define MK_N_LAUNCHES 1
#endif
constexpr int NPHASE = 11;
constexpr int N_LAUNCHES = MK_N_LAUNCHES;

constexpr int NB = 8, SEQ = 4096, D = 1024, T = NB * SEQ, CTXL = 256, TC = NB * CTXL, MROWS = T + TC;
constexpr int NCC = 34;
constexpr int IN_COLS = 2576, DT_COL0 = 1536, GLU_COL0 = 1552;
constexpr int NEXP = 16384;
constexpr float EPS = 1e-6f;

constexpr size_t MiB = 1u << 20;
constexpr size_t WS_CTL = 0, CTL_ZERO_BYTES = 64 * 1024;
constexpr size_t WS_MODV = 1 * MiB;
constexpr size_t WS_CS = 2 * MiB;
constexpr size_t WS_DEC = 4 * MiB;
constexpr size_t WS_DT = 5 * MiB;
constexpr size_t WS_USC = 7 * MiB + 256 * 1024, WS_VSC = 7 * MiB + 512 * 1024;
constexpr size_t WS_WIN = 8 * MiB;
constexpr size_t WS_WOUT = 13 * MiB;
constexpr size_t WS_WC = 15 * MiB;
constexpr size_t WS_U = 20 * MiB, WS_V = 52 * MiB;
constexpr size_t WS_XN = 84 * MiB;
constexpr size_t WS_XBC = 152 * MiB;
constexpr size_t WS_ZS = 220 * MiB;
constexpr size_t WS_UGLU = 252 * MiB;
constexpr size_t WS_YD = 284 * MiB;
constexpr size_t WS_SLOC = 316 * MiB;
constexpr size_t WS_CONVO = 384 * MiB;
constexpr size_t WS_CCONV = 416 * MiB;
constexpr size_t WS_SC = 152 * MiB;
constexpr size_t WS_X1B = 284 * MiB;
constexpr size_t WS_EIDX = 432 * MiB;
constexpr size_t WS_GATE = 448 * MiB;
constexpr size_t WS_USA = 464 * MiB;
constexpr size_t WS_END = 480 * MiB;
constexpr int CW_BAR = 4096;

constexpr int RING_BYTES = 131072, LDSCTL_OFF = 143360, MISC_OFF = LDSCTL_OFF + 320, LDS_BYTES = 147456;

#define GAS __attribute__((address_space(1)))
#define LAS __attribute__((address_space(3)))
typedef unsigned short bf16;
typedef unsigned v4u __attribute__((ext_vector_type(4)));
typedef unsigned v2u __attribute__((ext_vector_type(2)));
typedef float f32x4 __attribute__((ext_vector_type(4)));
typedef float f32x2 __attribute__((ext_vector_type(2)));
typedef short bf16x8 __attribute__((ext_vector_type(8)));
typedef GAS unsigned gu32;
#define RLX_AGENT __ATOMIC_RELAXED, __HIP_MEMORY_SCOPE_AGENT
__device__ __forceinline__ unsigned f2bf(float f) { unsigned u = __builtin_bit_cast(unsigned, f); return (u + 0x7fffu + ((u >> 16) & 1u)) >> 16; }
typedef __bf16 bf16x2_t __attribute__((ext_vector_type(2)));
__device__ __forceinline__ unsigned pk2(float lo, float hi) { const f32x2 v = {lo, hi}; return __builtin_bit_cast(unsigned, __builtin_convertvector(v, bf16x2_t)); }
__device__ __forceinline__ float bflo(unsigned u) { return __builtin_bit_cast(float, u << 16); }
__device__ __forceinline__ float bfhi(unsigned u) { return __builtin_bit_cast(float, u & 0xffff0000u); }
template <int CTRL> __device__ __forceinline__ float dppf(float x) { return __builtin_bit_cast(float, __builtin_amdgcn_mov_dpp(__builtin_bit_cast(int, x), CTRL, 0xf, 0xf, true)); }
__device__ __forceinline__ float swapsum32(float a, float b) { auto r = __builtin_amdgcn_permlane32_swap(__builtin_bit_cast(unsigned, a), __builtin_bit_cast(unsigned, b), false, false); const unsigned r0 = r[0], r1 = r[1]; return __uint_as_float(r0) + __uint_as_float(r1); }
__device__ __forceinline__ float swapsum16(float a, float b) { auto r = __builtin_amdgcn_permlane16_swap(__builtin_bit_cast(unsigned, a), __builtin_bit_cast(unsigned, b), false, false); const unsigned r0 = r[0], r1 = r[1]; return __uint_as_float(r0) + __uint_as_float(r1); }
__device__ __forceinline__ float allsumf8(float m) { m += dppf<0xB1>(m); m += dppf<0x4E>(m); m += dppf<0x141>(m); return m; }
__device__ __forceinline__ float allsumf16(float m) { m = allsumf8(m); m += dppf<0x140>(m); return m; }
__device__ __forceinline__ float wave_sum(float v) { v = allsumf16(v); v = swapsum16(v, v); return swapsum32(v, v); }
__device__ __forceinline__ void wave_tsum16(float (&p)[16], int lane) {
#pragma unroll
    for (int k = 0; k < 8; ++k) p[k] = swapsum32(p[k], p[k + 8]);
#pragma unroll
    for (int k = 0; k < 4; ++k) p[k] = swapsum16(p[k], p[k + 4]);
    const bool up = (lane & 8) != 0;
#pragma unroll
    for (int k = 0; k < 2; ++k) { const float snd = up ? p[k] : p[k + 2]; const float keep = up ? p[k + 2] : p[k]; p[k] = keep + dppf<0x128>(snd); }
    p[0] = allsumf8(p[0]); p[1] = allsumf8(p[1]);
}
__device__ __forceinline__ size_t x1b_off(int r, int c) { return ((size_t)(r >> 4) * 32 + (c >> 5)) * 512 + (r & 15) * 32 + (c & 31); }
__device__ __forceinline__ float silu_f(float x) { return x * __builtin_amdgcn_rcpf(1.f + __expf(-x)); }
__device__ __forceinline__ float sigmoid_f(float x) { return __builtin_amdgcn_rcpf(1.f + __expf(-x)); }
__device__ __forceinline__ float softplus_f(float x) { return fmaxf(x, 0.f) + log1pf(__expf(-fabsf(x))); }
__device__ __forceinline__ float gelu_f(float x) { return 0.5f * x * (1.f + erff(x * 0.70710678118654752f)); }

#define XB_TMO      128
#define XB_XCNT(j)  (256  + 64 * (j))
#define XB_XSUB(j)  (1280 + 64 * (j))
#define XB_XGEN(j)  (2304 + 64 * (j))
#define XB_TOP      3328
#define XB_TOPGEN   3392
#define XCD_BAR_WORDS 3456
#define XB_SPIN_CAP (1u << 22)
__device__ __forceinline__ unsigned xb_ld(unsigned* p)              { return __hip_atomic_load(p, __ATOMIC_RELAXED, __HIP_MEMORY_SCOPE_AGENT); }
__device__ __forceinline__ unsigned xb_add(unsigned* p, unsigned v) { return __hip_atomic_fetch_add(p, v, __ATOMIC_RELAXED, __HIP_MEMORY_SCOPE_AGENT); }
__device__ __forceinline__ unsigned xb_xcc_id() { return (unsigned)__builtin_amdgcn_s_getreg((3 << 11) | 20) & 0xFu; }
#define XB_SPIN(cond, bar) do { unsigned _sp = 0; while (cond) { __builtin_amdgcn_s_sleep(1); \
    if ((++_sp & 255u) == 0u) { if (xb_ld(&(bar)[XB_TMO])) break; if (_sp > XB_SPIN_CAP) { atomicAdd(&(bar)[XB_TMO], 1u); break; } } } } while (0)

struct XcdBarrier {
    unsigned* bar; unsigned x;
    volatile LAS unsigned* st;
};

__device__ __forceinline__ XcdBarrier xcd_barrier_post(unsigned* bar, volatile LAS unsigned* st) {
    XcdBarrier b; b.bar = bar; b.x = xb_xcc_id(); b.st = st;
    if (threadIdx.x == 0) (void)xb_add(&bar[XB_XCNT(b.x)], 1u);
    return b;
}
__device__ __forceinline__ void xcd_barrier_complete(unsigned* bar, unsigned x, unsigned& nloc, unsigned& nx) {
    const unsigned G = gridDim.x * gridDim.y * gridDim.z;
    unsigned sum, cnt, mine, sp = 0u;
    for (;;) {
        sum = 0u; cnt = 0u; mine = 0u;
#pragma unroll
        for (unsigned j = 0; j < 16; ++j) { const unsigned c = xb_ld(&bar[XB_XCNT(j)]); sum += c; cnt += (c > 0u) ? 1u : 0u; mine = (j == x) ? c : mine; }
        if (sum == G) break;
        __builtin_amdgcn_s_sleep(1);
        if ((++sp & 255u) == 0u) { if (xb_ld(&bar[XB_TMO])) break; if (sp > XB_SPIN_CAP) { atomicAdd(&bar[XB_TMO], 1u); break; } }
    }
    nloc = mine > 0u ? mine : 1u; nx = cnt > 0u ? cnt : 1u;
}

__device__ __forceinline__ void xcd_barrier(const XcdBarrier& b) {
    asm volatile("s_waitcnt vmcnt(0)" ::: "memory");
    __syncthreads();
    if (threadIdx.x == 0) {
        unsigned* bar = b.bar;
        __builtin_amdgcn_s_waitcnt(0);
        unsigned nloc = b.st[0], nx = b.st[1];
        if (nloc == 0u) { xcd_barrier_complete(bar, b.x, nloc, nx); b.st[0] = nloc; b.st[1] = nx; }
        const unsigned old = xb_add(&bar[XB_XSUB(b.x)], 1u);
        const unsigned gen = old / nloc;
        if (old + 1u == (gen + 1u) * nloc) {
            __builtin_amdgcn_fence(__ATOMIC_RELEASE, "agent");
            asm volatile("s_waitcnt vmcnt(0)" ::: "memory");
            const unsigned og = xb_add(&bar[XB_TOP], 1u);
            const unsigned tg = og / nx;
            if (og + 1u == (tg + 1u) * nx) xb_add(&bar[XB_TOPGEN], 1u);
            else XB_SPIN(xb_ld(&bar[XB_TOPGEN]) == tg, bar);
            __builtin_amdgcn_fence(__ATOMIC_ACQUIRE, "agent");
            xb_add(&bar[XB_XGEN(b.x)], 1u);
            asm volatile("s_waitcnt vmcnt(0)" ::: "memory");
        } else {
            XB_SPIN(xb_ld(&bar[XB_XGEN(b.x)]) == gen, bar);
            __builtin_amdgcn_fence(__ATOMIC_ACQUIRE, "agent");
            asm volatile("s_waitcnt vmcnt(0)" ::: "memory");
        }
    }
    __syncthreads();
}
struct EpiInProj {
    static constexpr bool PERM = true, AFTER_DRAIN = false;
    bf16* ZS; bf16* XBC; bf16* UG;
    __device__ __forceinline__ void operator()(const pg8::f32x4 (&acc)[2][2][4][2], const pg8::Unit& u, int wr, int wc, int fr, int fq) const {
        const int row0 = u.pm * 256 + wr * 64 + fr, cl0 = wc * 32 + 8 * fq;
        if (u.pn < 2) {
#pragma unroll
            for (int ai = 0; ai < 2; ++ai)
#pragma unroll
                for (int m = 0; m < 4; ++m) { bf16* rowp = ZS + (size_t)(row0 + ai * 128 + m * 16) * 512 + u.pn * 256 + cl0;
#pragma unroll
                    for (int bj = 0; bj < 2; ++bj) { const pg8::f32x4 a = acc[ai][bj][m][0], b = acc[ai][bj][m][1]; v4u w;
                        w.x = pk2(silu_f(a[0]), silu_f(a[1])); w.y = pk2(silu_f(a[2]), silu_f(a[3])); w.z = pk2(silu_f(b[0]), silu_f(b[1])); w.w = pk2(silu_f(b[2]), silu_f(b[3]));
                        *(v4u*)(rowp + bj * 128) = w; } }
        } else if (u.pn < 6) {
#pragma unroll
            for (int ai = 0; ai < 2; ++ai)
#pragma unroll
                for (int m = 0; m < 4; ++m) { bf16* rowp = XBC + (size_t)(row0 + ai * 128 + m * 16) * 1024 + (u.pn - 2) * 256 + cl0;
#pragma unroll
                    for (int bj = 0; bj < 2; ++bj) { const pg8::f32x4 a = acc[ai][bj][m][0], b = acc[ai][bj][m][1]; v4u w;
                        w.x = pk2(a[0], a[1]); w.y = pk2(a[2], a[3]); w.z = pk2(b[0], b[1]); w.w = pk2(b[2], b[3]);
                        *(v4u*)(rowp + bj * 128) = w; } }
        } else {
            const int ch0 = 128 * (u.pn - 6) + 16 * wc + 4 * fq;
#pragma unroll
            for (int ai = 0; ai < 2; ++ai)
#pragma unroll
                for (int m = 0; m < 4; ++m) { bf16* rowp = UG + (size_t)(row0 + ai * 128 + m * 16) * 512 + ch0;
#pragma unroll
                    for (int bj = 0; bj < 2; ++bj) { const pg8::f32x4 a = acc[ai][bj][m][0], g = acc[ai][bj][m][1]; v2u w;
                        w.x = pk2(a[0] * sigmoid_f(g[0]), a[1] * sigmoid_f(g[1])); w.y = pk2(a[2] * sigmoid_f(g[2]), a[3] * sigmoid_f(g[3]));
                        *(v2u*)(rowp + bj * 64) = w; } }
        }
    }
};
struct EpiOutProj {
    static constexpr bool PERM = true, AFTER_DRAIN = false;
    const float* X; bf16* X1; float* MODV;
    __device__ __forceinline__ void operator()(const pg8::f32x4 (&acc)[2][2][4][2], const pg8::Unit& u, int wr, int wc, int fr, int fq) const {
        const int row0 = u.pm * 256 + wr * 64 + fr, col0 = u.pn * 256 + wc * 32 + 8 * fq;
        const float* gp = MODV + (size_t)(row0 >> 12) * 6144 + 2 * 1024 + col0;
        pg8::f32x4 g[2][2];
#pragma unroll
        for (int bj = 0; bj < 2; ++bj) { g[bj][0] = *(const pg8::f32x4*)(gp + bj * 128); g[bj][1] = *(const pg8::f32x4*)(gp + bj * 128 + 4); }
#pragma unroll
        for (int ai = 0; ai < 2; ++ai) {
            pg8::f32x4 xv[4][2][2];
#pragma unroll
            for (int m = 0; m < 4; ++m) { const size_t o = (size_t)(row0 + ai * 128 + m * 16) * 1024 + col0;
#pragma unroll
                for (int bj = 0; bj < 2; ++bj) { xv[m][bj][0] = *(const pg8::f32x4*)(X + o + bj * 128); xv[m][bj][1] = *(const pg8::f32x4*)(X + o + bj * 128 + 4); } }
#pragma unroll
            for (int m = 0; m < 4; ++m) { const size_t o = (size_t)(row0 + ai * 128 + m * 16) * 1024 + col0;
#pragma unroll
                for (int bj = 0; bj < 2; ++bj) {
                    const pg8::f32x4 y0 = xv[m][bj][0] + g[bj][0] * acc[ai][bj][m][0], y1 = xv[m][bj][1] + g[bj][1] * acc[ai][bj][m][1];
                    v4u w; w.x = pk2(y0[0], y0[1]); w.y = pk2(y0[2], y0[3]); w.z = pk2(y1[0], y1[1]); w.w = pk2(y1[2], y1[3]);
                    *(v4u*)(X1 + ((size_t)(u.pm * 16 + ai * 8 + wr * 4 + m) * 32 + u.pn * 8 + bj * 4 + wc) * 512 + fr * 32 + 8 * fq) = w; } } }
    }
};
struct EpiScore {
    static constexpr bool PERM = true, AFTER_DRAIN = false;
    _Float16* SC;
    __device__ __forceinline__ void operator()(const pg8::f32x4 (&acc)[2][2][4][2], const pg8::Unit& u, int wr, int wc, int fr, int fq) const {
        const int row0 = u.pm * 256 + wr * 64 + fr, col0 = u.pn * 256 + wc * 32 + 8 * fq;
        typedef _Float16 h8 __attribute__((ext_vector_type(8)));
#pragma unroll
        for (int ai = 0; ai < 2; ++ai)
#pragma unroll
            for (int m = 0; m < 4; ++m) { const int rb = u.pm * 16 + ai * 8 + wr * 4 + m;
#pragma unroll
                for (int bj = 0; bj < 2; ++bj) { const pg8::f32x4 a = acc[ai][bj][m][0], b = acc[ai][bj][m][1]; const int cb = u.pn * 8 + bj * 4 + wc;
                    h8 o = {(_Float16)a[0], (_Float16)a[1], (_Float16)a[2], (_Float16)a[3], (_Float16)b[0], (_Float16)b[1], (_Float16)b[2], (_Float16)b[3]};
                    *(h8*)(SC + ((size_t)rb * (T / 32) + cb) * 512 + fr * 32 + 8 * fq) = o; } }
    }
};
struct InProjOrder {
    pg8::StaticOrder S; int G, c;
    __device__ void init(int G_, int c_) { S.init(T, 2560, G_, c_); G = G_; c = c_; }
    __device__ bool next(int i, pg8::Unit& u) const {
        const long L = (long)i * G + c;
        if (L < 1280) return S.next(i, u);
        if (L >= 1312) return false;
        const int l2 = (int)L - 1280; u.pm = 128 + (l2 >> 2); u.pn = 2 + (l2 & 3); return true;
    }
    __device__ __forceinline__ void a_ready(const pg8::Unit&) const {}
    __device__ __forceinline__ void done(const pg8::Unit&) const {}
};
struct Args { const float* in[25]; float* out; unsigned char* ws; int ph_lo, ph_hi, li, pad; };
enum { I_X = 0, I_C, I_CTX, I_CCTX, I_ADAW, I_ADAB, I_N1W, I_N2W, I_WIN, I_SCW, I_SCB, I_DTB, I_ALOG, I_SSD, I_SNW, I_CCW, I_CCB, I_CLW, I_CLB, I_WOUT, I_WQ, I_SK, I_PU, I_PV, I_FNW };

__device__ __forceinline__ void p0_mod(const Args& A, LAS unsigned char* lds, int tid) {
    LAS float* s = (LAS float*)lds;
    LAS float* red = (LAS float*)(lds + 36864);
    const float* c = A.in[I_C]; const float* cctx = A.in[I_CCTX]; const float* adaw = A.in[I_ADAW]; const float* adab = A.in[I_ADAB];
    float* MODV = (float*)(A.ws + WS_MODV);
    for (int item = blockIdx.x; item < 192; item += gridDim.x) {
        for (int i = tid; i < 9 * 1024; i += 512) { const int b = i >> 10, k = i & 1023; const float v = (b < 8) ? c[b * 1024 + k] : cctx[k]; s[i] = silu_f(v); }
        __syncthreads();
        const int chunk = tid & 7, rg = tid >> 3, col = item * 32 + chunk * 4;
        f32x4 acc[9];
#pragma unroll
        for (int b = 0; b < 9; ++b) acc[b] = (f32x4){0.f, 0.f, 0.f, 0.f};
#pragma unroll 4
        for (int i = 0; i < 16; ++i) { const int r = rg + 64 * i; const f32x4 w = *(const f32x4*)(adaw + (size_t)r * 6144 + col);
#pragma unroll
            for (int b = 0; b < 9; ++b) acc[b] += w * s[b * 1024 + r]; }
#pragma unroll
        for (int b = 0; b < 9; ++b) *(LAS f32x4*)(red + (rg * 9 + b) * 32 + chunk * 4) = acc[b];
        __syncthreads();
        if (tid < 288) { const int b = tid >> 5, cc = tid & 31; float sum = 0.f;
            for (int r2 = 0; r2 < 64; ++r2) sum += red[(r2 * 9 + b) * 32 + cc];
            MODV[b * 6144 + item * 32 + cc] = sum + adab[item * 32 + cc]; }
        __syncthreads();
    }
}
__device__ __forceinline__ int win_dest(int n) {
    if (n < 1536) return n;
    int ch = n - GLU_COL0;
    if (ch < 512) return 1536 + 8 * (ch >> 2) + (ch & 3);
    ch -= 512; return 1536 + 8 * (ch >> 2) + 4 + (ch & 3);
}
template <int MODE>
__device__ __forceinline__ void transpose_item(const float* W, int ldw, int k0, int n0, bf16* WT, LAS float* scr, int lane) {
#pragma unroll 8
    for (int i = 0; i < 32; ++i) { const int kk = 2 * i + (lane >> 5); scr[kk * 33 + (lane & 31)] = W[(size_t)(k0 + kk) * ldw + n0 + (lane & 31)]; }
    asm volatile("s_waitcnt lgkmcnt(0)" ::: "memory");
    const int c = lane & 7;
#pragma unroll
    for (int j = 0; j < 4; ++j) { const int n = (lane >> 3) + 8 * j; const LAS float* sp = scr + (8 * c) * 33 + n;
        v4u o; o.x = pk2(sp[0 * 33], sp[1 * 33]); o.y = pk2(sp[2 * 33], sp[3 * 33]); o.z = pk2(sp[4 * 33], sp[5 * 33]); o.w = pk2(sp[6 * 33], sp[7 * 33]);
        const int row = (MODE == 1) ? win_dest(n0 + n) : (n0 + n);
        *(v4u*)(WT + (size_t)row * 1024 + k0 + 8 * c) = o; }
    asm volatile("s_waitcnt lgkmcnt(0)" ::: "memory");
}
__device__ __forceinline__ void p0_weights(const Args& A, LAS unsigned char* lds, int tid, int wave, int lane) {
    LAS float* scr = (LAS float*)(lds + wave * 16384);
    const int gw = blockIdx.x * 8 + wave, NGW = gridDim.x * 8;
    bf16* WIN = (bf16*)(A.ws + WS_WIN); bf16* WOUT = (bf16*)(A.ws + WS_WOUT);
    for (int it = gw; it < 80 * 16 + 32 * 16; it += NGW) {
        if (it < 80 * 16) { const int nb = it >> 4, kb = it & 15; const int n0 = nb < 48 ? 32 * nb : GLU_COL0 + 32 * (nb - 48);
            transpose_item<1>(A.in[I_WIN], IN_COLS, 64 * kb, n0, WIN, scr, lane); }
        else { const int r = it - 80 * 16; transpose_item<0>(A.in[I_WOUT], 1024, 64 * (r & 15), 32 * (r >> 4), WOUT, scr, lane); }
    }
    const float* pu = A.in[I_PU]; const float* pv = A.in[I_PV];
#if PEER_FP8
    for (int row = gw; row < 2 * NEXP; row += NGW) {
        const int r = row & (NEXP - 1); const bool isv = row >= NEXP;
        const float* src = (isv ? pv : pu) + (size_t)r * 1024 + 4 * lane;
        f32x4 v[4]; float am = 0.f;
#pragma unroll
        for (int j = 0; j < 4; ++j) { v[j] = *(const f32x4*)(src + 256 * j); am = fmaxf(am, fmaxf(fmaxf(fabsf(v[j][0]), fabsf(v[j][1])), fmaxf(fabsf(v[j][2]), fabsf(v[j][3])))); }
#pragma unroll
        for (int o = 1; o < 64; o <<= 1) am = fmaxf(am, __shfl_xor(am, o));
        const float inv = am > 0.f ? 440.f / am : 0.f;
        unsigned char* dst = A.ws + (isv ? WS_V : WS_U) + (size_t)r * 1024 + 4 * lane;
        if (isv) {
#pragma unroll
            for (int j = 0; j < 4; ++j) { int w = __builtin_amdgcn_cvt_pk_fp8_f32(v[j][0] * inv, v[j][1] * inv, 0, false); w = __builtin_amdgcn_cvt_pk_fp8_f32(v[j][2] * inv, v[j][3] * inv, w, true);
                *(unsigned*)(dst + 256 * j) = (unsigned)w; }
            if (lane == 0) ((float*)(A.ws + WS_VSC))[r] = am * (1.f / 440.f);
        } else {
            const float inv8 = am > 0.f ? 127.f / am : 0.f;
#pragma unroll
            for (int j = 0; j < 4; ++j) { const unsigned w = ((unsigned)__float2int_rn(v[j][0] * inv8) & 255u) | (((unsigned)__float2int_rn(v[j][1] * inv8) & 255u) << 8)
                                                        | (((unsigned)__float2int_rn(v[j][2] * inv8) & 255u) << 16) | (((unsigned)__float2int_rn(v[j][3] * inv8) & 255u) << 24);
                *(unsigned*)(dst + 256 * j) = w; }
            if (lane == 0) ((float*)(A.ws + WS_USC))[r] = am * (1.f / 127.f);
        }
    }
#else
    bf16* U = (bf16*)(A.ws + WS_U); bf16* V = (bf16*)(A.ws + WS_V);
    const size_t nthr = (size_t)gridDim.x * 512, gt = (size_t)blockIdx.x * 512 + tid;
    for (size_t i = gt; i < (size_t)NEXP * 1024 / 8; i += nthr) {
        const f32x4 a = *(const f32x4*)(pu + i * 8), b = *(const f32x4*)(pu + i * 8 + 4);
        v4u o; o.x = pk2(a[0], a[1]); o.y = pk2(a[2], a[3]); o.z = pk2(b[0], b[1]); o.w = pk2(b[2], b[3]); *(v4u*)(U + i * 8) = o;
        const f32x4 c2 = *(const f32x4*)(pv + i * 8), d2 = *(const f32x4*)(pv + i * 8 + 4);
        v4u q; q.x = pk2(c2[0], c2[1]); q.y = pk2(c2[2], c2[3]); q.z = pk2(d2[0], d2[1]); q.w = pk2(d2[2], d2[3]); *(v4u*)(V + i * 8) = q;
    }
#endif
}
__device__ __forceinline__ void p0_wc(const Args& A, LAS unsigned char* lds, int tid) {
    LAS float* wqs = (LAS float*)lds;
    LAS float* sks = (LAS float*)(lds + 32768);
    const float* wq = A.in[I_WQ]; const float* sk = A.in[I_SK]; bf16* WC = (bf16*)(A.ws + WS_WC);
    for (int item = blockIdx.x; item < 256; item += gridDim.x) {
        const int hp = item >> 4, k0 = (item & 15) * 64;
        __syncthreads();
        for (int i = tid; i < 64 * 32; i += 512) { const int kk = i >> 5, d4 = i & 31; *(LAS f32x4*)(wqs + kk * 128 + 4 * d4) = *(const f32x4*)(wq + (size_t)(k0 + kk) * 2048 + hp * 128 + 4 * d4); }
        for (int i = tid; i < 128 * 32; i += 512) { const int j = i >> 5, d4 = i & 31; *(LAS f32x4*)(sks + j * 132 + 4 * d4) = *(const f32x4*)(sk + (size_t)(hp * 128 + j) * 128 + 4 * d4); }
        __syncthreads();
        const int j = tid & 127, kq = tid >> 7;
        float acc[16];
#pragma unroll
        for (int i = 0; i < 16; ++i) acc[i] = 0.f;
        for (int d4 = 0; d4 < 32; ++d4) { const f32x4 sv = *(LAS f32x4*)(sks + j * 132 + 4 * d4);
#pragma unroll
            for (int i = 0; i < 16; ++i) { const f32x4 wv = *(LAS f32x4*)(wqs + (kq * 16 + i) * 128 + 4 * d4); acc[i] += sv[0] * wv[0] + sv[1] * wv[1] + sv[2] * wv[2] + sv[3] * wv[3]; } }
        v4u o0, o1; o0.x = pk2(acc[0], acc[1]); o0.y = pk2(acc[2], acc[3]); o0.z = pk2(acc[4], acc[5]); o0.w = pk2(acc[6], acc[7]);
        o1.x = pk2(acc[8], acc[9]); o1.y = pk2(acc[10], acc[11]); o1.z = pk2(acc[12], acc[13]); o1.w = pk2(acc[14], acc[15]);
        bf16* dst = WC + (size_t)(hp * 128 + j) * 1024 + k0 + kq * 16;
        *(v4u*)dst = o0; *(v4u*)(dst + 8) = o1;
    }
}

__device__ __forceinline__ void p1_norm(const Args& A, LAS unsigned char* lds, int tid, int wave, int lane, int wg0) {
    LAS float* wdt = (LAS float*)lds;
    const float* win = A.in[I_WIN];
    for (int i = tid; i < 16384; i += 512) { const int k = i >> 4, c = i & 15; wdt[c * 1024 + k] = win[(size_t)k * IN_COLS + DT_COL0 + c]; }
    __syncthreads();
    const float* x = A.in[I_X]; const float* ctx = A.in[I_CTX]; const float* n1w = A.in[I_N1W]; const float* dtb = A.in[I_DTB];
    float* MODV = (float*)(A.ws + WS_MODV); bf16* XN = (bf16*)(A.ws + WS_XN); float* DT = (float*)(A.ws + WS_DT);
    const int gw = ((int)blockIdx.x - wg0) * 8 + wave, NGW = ((int)gridDim.x - wg0) * 8;
    f32x4 nx[4];
    if (gw < MROWS) { const float* xr = gw < T ? x + (size_t)gw * 1024 : ctx + (size_t)(gw - T) * 1024;
#pragma unroll
        for (int j = 0; j < 4; ++j) nx[j] = *(const f32x4*)(xr + 4 * lane + 256 * j); }
    const int myc = 8 * ((lane >> 5) & 1) + 4 * ((lane >> 4) & 1) + 2 * ((lane >> 3) & 1) + (lane & 1);
    const float mybias = dtb[myc];
    for (int row = gw; row < MROWS; row += NGW) {
        const float* mp = MODV + (size_t)(row < T ? (row >> 12) : 8) * 6144;
        f32x4 v[4]; float ss = 0.f;
#pragma unroll
        for (int j = 0; j < 4; ++j) { v[j] = nx[j]; ss += v[j][0] * v[j][0] + v[j][1] * v[j][1] + v[j][2] * v[j][2] + v[j][3] * v[j][3]; }
        { const int rn = row + NGW < MROWS ? row + NGW : row;
          const float* xr = rn < T ? x + (size_t)rn * 1024 : ctx + (size_t)(rn - T) * 1024;
#pragma unroll
          for (int j = 0; j < 4; ++j) nx[j] = *(const f32x4*)(xr + 4 * lane + 256 * j); }
        const float rstd = rsqrtf(wave_sum(ss) * (1.f / 1024.f) + EPS);
#pragma unroll
        for (int j = 0; j < 4; ++j) { const int col = 4 * lane + 256 * j;
            const f32x4 nw = *(const f32x4*)(n1w + col), sh = *(const f32x4*)(mp + col), sc = *(const f32x4*)(mp + 1024 + col);
            v[j] = v[j] * rstd * nw * (sc + 1.f) + sh;
            v2u o; o.x = pk2(v[j][0], v[j][1]); o.y = pk2(v[j][2], v[j][3]); *(v2u*)(XN + (size_t)row * 1024 + col) = o; }
        float p[16];
#pragma unroll
        for (int c = 0; c < 16; ++c) { float q = 0.f;
            if ((c & 3) == 0) asm volatile("" ::: "memory");
#pragma unroll
            for (int j = 0; j < 4; ++j) { const f32x4 w4 = *(LAS f32x4*)(wdt + c * 1024 + 4 * lane + 256 * j); q += v[j][0] * w4[0] + v[j][1] * w4[1] + v[j][2] * w4[2] + v[j][3] * w4[3]; }
            p[c] = q; }
        wave_tsum16(p, lane);
        if ((lane & 6) == 0) DT[(size_t)row * 16 + myc] = softplus_f(((lane & 1) ? p[1] : p[0]) + mybias);
    }
}
constexpr int LROW = 272;
constexpr int XT_OFF = 0, BM_OFF = 17408, BT_OFF = 52224, CM_OFF = 87040, SCAL_OFF = 121856;
__device__ __forceinline__ float bfe(const v4u& v, int i) { const unsigned w = v[i >> 1]; return (i & 1) ? bfhi(w) : bflo(w); }
__device__ __forceinline__ pg8::f32x4 mfma16(const v4u& a, const v4u& b, const pg8::f32x4& c) {
    return __builtin_amdgcn_mfma_f32_16x16x32_bf16(__builtin_bit_cast(bf16x8, a), __builtin_bit_cast(bf16x8, b), c, 0, 0, 0); }

__device__ __forceinline__ void ssd_stage_kind(const Args& A, LAS unsigned char* lds, int kind, int h, int g, size_t row0, int t0, int L, int tid) {
    if (kind == 0 && tid >= 256) return;
    const bf16* XBC = (const bf16*)(A.ws + WS_XBC);
    const int pair = kind == 0 ? (tid & 31) : (tid & 63), sg = kind == 0 ? (tid >> 5) : (tid >> 6);
    const int nl = 2 * pair;
    const int gch = (kind == 0 ? 64 * h : (kind == 1 ? 512 + 128 * g : 768 + 128 * g)) + nl;
    const float* scw = A.in[I_SCW] + gch; const float* scb = A.in[I_SCB] + gch;
    float w0[5], w1[5];
#pragma unroll
    for (int k = 0; k < 5; ++k) { w0[k] = scw[k * 1024]; w1[k] = scw[k * 1024 + 1]; }
    const float b0 = scb[0], b1 = scb[1];
    float lo[20], hi[20];
#pragma unroll
    for (int i = 0; i < 20; ++i) { const int tl = t0 + 16 * sg - 2 + i;
        const unsigned raw = (tl >= 0 && tl < L) ? *(const unsigned*)(XBC + (row0 + tl) * 1024 + gch) : 0u;
        lo[i] = bflo(raw); hi[i] = bfhi(raw); }
    float s0[16], s1[16];
#pragma unroll
    for (int o = 0; o < 16; ++o) { float a0 = b0, a1 = b1;
#pragma unroll
        for (int k = 0; k < 5; ++k) { a0 += w0[k] * lo[o + k]; a1 += w1[k] * hi[o + k]; }
        s0[o] = silu_f(a0); s1[o] = silu_f(a1); }
    if (kind != 2) {
        LAS unsigned char* base = lds + (kind == 0 ? XT_OFF : BT_OFF) + nl * LROW + 32 * sg;
        v4u a, bb, c2, d2;
        a.x = pk2(s0[0], s0[1]); a.y = pk2(s0[2], s0[3]); a.z = pk2(s0[4], s0[5]); a.w = pk2(s0[6], s0[7]);
        bb.x = pk2(s0[8], s0[9]); bb.y = pk2(s0[10], s0[11]); bb.z = pk2(s0[12], s0[13]); bb.w = pk2(s0[14], s0[15]);
        c2.x = pk2(s1[0], s1[1]); c2.y = pk2(s1[2], s1[3]); c2.z = pk2(s1[4], s1[5]); c2.w = pk2(s1[6], s1[7]);
        d2.x = pk2(s1[8], s1[9]); d2.y = pk2(s1[10], s1[11]); d2.z = pk2(s1[12], s1[13]); d2.w = pk2(s1[14], s1[15]);
        *(LAS v4u*)base = a; *(LAS v4u*)(base + 16) = bb; *(LAS v4u*)(base + LROW) = c2; *(LAS v4u*)(base + LROW + 16) = d2;
    }
    if (kind != 0) {
        LAS unsigned char* base = lds + (kind == 1 ? BM_OFF : CM_OFF) + (16 * sg) * LROW + nl * 2;
#pragma unroll
        for (int o = 0; o < 16; ++o) *(LAS unsigned*)(base + o * LROW) = pk2(s0[o], s1[o]);
    }
}

__device__ __forceinline__ void ssd_stage_x(const Args& A, LAS unsigned char* lds, int h, size_t row0, int t0, int L, int tid) {
    const bf16* XBC = (const bf16*)(A.ws + WS_XBC);
    const int pair = tid & 31, sg = tid >> 5, nl = 2 * pair, gch = 64 * h + nl;
    const float* scw = A.in[I_SCW] + gch; const float* scb = A.in[I_SCB] + gch;
    float w0[5], w1[5];
#pragma unroll
    for (int k = 0; k < 5; ++k) { w0[k] = scw[k * 1024]; w1[k] = scw[k * 1024 + 1]; }
    const float b0 = scb[0], b1 = scb[1];
    float lo[12], hi[12];
#pragma unroll
    for (int i = 0; i < 12; ++i) { const int tl = t0 + 8 * sg - 2 + i;
        const unsigned raw = (tl >= 0 && tl < L) ? *(const unsigned*)(XBC + (row0 + tl) * 1024 + gch) : 0u;
        lo[i] = bflo(raw); hi[i] = bfhi(raw); }
    float s0[8], s1[8];
#pragma unroll
    for (int o = 0; o < 8; ++o) { float a0 = b0, a1 = b1;
#pragma unroll
        for (int k = 0; k < 5; ++k) { a0 += w0[k] * lo[o + k]; a1 += w1[k] * hi[o + k]; }
        s0[o] = silu_f(a0); s1[o] = silu_f(a1); }
    LAS unsigned char* base = lds + XT_OFF + nl * LROW + 16 * sg;
    v4u a, c2;
    a.x = pk2(s0[0], s0[1]); a.y = pk2(s0[2], s0[3]); a.z = pk2(s0[4], s0[5]); a.w = pk2(s0[6], s0[7]);
    c2.x = pk2(s1[0], s1[1]); c2.y = pk2(s1[2], s1[3]); c2.z = pk2(s1[4], s1[5]); c2.w = pk2(s1[6], s1[7]);
    *(LAS v4u*)base = a; *(LAS v4u*)(base + LROW) = c2;
}

__device__ __forceinline__ void ssd_local_item(const Args& A, LAS unsigned char* lds, int item, int tid, int wave, int lane) {
    int b, cc, g;
    if (item < NB * 32 * 2) { b = item >> 6; cc = 2 + ((item >> 1) & 31); g = item & 1; }
    else { const int j = item - NB * 32 * 2; b = j >> 2; cc = (j >> 1) & 1; g = j & 1; }
    const bool is_ctx = cc < 2; const int L = is_ctx ? CTXL : SEQ, c = is_ctx ? cc : cc - 2;
    const size_t row0 = is_ctx ? (size_t)T + (size_t)b * CTXL : (size_t)b * SEQ; const int t0 = c * 128;
    float* DT = (float*)(A.ws + WS_DT);
    LAS float* csf = (LAS float*)(lds + SCAL_OFF); LAS float* csb = csf + 128; LAS float* dtf = csf + 256; LAS float* dtb = csf + 384;
    const int fr = lane & 15, fq = lane >> 4;
    __syncthreads();
    ssd_stage_kind(A, lds, 1, 0, g, row0, t0, L, tid);
    if (!is_ctx) ssd_stage_kind(A, lds, 2, 0, g, row0, t0, L, tid);
    __syncthreads();
    if (!is_ctx) {
        v4u cf[4];
#pragma unroll
        for (int ks = 0; ks < 4; ++ks) cf[ks] = *(const LAS v4u*)(lds + CM_OFF + (16 * wave + fr) * LROW + (32 * ks + 8 * fq) * 2);
        pg8::f32x4 acc[8];
#pragma unroll
        for (int j = 0; j < 8; ++j) { acc[j] = (pg8::f32x4){0.f, 0.f, 0.f, 0.f};
#pragma unroll
            for (int ks = 0; ks < 4; ++ks) { const v4u bfv = *(const LAS v4u*)(lds + BM_OFF + (16 * j + fr) * LROW + (32 * ks + 8 * fq) * 2); acc[j] = mfma16(bfv, cf[ks], acc[j]); } }
        __syncthreads();
#pragma unroll
        for (int j = 0; j < 8; ++j) { v2u w; w.x = pk2(acc[j][0], acc[j][1]); w.y = pk2(acc[j][2], acc[j][3]);
            *(LAS v2u*)(lds + BM_OFF + (16 * wave + fr) * LROW + (16 * j + 4 * fq) * 2) = w; }
        bf16* CC = (bf16*)(A.ws + WS_CCONV);
        for (int i = tid; i < 128 * 16; i += 512) { const int r = i >> 4, c8 = i & 15;
            *(v4u*)(CC + (row0 + t0 + r) * 256 + g * 128 + c8 * 8) = *(const LAS v4u*)(lds + CM_OFF + r * LROW + c8 * 16); }
    }
#pragma unroll 1
    for (int hl = 0; hl < 4; ++hl) {
        const int h = 4 * g + hl;
        __syncthreads();
        if (wave == 5) {
            const float Af = -__expf(A.in[I_ALOG][h]);
            const float* dtp = DT + (row0 + t0) * 16 + h;
            const float d0 = dtp[(2 * lane) * 16], d1 = dtp[(2 * lane + 1) * 16];
            const float a0 = d0 * Af, x = a0 + d1 * Af; float incl = x;
#pragma unroll
            for (int o = 1; o < 64; o <<= 1) { const float v = __shfl_up(incl, o); if (lane >= o) incl += v; }
            const float excl = incl - x;
            csf[2 * lane] = excl + a0; csf[2 * lane + 1] = incl; dtf[2 * lane] = d0; dtf[2 * lane + 1] = d1;
            if (lane == 63) ((float*)(A.ws + WS_DEC))[((size_t)(b * NCC + cc) * 8 + h) * 2 + 0] = __expf(incl);
            if (!is_ctx) { float* CS = (float*)(A.ws + WS_CS) + (((size_t)(b * 32 + c) * 8 + h) * 2 + 0) * 128; CS[2 * lane] = excl + a0; CS[2 * lane + 1] = incl; }
        } else if (wave == 6) {
            const float Ab = -__expf(A.in[I_ALOG][8 + h]);
            const float* dtp = DT + (row0 + t0) * 16 + 8 + h;
            const float d0 = dtp[(2 * lane) * 16], d1 = dtp[(2 * lane + 1) * 16];
            const float a1 = d1 * Ab, x = d0 * Ab + a1; float incl = x;
#pragma unroll
            for (int o = 1; o < 64; o <<= 1) { const float v = __shfl_down(incl, o); if (lane + o < 64) incl += v; }
            const float excl = incl - x;
            csb[2 * lane + 1] = excl + a1; csb[2 * lane] = incl; dtb[2 * lane] = d0; dtb[2 * lane + 1] = d1;
            if (lane == 0) ((float*)(A.ws + WS_DEC))[((size_t)(b * NCC + cc) * 8 + h) * 2 + 1] = __expf(incl);
            if (!is_ctx) { float* CS = (float*)(A.ws + WS_CS) + (((size_t)(b * 32 + c) * 8 + h) * 2 + 1) * 128; CS[2 * lane + 1] = excl + a1; CS[2 * lane] = incl; }
        }
        ssd_stage_x(A, lds, h, row0, t0, L, tid);
        __syncthreads();
        if (!is_ctx) {
            const float Dh = A.in[I_SSD][h]; const int l = 16 * wave + fr; const float csfl = csf[l], csbl = csb[l];
            pg8::f32x4 yacc[4];
#pragma unroll
            for (int j = 0; j < 4; ++j) yacc[j] = (pg8::f32x4){0.f, 0.f, 0.f, 0.f};
#pragma unroll 2
            for (int ks = 0; ks < 4; ++ks) { const int s0 = 32 * ks + 8 * fq;
                const v4u g4 = *(const LAS v4u*)(lds + BM_OFF + l * LROW + s0 * 2);
                const f32x4 cfa = *(const LAS f32x4*)(csf + s0), cfb = *(const LAS f32x4*)(csf + s0 + 4), cba = *(const LAS f32x4*)(csb + s0), cbb = *(const LAS f32x4*)(csb + s0 + 4);
                const f32x4 dfa = *(const LAS f32x4*)(dtf + s0), dfb = *(const LAS f32x4*)(dtf + s0 + 4), dba = *(const LAS f32x4*)(dtb + s0), dbb = *(const LAS f32x4*)(dtb + s0 + 4);
                float m[8];
#pragma unroll
                for (int i = 0; i < 8; ++i) { const int s = s0 + i;
                    const float cfs = i < 4 ? cfa[i & 3] : cfb[i & 3], cbs = i < 4 ? cba[i & 3] : cbb[i & 3], dfs = i < 4 ? dfa[i & 3] : dfb[i & 3], dbs = i < 4 ? dba[i & 3] : dbb[i & 3];
                    const float arg = (s < l) ? csfl - cfs : csbl - cbs; const float dtv = (s < l) ? dfs : dbs;
                    float w = __expf(arg) * dtv; w = (s == l) ? dfs + dbs : w;
                    m[i] = bfe(g4, i) * w + ((s == l) ? Dh : 0.f); }
                v4u mf; mf.x = pk2(m[0], m[1]); mf.y = pk2(m[2], m[3]); mf.z = pk2(m[4], m[5]); mf.w = pk2(m[6], m[7]);
#pragma unroll
                for (int j = 0; j < 4; ++j) { const v4u af = *(const LAS v4u*)(lds + XT_OFF + (16 * j + fr) * LROW + s0 * 2); yacc[j] = mfma16(af, mf, yacc[j]); } }
            LAS unsigned char* st = lds + CM_OFF + wave * 4352;
#pragma unroll
            for (int j = 0; j < 4; ++j) { v2u w; w.x = pk2(yacc[j][0], yacc[j][1]); w.y = pk2(yacc[j][2], yacc[j][3]); *(LAS v2u*)(st + fr * 144 + (16 * j + 4 * fq) * 2) = w; }
            bf16* YD = (bf16*)(A.ws + WS_YD) + (row0 + t0 + 16 * wave) * 512 + 64 * h;
#pragma unroll
            for (int q = 0; q < 2; ++q) { const int r = 8 * q + (lane >> 3), ch = lane & 7; *(v4u*)(YD + (size_t)r * 512 + ch * 8) = *(const LAS v4u*)(st + r * 144 + ch * 16); }
        }
        {
            const int dir = wave >> 2, p = 16 * (wave & 3) + fr; LAS float* cs = dir ? csb : csf; LAS float* dtv = dir ? dtb : dtf;
            const float cend = dir ? csb[0] : csf[127];
            pg8::f32x4 sacc[8];
#pragma unroll
            for (int j = 0; j < 8; ++j) sacc[j] = (pg8::f32x4){0.f, 0.f, 0.f, 0.f};
#pragma unroll 2
            for (int ks = 0; ks < 4; ++ks) { const int s0 = 32 * ks + 8 * fq;
                const v4u x4 = *(const LAS v4u*)(lds + XT_OFF + p * LROW + s0 * 2);
                const f32x4 ca = *(const LAS f32x4*)(cs + s0), cb = *(const LAS f32x4*)(cs + s0 + 4), da = *(const LAS f32x4*)(dtv + s0), db = *(const LAS f32x4*)(dtv + s0 + 4);
                float m[8];
#pragma unroll
                for (int i = 0; i < 8; ++i) m[i] = bfe(x4, i) * (__expf(cend - (i < 4 ? ca[i & 3] : cb[i & 3])) * (i < 4 ? da[i & 3] : db[i & 3]));
                v4u xf; xf.x = pk2(m[0], m[1]); xf.y = pk2(m[2], m[3]); xf.z = pk2(m[4], m[5]); xf.w = pk2(m[6], m[7]);
#pragma unroll
                for (int j = 0; j < 8; ++j) { const v4u af = *(const LAS v4u*)(lds + BT_OFF + (16 * j + fr) * LROW + s0 * 2); sacc[j] = mfma16(af, xf, sacc[j]); } }
            LAS unsigned char* st = lds + CM_OFF + wave * 4352;
#pragma unroll
            for (int j = 0; j < 8; ++j) { v2u w; w.x = pk2(sacc[j][0], sacc[j][1]); w.y = pk2(sacc[j][2], sacc[j][3]); *(LAS v2u*)(st + fr * 272 + (16 * j + 4 * fq) * 2) = w; }
            bf16* SL = (bf16*)(A.ws + WS_SLOC) + ((((size_t)(b * NCC + cc) * 8 + h) * 2 + dir) * 64 + 16 * (wave & 3)) * 128;
#pragma unroll
            for (int q = 0; q < 4; ++q) { const int r = 4 * q + (lane >> 4), ch = lane & 15; *(v4u*)(SL + (size_t)r * 128 + ch * 8) = *(const LAS v4u*)(st + r * 272 + ch * 16); }
        }
    }
}

__device__ __forceinline__ void cfm_conv_item(const Args& A, int item, int tid) {
    const int line = item & 63, dir = (item >> 6) & 1, b = item >> 7;
    const int seg = tid >> 7, cp = tid & 127, ch = 256 * dir + 2 * cp;
    const bf16* UG = (const bf16*)(A.ws + WS_UGLU) + (size_t)b * SEQ * 512 + ch;
    const int tstride = dir ? 64 : 1, tbase = dir ? line : line * 64;
    unsigned raw[46];
#pragma unroll
    for (int ii = 0; ii < 46; ++ii) { const int pos = 16 * seg - 15 + ii;
        raw[ii] = (pos >= 0 && pos < 64) ? *(const unsigned*)(UG + (size_t)(tbase + pos * tstride) * 512) : 0u; }
    const float* ccw = A.in[I_CCW] + ch; const float* ccb = A.in[I_CCB] + ch;
    float w0[31], w1[31];
#pragma unroll
    for (int k = 0; k < 31; ++k) { w0[k] = ccw[k * 512]; w1[k] = ccw[k * 512 + 1]; }
    float a0[16], a1[16];
#pragma unroll
    for (int o = 0; o < 16; ++o) { a0[o] = ccb[0]; a1[o] = ccb[1]; }
#pragma unroll
    for (int ii = 0; ii < 46; ++ii) { const float lo = bflo(raw[ii]), hi = bfhi(raw[ii]);
#pragma unroll
        for (int o = 0; o < 16; ++o) { const int k = ii - o; if (k >= 0 && k <= 30) { a0[o] += w0[k] * lo; a1[o] += w1[k] * hi; } } }
    bf16* CO = (bf16*)(A.ws + WS_CONVO) + (size_t)b * SEQ * 512 + ch;
#pragma unroll
    for (int o = 0; o < 16; ++o) *(unsigned*)(CO + (size_t)(tbase + (16 * seg + o) * tstride) * 512) = pk2(a0[o], a1[o]);
}

__device__ __forceinline__ void p4_recur(const Args& A, int tid) {
    bf16* SLOC = (bf16*)(A.ws + WS_SLOC); float* DEC = (float*)(A.ws + WS_DEC);
    const int nthr = gridDim.x * 512;
    for (int idx = blockIdx.x * 512 + tid; idx < NB * 8 * 2 * 64 * 32; idx += nthr) {
        const int n4 = idx & 31, p = (idx >> 5) & 63, dir = (idx >> 11) & 1, h = (idx >> 12) & 7, b = idx >> 15;
        float S0 = 0.f, S1 = 0.f, S2 = 0.f, S3 = 0.f;
#pragma unroll 1
        for (int half = 0; half < 2; ++half) {
            v2u loc[17]; float dec[17];
#pragma unroll
            for (int s = 0; s < 17; ++s) { const int step = 17 * half + s;
                const int cc = dir == 0 ? step : (step < 2 ? 1 - step : 35 - step);
                const size_t slot = ((size_t)(b * NCC + cc) * 8 + h) * 2 + dir;
                loc[s] = *(const v2u*)(SLOC + slot * 8192 + p * 128 + 4 * n4); dec[s] = DEC[slot]; }
#pragma unroll
            for (int s = 0; s < 17; ++s) { const int step = 17 * half + s;
                const int cc = dir == 0 ? step : (step < 2 ? 1 - step : 35 - step);
                const size_t slot = ((size_t)(b * NCC + cc) * 8 + h) * 2 + dir;
                if (cc >= 2) { v2u o; o.x = pk2(S0, S1); o.y = pk2(S2, S3); *(v2u*)(SLOC + slot * 8192 + p * 128 + 4 * n4) = o; }
                S0 = dec[s] * S0 + bflo(loc[s].x); S1 = dec[s] * S1 + bfhi(loc[s].x); S2 = dec[s] * S2 + bflo(loc[s].y); S3 = dec[s] * S3 + bfhi(loc[s].y); }
        }
    }
}
__device__ __forceinline__ void ssd_out_item(const Args& A, LAS unsigned char* lds, int item, int tid, int wave, int lane) {
    const int g = item & 1, c = (item >> 1) & 31, b = item >> 6;
    LAS float* ECS = (LAS float*)(lds + 34816);
    LAS float* RED = (LAS float*)(lds + 38912);
    const size_t row0 = (size_t)b * SEQ + c * 128;
    const int fr = lane & 15, fq = lane >> 4;
    __syncthreads();
    { const bf16* CC = (const bf16*)(A.ws + WS_CCONV);
      for (int i = tid; i < 128 * 16; i += 512) { const int r = i >> 4, c8 = i & 15;
          *(LAS v4u*)(lds + r * LROW + c8 * 16) = *(const v4u*)(CC + (row0 + r) * 256 + g * 128 + c8 * 8); }
      const float* CS = (const float*)(A.ws + WS_CS) + ((size_t)(b * 32 + c) * 8 + 4 * g) * 256;
      for (int i = tid; i < 1024; i += 512) ECS[i] = __expf(CS[i]); }
    __syncthreads();
    const int hl = wave >> 1, ph = wave & 1, h = 4 * g + hl;
    v4u sf[2][2][4];
#pragma unroll
    for (int dir = 0; dir < 2; ++dir) { const bf16* SL = (const bf16*)(A.ws + WS_SLOC) + (((size_t)(b * NCC + c + 2) * 8 + h) * 2 + dir) * 8192;
#pragma unroll
        for (int jt = 0; jt < 2; ++jt)
#pragma unroll
            for (int ks = 0; ks < 4; ++ks) sf[dir][jt][ks] = *(const v4u*)(SL + (32 * ph + 16 * jt + fr) * 128 + 32 * ks + 8 * fq); }
    const bf16* YD = (const bf16*)(A.ws + WS_YD); const bf16* ZS = (const bf16*)(A.ws + WS_ZS);
    const int chb = 256 * g + 64 * hl + 32 * ph + 4 * fq;
    const float* snw = A.in[I_SNW]; bf16* A2 = (bf16*)(A.ws + WS_XN);
    f32x4 nw[2];
#pragma unroll
    for (int jt = 0; jt < 2; ++jt) nw[jt] = *(const f32x4*)(snw + chb + 16 * jt);
#pragma unroll 1
    for (int half = 0; half < 2; ++half) {
        float gv[4][2][4]; float ssq[4];
#pragma unroll
        for (int l4 = 0; l4 < 4; ++l4) { const int lt = 4 * half + l4;
            v4u cfr[4];
#pragma unroll
            for (int ks = 0; ks < 4; ++ks) cfr[ks] = *(const LAS v4u*)(lds + (16 * lt + fr) * LROW + (32 * ks + 8 * fq) * 2);
            pg8::f32x4 af[2], ab[2];
#pragma unroll
            for (int jt = 0; jt < 2; ++jt) { af[jt] = (pg8::f32x4){0.f, 0.f, 0.f, 0.f}; ab[jt] = (pg8::f32x4){0.f, 0.f, 0.f, 0.f};
#pragma unroll
                for (int ks = 0; ks < 4; ++ks) { af[jt] = mfma16(sf[0][jt][ks], cfr[ks], af[jt]); ab[jt] = mfma16(sf[1][jt][ks], cfr[ks], ab[jt]); } }
            const int l = 16 * lt + fr; const float ef = ECS[(hl * 2 + 0) * 128 + l], eb = ECS[(hl * 2 + 1) * 128 + l];
            float sq = 0.f;
#pragma unroll
            for (int jt = 0; jt < 2; ++jt) { const size_t o = (row0 + l) * 512 + chb + 16 * jt;
                const v2u yd = *(const v2u*)(YD + o), zs = *(const v2u*)(ZS + o);
                const float y0 = ef * af[jt][0] + eb * ab[jt][0] + bflo(yd.x), y1 = ef * af[jt][1] + eb * ab[jt][1] + bfhi(yd.x);
                const float y2 = ef * af[jt][2] + eb * ab[jt][2] + bflo(yd.y), y3 = ef * af[jt][3] + eb * ab[jt][3] + bfhi(yd.y);
                gv[l4][jt][0] = y0 * bflo(zs.x); gv[l4][jt][1] = y1 * bfhi(zs.x); gv[l4][jt][2] = y2 * bflo(zs.y); gv[l4][jt][3] = y3 * bfhi(zs.y);
#pragma unroll
                for (int r = 0; r < 4; ++r) sq += gv[l4][jt][r] * gv[l4][jt][r]; }
            sq += __shfl_xor(sq, 16); sq += __shfl_xor(sq, 32); ssq[l4] = sq;
        }
        __syncthreads();
        if (fq == 0) {
#pragma unroll
            for (int l4 = 0; l4 < 4; ++l4) RED[wave * 64 + 16 * l4 + fr] = ssq[l4]; }
        __syncthreads();
#pragma unroll
        for (int l4 = 0; l4 < 4; ++l4) { const int l = 16 * (4 * half + l4) + fr; float tot = 0.f;
#pragma unroll
            for (int w = 0; w < 8; ++w) tot += RED[w * 64 + 16 * l4 + fr];
            const float rstd = rsqrtf(tot * (1.f / 256.f) + EPS);
#pragma unroll
            for (int jt = 0; jt < 2; ++jt) { v2u o; o.x = pk2(gv[l4][jt][0] * rstd * nw[jt][0], gv[l4][jt][1] * rstd * nw[jt][1]); o.y = pk2(gv[l4][jt][2] * rstd * nw[jt][2], gv[l4][jt][3] * rstd * nw[jt][3]);
                *(v2u*)(A2 + (row0 + l) * 1024 + chb + 16 * jt) = o; } }
    }
}
__device__ __forceinline__ void cfm_ln_rows(const Args& A, int wave, int lane) {
    const bf16* CO = (const bf16*)(A.ws + WS_CONVO); bf16* A2 = (bf16*)(A.ws + WS_XN);
    const float* clw = A.in[I_CLW] + 8 * lane; const float* clb = A.in[I_CLB] + 8 * lane;
    const f32x4 w0 = *(const f32x4*)clw, w1 = *(const f32x4*)(clw + 4), b0 = *(const f32x4*)clb, b1 = *(const f32x4*)(clb + 4);
    const int gw = blockIdx.x * 8 + wave, NGW = gridDim.x * 8;
    for (int t = gw; t < T; t += NGW) {
        const v4u raw = *(const v4u*)(CO + (size_t)t * 512 + 8 * lane);
        float v[8]; float s = 0.f;
#pragma unroll
        for (int i = 0; i < 8; ++i) { v[i] = bfe(raw, i); s += v[i]; }
        const float mean = wave_sum(s) * (1.f / 512.f); float s2 = 0.f;
#pragma unroll
        for (int i = 0; i < 8; ++i) { v[i] -= mean; s2 += v[i] * v[i]; }
        const float rstd = rsqrtf(wave_sum(s2) * (1.f / 512.f) + EPS);
        float o[8];
#pragma unroll
        for (int i = 0; i < 8; ++i) o[i] = silu_f(v[i] * rstd * (i < 4 ? w0[i & 3] : w1[i & 3]) + (i < 4 ? b0[i & 3] : b1[i & 3]));
        v4u q; q.x = pk2(o[0], o[1]); q.y = pk2(o[2], o[3]); q.z = pk2(o[4], o[5]); q.w = pk2(o[6], o[7]);
        *(v4u*)(A2 + (size_t)t * 1024 + 512 + 8 * lane) = q;
    }
}

__device__ __forceinline__ void p7_norm2(const Args& A, int wave, int lane) {
    const bf16* X1 = (const bf16*)(A.ws + WS_X1B); const float* n2w = A.in[I_N2W]; float* MODV = (float*)(A.ws + WS_MODV); bf16* XN = (bf16*)(A.ws + WS_XN);
    const int gw = blockIdx.x * 8 + wave, NGW = gridDim.x * 8;
    v4u nx[2];
    if (gw < T) { nx[0] = *(const v4u*)(X1 + x1b_off(gw, 8 * lane)); nx[1] = *(const v4u*)(X1 + x1b_off(gw, 512 + 8 * lane)); }
    for (int row = gw; row < T; row += NGW) {
        const float* mp = MODV + (size_t)(row >> 12) * 6144;
        float v[16]; float ss = 0.f;
#pragma unroll
        for (int j = 0; j < 4; ++j) { v[2 * j] = bflo(nx[0][j]); v[2 * j + 1] = bfhi(nx[0][j]); v[8 + 2 * j] = bflo(nx[1][j]); v[8 + 2 * j + 1] = bfhi(nx[1][j]); }
#pragma unroll
        for (int i = 0; i < 16; ++i) ss += v[i] * v[i];
        { const int rn = row + NGW < T ? row + NGW : row;
          nx[0] = *(const v4u*)(X1 + x1b_off(rn, 8 * lane)); nx[1] = *(const v4u*)(X1 + x1b_off(rn, 512 + 8 * lane)); }
        const float rstd = rsqrtf(wave_sum(ss) * (1.f / 1024.f) + EPS);
#pragma unroll
        for (int hf = 0; hf < 2; ++hf) { const int col = 512 * hf + 8 * lane; float hv[8];
#pragma unroll
            for (int q = 0; q < 2; ++q) { const f32x4 nw = *(const f32x4*)(n2w + col + 4 * q), sh = *(const f32x4*)(mp + 3 * 1024 + col + 4 * q), sc = *(const f32x4*)(mp + 4 * 1024 + col + 4 * q);
#pragma unroll
                for (int i = 0; i < 4; ++i) hv[4 * q + i] = v[8 * hf + 4 * q + i] * rstd * nw[i] * (sc[i] + 1.f) + sh[i]; }
            v4u o; o.x = pk2(hv[0], hv[1]); o.y = pk2(hv[2], hv[3]); o.z = pk2(hv[4], hv[5]); o.w = pk2(hv[6], hv[7]);
            *(v4u*)(XN + (size_t)row * 1024 + col) = o; }
    }
}
constexpr int PEER_RV = PEER_FP8 ? 1 : 2;
__device__ __forceinline__ unsigned fkey(float s) { const unsigned u = __builtin_bit_cast(unsigned, s); return (u & 0x80000000u) ? ~u : (u | 0x80000000u); }
__device__ __forceinline__ float fkey_inv(unsigned k) { const unsigned u = (k & 0x80000000u) ? (k & 0x7fffffffu) : ~k; return __builtin_bit_cast(float, u); }
__device__ __forceinline__ unsigned umax_(unsigned a, unsigned b) { return a > b ? a : b; }
template <int CTRL> __device__ __forceinline__ unsigned dppu(unsigned x) { return (unsigned)__builtin_amdgcn_mov_dpp((int)x, CTRL, 0xf, 0xf, true); }
__device__ __forceinline__ unsigned allmax16(unsigned m) { m = umax_(m, dppu<0xB1>(m)); m = umax_(m, dppu<0x4E>(m)); m = umax_(m, dppu<0x141>(m)); m = umax_(m, dppu<0x140>(m)); return m; }
__device__ __forceinline__ unsigned allmax32(unsigned m) { m = allmax16(m); auto s = __builtin_amdgcn_permlane16_swap(m, m, false, false); const unsigned s0 = s[0], s1 = s[1]; return umax_(s0, s1); }
__device__ __forceinline__ unsigned allmax64(unsigned m) { m = allmax32(m); auto s = __builtin_amdgcn_permlane32_swap(m, m, false, false); const unsigned s0 = s[0], s1 = s[1]; return umax_(s0, s1); }
__device__ __forceinline__ float allmaxf16(float m) { m = fmaxf(m, dppf<0xB1>(m)); m = fmaxf(m, dppf<0x4E>(m)); m = fmaxf(m, dppf<0x141>(m)); m = fmaxf(m, dppf<0x140>(m)); return m; }
__device__ __forceinline__ float dot2bf(unsigned a, unsigned b, float acc) { return __builtin_amdgcn_fdot2_f32_bf16(__builtin_bit_cast(bf16x2_t, a), __builtin_bit_cast(bf16x2_t, b), acc, false); }

struct PeerRow { v4u r[PEER_RV]; };
__device__ __forceinline__ PeerRow peer_load(const unsigned char* tab, unsigned e, int lane) {
    PeerRow o; const unsigned char* p = tab + (size_t)e * (PEER_FP8 ? 1024 : 2048) + 16 * lane;
    o.r[0] = *(const v4u*)p;
    if (!PEER_FP8) o.r[PEER_RV - 1] = *(const v4u*)(p + 1024);
    return o;
}
__device__ __forceinline__ float peer_dot(const PeerRow& w, const unsigned (&xp)[8], const float (&xf)[16]) {
    if (PEER_FP8) {
        f32x2 a0 = {0.f, 0.f}, a1 = {0.f, 0.f};
#pragma unroll
        for (int j = 0; j < 4; ++j) { const f32x2 lo = __builtin_amdgcn_cvt_pk_f32_fp8((int)w.r[0][j], false), hi = __builtin_amdgcn_cvt_pk_f32_fp8((int)w.r[0][j], true);
            a0 += lo * (f32x2){xf[4 * j], xf[4 * j + 1]}; a1 += hi * (f32x2){xf[4 * j + 2], xf[4 * j + 3]}; }
        return (a0.x + a0.y) + (a1.x + a1.y);
    } else {
        float s0 = 0.f, s1 = 0.f;
#pragma unroll
        for (int j = 0; j < 4; ++j) { s0 = dot2bf(w.r[0][j], xp[j], s0); s1 = dot2bf(w.r[PEER_RV - 1][j], xp[4 + j], s1); }
        return s0 + s1;
    }
}
__device__ __forceinline__ void peer_axpy(const PeerRow& w, float c, f32x2 (&acc)[8]) {
    const f32x2 cc = {c, c};
    if (PEER_FP8) {
#pragma unroll
        for (int j = 0; j < 4; ++j) { acc[2 * j] += cc * __builtin_amdgcn_cvt_pk_f32_fp8((int)w.r[0][j], false); acc[2 * j + 1] += cc * __builtin_amdgcn_cvt_pk_f32_fp8((int)w.r[0][j], true); }
    } else {
#pragma unroll
        for (int j = 0; j < 4; ++j) { acc[j] += cc * (f32x2){bflo(w.r[0][j]), bfhi(w.r[0][j])}; acc[4 + j] += cc * (f32x2){bflo(w.r[PEER_RV - 1][j]), bfhi(w.r[PEER_RV - 1][j])}; }
    }
}

__device__ __forceinline__ unsigned umin_(unsigned a, unsigned b) { return a < b ? a : b; }
template <int N> __device__ __forceinline__ void bitonic_sort_desc(unsigned (&a)[N]) {
#pragma unroll
    for (int k = 2; k <= N; k <<= 1)
#pragma unroll
        for (int j = k >> 1; j > 0; j >>= 1)
#pragma unroll
            for (int i = 0; i < N; ++i) { const int l = i ^ j; if (l > i) { const unsigned mx = umax_(a[i], a[l]), mn = umin_(a[i], a[l]); const bool up = (i & k) == 0; a[i] = up ? mx : mn; a[l] = up ? mn : mx; } }
}
template <int N> __device__ __forceinline__ void bitonic_merge_desc(unsigned (&a)[N]) {
#pragma unroll
    for (int j = N >> 1; j > 0; j >>= 1)
#pragma unroll
        for (int i = 0; i < N; ++i) { const int l = i ^ j; if (l > i) { const unsigned mx = umax_(a[i], a[l]), mn = umin_(a[i], a[l]); a[i] = mx; a[l] = mn; } }
}
__device__ __forceinline__ void top16_merge(unsigned (&t)[16], const unsigned (&g)[16]) {
#pragma unroll
    for (int i = 0; i < 16; ++i) t[i] = umax_(t[i], g[15 - i]);
    bitonic_merge_desc<16>(t);
}
__device__ __forceinline__ void top16_of_128(const _Float16* col  , unsigned (&t)[16]) {
    _Float16 nx[16];
#pragma unroll
    for (int i = 0; i < 16; ++i) nx[i] = col[i * 32];
#pragma unroll 1
    for (int g = 0; g < 8; ++g) { unsigned q[16];
#pragma unroll
        for (int i = 0; i < 16; ++i) q[i] = (fkey((float)nx[i]) & ~127u) | (unsigned)(127 - 16 * g - i);
        { const int gn = g < 7 ? g + 1 : 7;
#pragma unroll
          for (int i = 0; i < 16; ++i) nx[i] = col[(size_t)gn * (T / 32) * 512 + i * 32]; }
        bitonic_sort_desc<16>(q);
        if (g == 0) {
#pragma unroll
            for (int i = 0; i < 16; ++i) t[i] = q[i];
        } else top16_merge(t, q); }
}
__host__ __device__ constexpr int stair_r1(int idx) {
    const int th[15] = {16, 24, 29, 33, 36, 38, 40, 42, 43, 44, 45, 46, 47, 48, 49}; int r = 0; for (int i = 0; i < 15; ++i) r += (idx >= th[i]) ? 1 : 0; return r; }
__host__ __device__ constexpr int stair_r2(int idx) {
    const int st[16] = {0, 16, 24, 29, 33, 36, 38, 40, 42, 43, 44, 45, 46, 47, 48, 49}; return idx - st[stair_r1(idx)]; }
__device__ __forceinline__ void p9_select_init(LAS unsigned char* lds, int tid) {
    LAS unsigned* TAB = (LAS unsigned*)(lds + 65536);
    if (tid < 64) { const int idx = tid < 50 ? tid : 49; int r1 = 0; const int th[15] = {16, 24, 29, 33, 36, 38, 40, 42, 43, 44, 45, 46, 47, 48, 49};
#pragma unroll
        for (int i = 0; i < 15; ++i) r1 += (idx >= th[i]) ? 1 : 0;
        const int st[16] = {0, 16, 24, 29, 33, 36, 38, 40, 42, 43, 44, 45, 46, 47, 48, 49}; int s0 = 0;
#pragma unroll
        for (int i = 0; i < 16; ++i) s0 = (r1 == i) ? st[i] : s0;
        TAB[tid] = (unsigned)r1 | ((unsigned)(idx - s0) << 8); }
}
__device__ __forceinline__ void p9_select_one(const Args& A, LAS unsigned char* lds, int tid, int token, int h) {
    const _Float16* SCT = (const _Float16*)(A.ws + WS_SC); unsigned* EIDX = (unsigned*)(A.ws + WS_EIDX); float* GATE = (float*)(A.ws + WS_GATE);
    LAS unsigned* KL = (LAS unsigned*)lds;
    LAS unsigned* TAB = (LAS unsigned*)(lds + 65536);
    {
        unsigned k1[16], k2[16];
        top16_of_128(SCT + ((size_t)(2 * h) * 8 * (T / 32) + (token >> 5)) * 512 + (token & 31), k1);
        top16_of_128(SCT + ((size_t)(2 * h + 1) * 8 * (T / 32) + (token >> 5)) * 512 + (token & 31), k2);
        float v1[16], v2[16];
#pragma unroll
        for (int i = 0; i < 16; ++i) { KL[i * 512 + tid] = k1[i]; KL[(16 + i) * 512 + tid] = k2[i]; v1[i] = fkey_inv(k1[i] & ~127u); v2[i] = fkey_inv(k2[i] & ~127u); }
        unsigned c[16], q[16];
#pragma unroll
        for (int i = 0; i < 16; ++i) c[i] = (fkey(v1[stair_r1(i)] + v2[stair_r2(i)]) & ~63u) | (unsigned)(63 - i);
        bitonic_sort_desc<16>(c);
#pragma unroll
        for (int i = 0; i < 16; ++i) q[i] = (fkey(v1[stair_r1(16 + i)] + v2[stair_r2(16 + i)]) & ~63u) | (unsigned)(63 - 16 - i);
        bitonic_sort_desc<16>(q); top16_merge(c, q);
#pragma unroll
        for (int i = 0; i < 16; ++i) q[i] = (fkey(v1[stair_r1(32 + i)] + v2[stair_r2(32 + i)]) & ~63u) | (unsigned)(63 - 32 - i);
        bitonic_sort_desc<16>(q); top16_merge(c, q);
#pragma unroll
        for (int i = 0; i < 16; ++i) q[i] = (i < 2) ? ((fkey(v1[stair_r1(48 + (i < 2 ? i : 0))] + v2[stair_r2(48 + (i < 2 ? i : 0))]) & ~63u) | (unsigned)(63 - 48 - i)) : 0u;
        bitonic_sort_desc<16>(q); top16_merge(c, q);
        unsigned eid[16]; float ex[16]; const float mx = fkey_inv(c[0] & ~63u); float sm = 0.f;
#pragma unroll
        for (int i = 0; i < 16; ++i) { const unsigned rr = TAB[63 - (c[i] & 63u)];
            const unsigned ka = KL[(rr & 255u) * 512 + tid], kb = KL[(16 + (rr >> 8)) * 512 + tid];
            eid[i] = (127u - (ka & 127u)) * 128u + (127u - (kb & 127u));
            ex[i] = __expf(fkey_inv(c[i] & ~63u) - mx); sm += ex[i]; }
        const float inv = 1.f / sm;
        unsigned* ep = EIDX + (size_t)token * 128 + 16 * h; float* gp = GATE + (size_t)token * 128 + 16 * h; float* up = (float*)(A.ws + WS_USA) + (size_t)token * 128 + 16 * h;
        const float* USC = (const float*)(A.ws + WS_USC); const float* VSC = (const float*)(A.ws + WS_VSC);
        float us[16];
#pragma unroll
        for (int i = 0; i < 16; ++i) { us[i] = USC[eid[i]]; ex[i] = ex[i] * inv * VSC[eid[i]]; }
#pragma unroll
        for (int i = 0; i < 4; ++i) { *(v4u*)(ep + 4 * i) = (v4u){eid[4 * i], eid[4 * i + 1], eid[4 * i + 2], eid[4 * i + 3]};
            *(f32x4*)(gp + 4 * i) = (f32x4){ex[4 * i], ex[4 * i + 1], ex[4 * i + 2], ex[4 * i + 3]};
            *(f32x4*)(up + 4 * i) = (f32x4){us[4 * i], us[4 * i + 1], us[4 * i + 2], us[4 * i + 3]}; }
    }
}

#define PEER_LOAD8(buf, tab, ev, lb_) do { _Pragma("unroll") for (int i_ = 0; i_ < 8; ++i_) buf[i_] = peer_load(tab, (unsigned)__builtin_amdgcn_readlane((int)(ev), (lb_) + i_), lane); } while (0)
#define PEER_DOT8(buf, off_) do { _Pragma("unroll") for (int i_ = 0; i_ < 8; ++i_) p[(off_) + i_] = peer_dot(buf[i_], xp, xf); } while (0)
#define PEER_UFIN(hb_) do { wave_tsum16(p, lane); \
            const float d0 = __shfl(p[0], srcl), d1 = __shfl(p[1], srcl); \
            float dot = (i16 & 1) ? d1 : d0; \
            const unsigned eS_ = (hb_) < 4 ? eA : eB; const float gS = (hb_) < 4 ? gA : gB; \
            float wv; if (PEER_FP8) { dot *= USC[eS_]; wv = gS * gelu_f(dot) * VSC[eS_]; } else { wv = gS * gelu_f(dot); } \
            const bool mine = (lane >> 4) == ((hb_) & 3); \
            if ((hb_) < 4) wA = mine ? wv : wA; else wB = mine ? wv : wB; } while (0)
#define PEER_AXPY8(buf, wS_, lb_) do { _Pragma("unroll") for (int i_ = 0; i_ < 8; ++i_) peer_axpy(buf[i_], __builtin_bit_cast(float, __builtin_amdgcn_readlane(__builtin_bit_cast(int, (wS_)), (lb_) + i_)), acc); } while (0)
template <bool DUMMY> __device__ __forceinline__ void p9_peer(const Args& A, int wave, int lane, unsigned emask) {
    unsigned* EIDX = (unsigned*)(A.ws + WS_EIDX); float* GATE = (float*)(A.ws + WS_GATE); const bf16* XN = (const bf16*)(A.ws + WS_XN);
    const unsigned char* U = A.ws + WS_U; const unsigned char* V = A.ws + WS_V;
    const float* USC = (const float*)(A.ws + WS_USC); const float* VSC = (const float*)(A.ws + WS_VSC);
    float* MODV = (float*)(A.ws + WS_MODV); float* OUT = A.out; const float* fnw = A.in[I_FNW];
    const int i16 = lane & 15;
    const int srcl = 32 * ((i16 >> 3) & 1) + 16 * ((i16 >> 2) & 1) + 8 * ((i16 >> 1) & 1);
    const int gw = blockIdx.x * 8 + wave, NGW = gridDim.x * 8;
    PeerRow bufa[8], bufb[8];
    unsigned eA = 0, eB = 0; float gA = 0.f, gB = 0.f;
    if (gw < T) { eA = EIDX[(size_t)gw * 128 + lane] & emask; eB = EIDX[(size_t)gw * 128 + 64 + lane] & emask; gA = GATE[(size_t)gw * 128 + lane]; gB = GATE[(size_t)gw * 128 + 64 + lane];
        PEER_LOAD8(bufa, U, eA, 0); }
    for (int t = gw; t < T; t += NGW) {
        const int tn = (t + NGW < T) ? t + NGW : t;
        unsigned xp[8]; float xf[16];
        if (PEER_FP8) {
            const v4u a = *(const v4u*)(XN + (size_t)t * 1024 + 16 * lane), b2 = *(const v4u*)(XN + (size_t)t * 1024 + 16 * lane + 8);
#pragma unroll
            for (int j = 0; j < 4; ++j) { xf[2 * j] = bflo(a[j]); xf[2 * j + 1] = bfhi(a[j]); xf[8 + 2 * j] = bflo(b2[j]); xf[8 + 2 * j + 1] = bfhi(b2[j]); xp[j] = 0u; xp[4 + j] = 0u; }
        } else {
            const v4u a = *(const v4u*)(XN + (size_t)t * 1024 + 8 * lane), b2 = *(const v4u*)(XN + (size_t)t * 1024 + 512 + 8 * lane);
#pragma unroll
            for (int j = 0; j < 4; ++j) { xp[j] = a[j]; xp[4 + j] = b2[j]; }
#pragma unroll
            for (int j = 0; j < 16; ++j) xf[j] = 0.f;
        }
        float wA = 0.f, wB = 0.f;
#pragma unroll 1
        for (int hb = 0; hb < 8; ++hb) {
            const unsigned eS = hb < 4 ? eA : eB; const int lb = 16 * (hb & 3);
            float p[16];
            PEER_LOAD8(bufb, U, eS, lb + 8);
            PEER_DOT8(bufa, 0);
            if (hb < 7) { const unsigned eN = hb < 3 ? eA : eB; PEER_LOAD8(bufa, U, eN, 16 * ((hb + 1) & 3)); }
            else PEER_LOAD8(bufa, V, eA, 0);
            PEER_DOT8(bufb, 8);
            PEER_UFIN(hb);
        }
        const unsigned eAn = EIDX[(size_t)tn * 128 + lane] & emask;
        f32x2 acc[8];
#pragma unroll
        for (int i = 0; i < 8; ++i) acc[i] = (f32x2){0.f, 0.f};
#pragma unroll 1
        for (int hb = 0; hb < 8; ++hb) {
            const unsigned eS = hb < 4 ? eA : eB; const float wS = hb < 4 ? wA : wB; const int lb = 16 * (hb & 3);
            PEER_LOAD8(bufb, V, eS, lb + 8);
            PEER_AXPY8(bufa, wS, lb);
            if (hb < 7) { const unsigned eN = hb < 3 ? eA : eB; PEER_LOAD8(bufa, V, eN, 16 * ((hb + 1) & 3)); }
            else if (tn != t) PEER_LOAD8(bufa, U, eAn, 0);
            PEER_AXPY8(bufb, wS, lb + 8);
        }
        float* orow = OUT + (size_t)t * 1024; const float* g5 = MODV + (size_t)(t >> 12) * 6144 + 5 * 1024;
        float x2[16]; float ss = 0.f;
#pragma unroll
        for (int q = 0; q < 4; ++q) { const int col = PEER_FP8 ? 16 * lane + 4 * q : (q < 2 ? 8 * lane + 4 * q : 512 + 8 * lane + 4 * (q - 2));
            const f32x4 a = *(const f32x4*)(orow + col), ga = *(const f32x4*)(g5 + col);
            x2[4 * q] = a[0] + ga[0] * acc[2 * q].x; x2[4 * q + 1] = a[1] + ga[1] * acc[2 * q].y; x2[4 * q + 2] = a[2] + ga[2] * acc[2 * q + 1].x; x2[4 * q + 3] = a[3] + ga[3] * acc[2 * q + 1].y; }
#pragma unroll
        for (int i = 0; i < 16; ++i) ss += x2[i] * x2[i];
        const float rstd = rsqrtf(wave_sum(ss) * (1.f / 1024.f) + EPS);
#pragma unroll
        for (int q = 0; q < 4; ++q) { const int col = PEER_FP8 ? 16 * lane + 4 * q : (q < 2 ? 8 * lane + 4 * q : 512 + 8 * lane + 4 * (q - 2));
            const f32x4 wa = *(const f32x4*)(fnw + col); f32x4 oa;
#pragma unroll
            for (int k = 0; k < 4; ++k) oa[k] = x2[4 * q + k] * rstd * wa[k];
            if (!DUMMY || rstd == 123.456f) *(f32x4*)(orow + col) = oa; }
        eA = eAn; eB = EIDX[(size_t)tn * 128 + 64 + lane] & emask; gA = GATE[(size_t)tn * 128 + lane]; gB = GATE[(size_t)tn * 128 + 64 + lane];
    }
}
#if PEER_FP8
#ifndef GL_PROBE_SKIP
#define GL_PROBE_SKIP 0
#endif
#ifndef GL_HALF_PROBE
#define GL_HALF_PROBE 0
#endif
constexpr int GL_RSH = 11, GL_KB = 2;
constexpr int GL_TG = 4, GL_NE = 128 * GL_TG, GL_NBT = GL_NE / 8;
constexpr int GL_L = 0, GL_W = 4 * GL_NE, GL_CNT = 8 * GL_NE, GL_OFF = GL_CNT + 256, GL_US = GL_OFF + 256, GL_D = GL_US + 4 * GL_NE, GL_X = GL_D + 4 * GL_NE, GL_K = GL_X + 2048 * GL_TG, GL_WAVE_BYTES = GL_K + GL_NE;
constexpr int GL_ACC = GL_US;
static_assert(GL_K - GL_ACC >= 4096 * (GL_TG - 1), "parked accumulators fit");
static_assert(8 * GL_WAVE_BYTES <= LDSCTL_OFF && GL_NBT % 4 == 0, "gather LDS map");
template <bool CHEAP = false> __device__ __forceinline__ void gl_axpy(const v4u& w, float c, f32x2 (&acc)[8]) {
    const f32x2 cc = {c, c};
    if (CHEAP) {
#pragma unroll
        for (int j = 0; j < 4; ++j) { acc[2 * j] += cc * __builtin_bit_cast(f32x2, (v2u){w[j], w[j] << 3}); acc[2 * j + 1] += cc * __builtin_bit_cast(f32x2, (v2u){w[j] << 5, w[j] << 7}); }
        return; }
#pragma unroll
    for (int j = 0; j < 4; ++j) { acc[2 * j] += cc * __builtin_amdgcn_cvt_pk_f32_fp8((int)w[j], false); acc[2 * j + 1] += cc * __builtin_amdgcn_cvt_pk_f32_fp8((int)w[j], true); }
}
__device__ __forceinline__ float swapmax16(float a) { auto r = __builtin_amdgcn_permlane16_swap(__builtin_bit_cast(unsigned, a), __builtin_bit_cast(unsigned, a), false, false); const unsigned r0 = r[0], r1 = r[1]; return fmaxf(__uint_as_float(r0), __uint_as_float(r1)); }
__device__ __forceinline__ float swapmax32(float a) { auto r = __builtin_amdgcn_permlane32_swap(__builtin_bit_cast(unsigned, a), __builtin_bit_cast(unsigned, a), false, false); const unsigned r0 = r[0], r1 = r[1]; return fmaxf(__uint_as_float(r0), __uint_as_float(r1)); }
__device__ __forceinline__ float wave_max(float v) { v = fmaxf(v, dppf<0xB1>(v)); v = fmaxf(v, dppf<0x4E>(v)); v = fmaxf(v, dppf<0x141>(v)); v = fmaxf(v, dppf<0x140>(v)); return swapmax32(swapmax16(v)); }
#define GL_WAIT() asm volatile("s_waitcnt lgkmcnt(0)" ::: "memory")
typedef const __attribute__((address_space(1))) unsigned char* gl_gptr;
#define GL_LOAD1(bufl, tab, entl_, j_) do { const unsigned vo_ = (unsigned)__builtin_amdgcn_readlane((int)(entl_), 8 * (j_)) + lane16; bufl[j_] = *(const __attribute__((address_space(1))) v4u*)((gl_gptr)(tab) + vo_); } while (0)
#define GL_RLOAD(buf, tab, bidx) do { const unsigned ent_ = Ls[8 * (bidx) + (lane >> 3)]; \
    _Pragma("unroll") for (int j_ = 0; j_ < 8; ++j_) GL_LOAD1(buf, tab, ent_, j_); } while (0)
#define GL_VSWITCH(kn_) do { const int s_ = (mapbits >> (2 * (kn_))) & 3; LAS unsigned char* sp_ = ACCS + s_ * 4096 + 64 * lane; \
    const f32x4 t0_ = *(const LAS f32x4*)sp_, t1_ = *(const LAS f32x4*)(sp_ + 16), t2_ = *(const LAS f32x4*)(sp_ + 32), t3_ = *(const LAS f32x4*)(sp_ + 48); \
    *(LAS f32x4*)sp_ = (f32x4){cur[0].x, cur[0].y, cur[1].x, cur[1].y}; *(LAS f32x4*)(sp_ + 16) = (f32x4){cur[2].x, cur[2].y, cur[3].x, cur[3].y}; \
    *(LAS f32x4*)(sp_ + 32) = (f32x4){cur[4].x, cur[4].y, cur[5].x, cur[5].y}; *(LAS f32x4*)(sp_ + 48) = (f32x4){cur[6].x, cur[6].y, cur[7].x, cur[7].y}; \
    cur[0] = (f32x2){t0_[0], t0_[1]}; cur[1] = (f32x2){t0_[2], t0_[3]}; cur[2] = (f32x2){t1_[0], t1_[1]}; cur[3] = (f32x2){t1_[2], t1_[3]}; \
    cur[4] = (f32x2){t2_[0], t2_[1]}; cur[5] = (f32x2){t2_[2], t2_[3]}; cur[6] = (f32x2){t3_[0], t3_[1]}; cur[7] = (f32x2){t3_[2], t3_[3]}; \
    mapbits = (mapbits & ~(3 << (2 * kcur))) | (s_ << (2 * kcur)); kcur = (kn_); } while (0)
template <int CTRL> __device__ __forceinline__ int dppi(int x) { return __builtin_amdgcn_mov_dpp(x, CTRL, 0xf, 0xf, true); }
__device__ __forceinline__ int swapsum32i(int a, int b) { auto r = __builtin_amdgcn_permlane32_swap((unsigned)a, (unsigned)b, false, false); const unsigned r0 = r[0], r1 = r[1]; return (int)(r0 + r1); }
__device__ __forceinline__ int swapsum16i(int a, int b) { auto r = __builtin_amdgcn_permlane16_swap((unsigned)a, (unsigned)b, false, false); const unsigned r0 = r[0], r1 = r[1]; return (int)(r0 + r1); }
#define GL_USTEP(bufc, bufl, bc, bl) do { const unsigned entc_ = Ks[8 * (bc) + (lane >> 3)], entl_ = Ls[8 * (bl) + (lane >> 3)]; int p[8]; \
    _Pragma("unroll") for (int j_ = 0; j_ < 8; ++j_) { GL_LOAD1(bufl, U, entl_, j_); \
        const int kk_ = __builtin_amdgcn_readlane((int)entc_, 8 * j_); \
        if (kk_ != kcu) { asm volatile("" ::: "memory"); xcur = kk_ == 0 ? xr[0] : kk_ == 1 ? xr[1] : kk_ == 2 ? xr[2] : xr[3]; kcu = kk_; } \
        int s_; asm volatile("v_dot4_i32_i8 %0, %1, %2, 0" : "=v"(s_) : "v"(bufc[j_][0]), "v"(xcur[0])); \
        asm volatile("v_dot4_i32_i8 %0, %1, %2, %0" : "+v"(s_) : "v"(bufc[j_][1]), "v"(xcur[1])); asm volatile("v_dot4_i32_i8 %0, %1, %2, %0" : "+v"(s_) : "v"(bufc[j_][2]), "v"(xcur[2])); \
        asm volatile("v_dot4_i32_i8 %0, %1, %2, %0" : "+v"(s_) : "v"(bufc[j_][3]), "v"(xcur[3])); p[j_] = s_; } \
    asm volatile("s_nop 2" : "+v"(p[0]), "+v"(p[1]), "+v"(p[2]), "+v"(p[3]), "+v"(p[4]), "+v"(p[5]), "+v"(p[6]), "+v"(p[7]));        \
    _Pragma("unroll") for (int q_ = 0; q_ < 4; ++q_) p[q_] = swapsum32i(p[q_], p[q_ + 4]); \
    _Pragma("unroll") for (int q_ = 0; q_ < 2; ++q_) p[q_] = swapsum16i(p[q_], p[q_ + 2]); \
    { const bool up_ = (lane & 8) != 0; const int snd_ = up_ ? p[0] : p[1]; const int keep_ = up_ ? p[1] : p[0]; p[0] = keep_ + dppi<0x128>(snd_); } \
    p[0] += dppi<0xB1>(p[0]); p[0] += dppi<0x4E>(p[0]); p[0] += dppi<0x141>(p[0]);        \
    if ((lane & 7) == 0) Ds[8 * (bc) + (lane >> 3)] = (float)p[0]; } while (0)
#define GL_VSTEP(bufc, bufl, bc, bl) do { const unsigned entc_ = Ks[8 * (bc) + (lane >> 3)], entl_ = Ls[8 * (bl) + (lane >> 3)]; const float wv_ = Ws[8 * (bc) + (lane >> 3)]; \
    _Pragma("unroll") for (int j_ = 0; j_ < 8; ++j_) { GL_LOAD1(bufl, V, entl_, j_); \
        const int kk_ = __builtin_amdgcn_readlane((int)entc_, 8 * j_); \
        const float w_ = __builtin_bit_cast(float, __builtin_amdgcn_readlane(__builtin_bit_cast(int, wv_), 8 * j_)); \
        if (kk_ != kcur) { asm volatile("" ::: "memory"); GL_VSWITCH(kk_); } \
        gl_axpy<DUMMY && (GL_PROBE_SKIP & 4) != 0>(bufc[j_], w_, cur); } } while (0)
#define GL_SWEEP(tab, STEP) do { GL_RLOAD(buf0, tab, 0); GL_RLOAD(buf1, tab, 1); GL_RLOAD(buf2, tab, 2); \
    _Pragma("unroll 1") for (int b_ = 0; b_ < GL_NBT; b_ += 4) { \
        STEP(buf0, buf3, b_, b_ + 3); \
        STEP(buf1, buf0, b_ + 1, (b_ + 4 < GL_NBT ? b_ + 4 : GL_NBT - 1)); \
        STEP(buf2, buf1, b_ + 2, (b_ + 5 < GL_NBT ? b_ + 5 : GL_NBT - 1)); \
        STEP(buf3, buf2, b_ + 3, (b_ + 6 < GL_NBT ? b_ + 6 : GL_NBT - 1)); } } while (0)

template <bool DUMMY> __device__ __forceinline__ void p10_gather(const Args& A, LAS unsigned char* lds, int wave, int lane, const XcdBarrier& bar, unsigned emask) {
    unsigned* EIDX = (unsigned*)(A.ws + WS_EIDX); float* GATE = (float*)(A.ws + WS_GATE); const bf16* XN = (const bf16*)(A.ws + WS_XN);
    const unsigned char* U = A.ws + WS_U; const unsigned char* V = A.ws + WS_V;
    const float* USC = (const float*)(A.ws + WS_USC); const float* VSC = (const float*)(A.ws + WS_VSC);
    float* MODV = (float*)(A.ws + WS_MODV); float* OUT = A.out; const float* fnw = A.in[I_FNW];
    LAS unsigned char* wl = lds + wave * GL_WAVE_BYTES;
    LAS unsigned* Ls = (LAS unsigned*)(wl + GL_L); LAS unsigned char* Ks = wl + GL_K; LAS float* Ws = (LAS float*)(wl + GL_W); LAS float* USs = (LAS float*)(wl + GL_US); LAS float* Ds = (LAS float*)(wl + GL_D);
    LAS unsigned* CNT = (LAS unsigned*)(wl + GL_CNT); LAS unsigned* OFF = (LAS unsigned*)(wl + GL_OFF); LAS unsigned char* XS = wl + GL_X; LAS unsigned char* ACCS = wl + GL_ACC; LAS float* SXS = (LAS float*)(wl + GL_CNT);
    const unsigned lane16 = 16u * (unsigned)lane;
    const int gw = blockIdx.x * 8 + wave, NGW = gridDim.x * 8, NGRP = T / GL_TG;
    (void)bar;
    unsigned e[2 * GL_TG]; float g[2 * GL_TG], us[2 * GL_TG]; const float* USA = (const float*)(A.ws + WS_USA);
#define GL_LOADSEL(E_, G_, U_, grp_) do { _Pragma("unroll") for (int j = 0; j < 2 * GL_TG; ++j) { const size_t o = (size_t)(GL_TG * (grp_) + (j >> 1)) * 128 + (j & 1) * 64 + lane; E_[j] = EIDX[o] & emask; G_[j] = GATE[o]; U_[j] = USA[o]; } } while (0)
    if (gw < NGRP) GL_LOADSEL(e, g, us, gw);
    for (int it = 0; it < (NGRP + NGW - 1) / NGW; ++it) {
        const int gi = gw + it * NGW;
#ifndef GL_GRID_SYNC
#define GL_GRID_SYNC 0
#endif
        if (GL_GRID_SYNC && N_LAUNCHES == 1 && it > 0 && !DUMMY) xcd_barrier(bar); else __syncthreads();
        if (gi < NGRP) {
            const int t0 = GL_TG * gi;
            CNT[lane] = 0u; GL_WAIT();
            unsigned ps[2 * GL_TG]; v4u xr[GL_TG];
#pragma unroll
            for (int j = 0; j < 2 * GL_TG; ++j) ps[j] = __hip_atomic_fetch_add(CNT + (((e[j] >> GL_RSH) << GL_KB) | (unsigned)(j >> 1)), 1u, __ATOMIC_RELAXED, __HIP_MEMORY_SCOPE_WORKGROUP);
            GL_WAIT();
            { const unsigned c = CNT[lane]; unsigned incl = c;
#pragma unroll
              for (int o = 1; o < 64; o <<= 1) { const unsigned v = (unsigned)__shfl_up((int)incl, o); if (lane >= o) incl += v; }
              OFF[lane] = incl - c; }
            GL_WAIT();
#pragma unroll
            for (int j = 0; j < 2 * GL_TG; ++j) { const unsigned i2 = OFF[((e[j] >> GL_RSH) << GL_KB) | (unsigned)(j >> 1)] + ps[j];
                Ls[i2] = e[j] << 10; Ks[i2] = (unsigned char)(j >> 1); Ws[i2] = g[j]; USs[i2] = us[j]; }
#pragma unroll
            for (int k = 0; k < GL_TG; ++k) { const v4u a = *(const v4u*)(XN + (size_t)(t0 + k) * 1024 + 16 * lane), b2 = *(const v4u*)(XN + (size_t)(t0 + k) * 1024 + 16 * lane + 8);
                float xv[16]; float am = 0.f;
#pragma unroll
                for (int j = 0; j < 4; ++j) { xv[2 * j] = bflo(a[j]); xv[2 * j + 1] = bfhi(a[j]); xv[8 + 2 * j] = bflo(b2[j]); xv[8 + 2 * j + 1] = bfhi(b2[j]); }
#pragma unroll
                for (int j = 0; j < 16; ++j) am = fmaxf(am, fabsf(xv[j]));
                am = wave_max(am); const float inv8 = am > 0.f ? 127.f / am : 0.f;
                v4u qx;
#pragma unroll
                for (int j = 0; j < 4; ++j) qx[j] = ((unsigned)__float2int_rn(xv[4 * j] * inv8) & 255u) | (((unsigned)__float2int_rn(xv[4 * j + 1] * inv8) & 255u) << 8)
                                                  | (((unsigned)__float2int_rn(xv[4 * j + 2] * inv8) & 255u) << 16) | (((unsigned)__float2int_rn(xv[4 * j + 3] * inv8) & 255u) << 24);
                xr[k] = qx; if (lane == 0) SXS[k] = am * (1.f / 127.f); }
            GL_WAIT();
            v4u buf0[8], buf1[8], buf2[8], buf3[8];
            { v4u xcur = xr[0]; int kcu = 0;
              if (!(DUMMY && (GL_PROBE_SKIP & 1))) GL_SWEEP(U, GL_USTEP); }
            GL_WAIT();
#pragma unroll
            for (int j = 0; j < 2 * GL_TG; ++j) { const int i = lane + 64 * j; Ws[i] = Ws[i] * gelu_f(Ds[i] * USs[i] * SXS[Ks[i]]); }
            GL_WAIT();
            f32x2 cur[8]; int kcur = 0; int mapbits = (0 << 2) | (1 << 4) | (2 << 6);
            { LAS unsigned char* zp = ACCS + 64 * lane;
#pragma unroll
              for (int q = 0; q < 4 * (GL_TG - 1); ++q) *(LAS f32x4*)(zp + (q >> 2) * 4096 + (q & 3) * 16) = (f32x4){0.f, 0.f, 0.f, 0.f}; }
#pragma unroll
            for (int i = 0; i < 8; ++i) cur[i] = (f32x2){0.f, 0.f};
            GL_WAIT();
            if (!(DUMMY && (GL_PROBE_SKIP & 2)))
            GL_SWEEP(V, GL_VSTEP);
            { const int gn = gi + NGW < NGRP ? gi + NGW : gi; GL_LOADSEL(e, g, us, gn); }
            const float* fnw_ = fnw; asm volatile("" : "+s"(fnw_));
#pragma unroll
            for (int k = 0; k < GL_TG; ++k) { const int t = t0 + k;
                if (k != kcur) { asm volatile("" ::: "memory"); GL_VSWITCH(k); }
                float* orow = OUT + (size_t)t * 1024 + 16 * lane; const float* g5 = MODV + (size_t)(t >> 12) * 6144 + 5 * 1024 + 16 * lane;
                const bf16* x1p = (const bf16*)(A.ws + WS_X1B) + x1b_off(t, 16 * lane); const v4u xa1 = *(const v4u*)x1p, xb1 = *(const v4u*)(x1p + 8);
                float x2[16]; float ss = 0.f;
#pragma unroll
                for (int q = 0; q < 4; ++q) { const unsigned w0_ = q < 2 ? xa1[2 * q] : xb1[2 * q - 4], w1_ = q < 2 ? xa1[2 * q + 1] : xb1[2 * q - 3];
                    const f32x4 a = {bflo(w0_), bfhi(w0_), bflo(w1_), bfhi(w1_)}, ga = *(const f32x4*)(g5 + 4 * q);
                    x2[4 * q] = a[0] + ga[0] * cur[2 * q].x; x2[4 * q + 1] = a[1] + ga[1] * cur[2 * q].y; x2[4 * q + 2] = a[2] + ga[2] * cur[2 * q + 1].x; x2[4 * q + 3] = a[3] + ga[3] * cur[2 * q + 1].y; }
#pragma unroll
                for (int i = 0; i < 16; ++i) ss += x2[i] * x2[i];
                const float rstd = rsqrtf(wave_sum(ss) * (1.f / 1024.f) + EPS);
#pragma unroll
                for (int q = 0; q < 4; ++q) { const f32x4 wa = *(const f32x4*)(fnw_ + 16 * lane + 4 * q); f32x4 oa;
#pragma unroll
                    for (int i = 0; i < 4; ++i) oa[i] = x2[4 * q + i] * rstd * wa[i];
                    if (!DUMMY || rstd == 123.456f) *(f32x4*)(orow + 4 * q) = oa; } }
        }
    }
}
#endif
__global__ void __launch_bounds__(512, 2) fwd_kernel(Args args) {
    extern __shared__ __attribute__((aligned(16))) unsigned char lds_raw[];
    LAS unsigned char* lds = (LAS unsigned char*)lds_raw;
    volatile LAS unsigned* MISC = (volatile LAS unsigned*)(lds + MISC_OFF);
    const int tid = threadIdx.x, lane = tid & 63, wave = __builtin_amdgcn_readfirstlane(tid >> 6);
    for (int u = tid; u < (LDS_BYTES - LDSCTL_OFF) / 4; u += 512) ((LAS unsigned*)(lds + LDSCTL_OFF))[u] = 0u;
    __syncthreads();
    unsigned* ctl = (unsigned*)(args.ws + WS_CTL);
    XcdBarrier bar; bar.bar = ctl + CW_BAR; bar.x = 0; bar.st = nullptr;
    if (N_LAUNCHES == 1) bar = xcd_barrier_post(ctl + CW_BAR, MISC + 8);
    const int lo = args.ph_lo, hi = args.ph_hi;
#ifndef ONLY_PHASE
#define ONLY_PHASE -1
#endif
#define IN(k) ((ONLY_PHASE < 0 || ONLY_PHASE == (k)) && lo <= (k) && (k) < hi)
#define SEAM(k) do { if (IN(k) && IN((k) + 1)) xcd_barrier(bar); } while (0)
#ifndef DUP_MASK
#define DUP_MASK 0
#endif
#define REP(k) for (int rep_ = 0; rep_ < (((DUP_MASK >> (k)) & 1) ? 2 : 1); ++rep_, (rep_ < (((DUP_MASK >> (k)) & 1) ? 2 : 1) ? xcd_barrier(bar) : (void)0))

#ifdef UB_KIND
    {
        f32x2 a0 = {1.f + tid, 2.f}, a1 = a0 * 1.5f, a2 = a0 * 2.5f, a3 = a0 * 3.5f, a4 = a0 * 4.5f, a5 = a0 * 5.5f, a6 = a0 * 6.5f, a7 = a0 * 7.5f;
        f32x2 m = {1.0001f, 0.9999f}, c = {1e-3f, -1e-3f}; unsigned w = 0x38343c30u + tid;
#if UB_KIND == 1
#define UB_OP(q_) asm volatile("v_pk_fma_f32 %0, %0, %1, %2" : "+v"(q_) : "v"(m), "v"(c))
#elif UB_KIND == 2
#define UB_OP(q_) asm volatile("v_fma_f32 %0, %0, %1, %2" : "+v"(q_.x) : "v"(m.x), "v"(c.x))
#elif UB_KIND == 3
#define UB_OP(q_) asm volatile("v_cvt_pk_f32_fp8 %0, %1" : "=v"(q_) : "v"(w))
#elif UB_KIND == 4
#define UB_OP(q_) asm volatile("v_dot4c_i32_i8 %0, %1, %2" : "+v"(q_.x) : "v"(w), "v"(m.x))
#elif UB_KIND == 5
#define UB_OP(q_) asm volatile("v_pk_fma_f16 %0, %0, %1, %2" : "+v"(q_.x) : "v"(m.x), "v"(c.x))
#elif UB_KIND == 6
#define UB_OP(q_) asm volatile("v_cvt_scalef32_pk_f16_fp8 %0, %1, %2" : "+v"(q_.x) : "v"(w), "v"(m.x))
#endif
#pragma unroll 1
        for (int i = 0; i < UB_N; ++i) {
#pragma unroll
            for (int r = 0; r < 4; ++r) { UB_OP(a0); UB_OP(a1); UB_OP(a2); UB_OP(a3); UB_OP(a4); UB_OP(a5); UB_OP(a6); UB_OP(a7); }
        }
        const f32x2 sum = a0 + a1 + a2 + a3 + a4 + a5 + a6 + a7;
        if (sum.x == 123.456f && sum.y == 654.321f) ((float*)(args.ws + WS_END - 4096))[tid] = sum.x;
    }
#endif
    if (IN(0)) REP(0) { p0_mod(args, lds, tid); p0_weights(args, lds, tid, wave, lane); p0_wc(args, lds, tid); }
    SEAM(0);
    if (IN(1)) REP(1) { p1_norm(args, lds, tid, wave, lane, 0); }
    SEAM(1);
    if (IN(2)) REP(2) {
        pg8::Gemm g{(const pg8::bf16_t*)(args.ws + WS_XN), (const pg8::bf16_t*)(args.ws + WS_WIN), MROWS, 2560, 1024};
        InProjOrder S; S.init((int)gridDim.x, (int)blockIdx.x);
        EpiInProj E{(bf16*)(args.ws + WS_ZS), (bf16*)(args.ws + WS_XBC), (bf16*)(args.ws + WS_UGLU)};
        pg8::gemm_phase<EpiInProj, InProjOrder, true, true>(lds, g, S, E);
    }
    SEAM(2);
    if (IN(3)) REP(3) {
        const int G3 = (int)gridDim.x, c3 = (int)blockIdx.x, NSSD = NB * NCC * 2, NCTX = NB * 2 * 2, NCONV = NB * 2 * 64;
        for (int it = c3; it < NSSD; it += G3) ssd_local_item(args, lds, it, tid, wave, lane);
        const bool split = G3 == 256;
        if (!split || c3 >= NCTX) for (int j = split ? c3 - NCTX : c3; j < NCONV; j += split ? G3 - NCTX : G3) cfm_conv_item(args, j, tid);
    }
    SEAM(3);
    if (IN(4)) REP(4) { p4_recur(args, tid); }
    SEAM(4);
    if (IN(5)) REP(5) {
        for (int it = blockIdx.x; it < NB * 32 * 2; it += gridDim.x) ssd_out_item(args, lds, it, tid, wave, lane);
        cfm_ln_rows(args, wave, lane);
    }
    SEAM(5);
    if (IN(6)) REP(6) {
        pg8::Gemm g{(const pg8::bf16_t*)(args.ws + WS_XN), (const pg8::bf16_t*)(args.ws + WS_WOUT), T, 1024, 1024};
        pg8::StaticOrder S; S.init(T, 1024, (int)gridDim.x, (int)blockIdx.x);
        EpiOutProj E{args.in[I_X], (bf16*)(args.ws + WS_X1B), (float*)(args.ws + WS_MODV)};
        pg8::gemm_phase<EpiOutProj, pg8::StaticOrder, true, true>(lds, g, S, E);
    }
    SEAM(6);
    if (IN(7)) REP(7) { p7_norm2(args, wave, lane); }
    SEAM(7);
    if (IN(8)) REP(8) {
        pg8::Gemm g{(const pg8::bf16_t*)(args.ws + WS_WC), (const pg8::bf16_t*)(args.ws + WS_XN), 2048, T, 1024};
        pg8::StaticOrder S; S.init(2048, T, (int)gridDim.x, (int)blockIdx.x);
        EpiScore E{(_Float16*)(args.ws + WS_SC)};
        pg8::gemm_phase<EpiScore, pg8::StaticOrder, true, true>(lds, g, S, E);
    }
    SEAM(8);
    if (IN(9)) REP(9) {
        p9_select_init(lds, tid); __syncthreads();
        for (int item = blockIdx.x; item < 8 * (T / 512); item += gridDim.x) p9_select_one(args, lds, tid, (item >> 3) * 512 + tid, item & 7);
    }
    SEAM(9);
#if PEER_FP8 && !defined(PEER_FLAT)
#ifdef PEER_PROBE_MASK
    if (IN(10)) { p10_gather<true>(args, lds, wave, lane, bar, PEER_PROBE_MASK); }
#endif
    if (IN(10)) REP(10) { p10_gather<false>(args, lds, wave, lane, bar, 0xffffffffu); }
#else
    if (IN(10)) REP(10) { p9_peer<false>(args, wave, lane, 0xffffffffu); }
#endif
#undef IN
#undef SEAM
}

#ifndef HOST_DUP_MASK
#define HOST_DUP_MASK 0
#endif
extern "C" void kernel_launch(void* const* d_in, const int* in_sizes, int n_in, void* d_out, int out_size, void* d_ws, size_t ws_size, hipStream_t stream) {
    static int grid = 0;
    if (grid == 0) {
        if (n_in != 25 || in_sizes[0] != T * D || out_size != T * D || ws_size < WS_END) {
            fprintf(stderr, "kernel_launch: unexpected problem (n_in %d, in0 %d, out %d, ws %zu); nothing launched\n", n_in, n_in > 0 ? in_sizes[0] : -1, out_size, ws_size); grid = -1; return; }
        int dev = 0, cus = 0, per_cu = 0;
        if (hipGetDevice(&dev) != hipSuccess || hipDeviceGetAttribute(&cus, hipDeviceAttributeMultiprocessorCount, dev) != hipSuccess) { grid = -1; return; }
        if (hipFuncSetAttribute((const void*)fwd_kernel, hipFuncAttributeMaxDynamicSharedMemorySize, LDS_BYTES) != hipSuccess) { fprintf(stderr, "kernel_launch: hipFuncSetAttribute failed\n"); grid = -1; return; }
        if (hipOccupancyMaxActiveBlocksPerMultiprocessor(&per_cu, (const void*)fwd_kernel, 512, LDS_BYTES) != hipSuccess || per_cu < 1) { fprintf(stderr, "kernel_launch: occupancy query says %d blocks/CU\n", per_cu); grid = -1; (void)hipGetLastError(); return; }
        (void)hipGetLastError();
        grid = cus;
    }
    if (grid < 0) return;
    (void)hipMemsetAsync((char*)d_ws + WS_CTL, 0, CTL_ZERO_BYTES, stream);
    Args a{};
    for (int i = 0; i < 25; ++i) a.in[i] = (const float*)d_in[i];
    a.out = (float*)d_out; a.ws = (unsigned char*)d_ws;
    if (N_LAUNCHES == 1) {
        a.ph_lo = 0; a.ph_hi = NPHASE; a.li = 0;
        hipLaunchKernelGGL(fwd_kernel, dim3(grid), dim3(512), LDS_BYTES, stream, a);
    } else {
        for (int li = 0; li < NPHASE; ++li) { a.ph_lo = li; a.ph_hi = li + 1; a.li = li;
            for (int r = 0; r < (((HOST_DUP_MASK >> li) & 1) ? 2 : 1); ++r) hipLaunchKernelGGL(fwd_kernel, dim3(grid), dim3(512), LDS_BYTES, stream, a); }
    }
}
```

```cpp
#include <hip/hip_runtime.h>
#include <cstdio>
#include <cstdint>
namespace pg8 {
#define PG8_LAS __attribute__((address_space(3)))
typedef unsigned short bf16_t;
typedef short bf16x8 __attribute__((ext_vector_type(8)));
typedef float f32x4 __attribute__((ext_vector_type(4)));
typedef unsigned u32x4 __attribute__((ext_vector_type(4)));
constexpr int BM = 256, BK = 64, HALF = 128, HTB = HALF * BK * 2  , STAGE_BYTES = 8 * HTB, NXCD = 8, WGM = 8;

__host__ __device__ __forceinline__ int lds_byte(int r, int c) { const int st = (r >> 4) * 2 + (c >> 5), rr = r & 15, cc = c & 31, ob = rr * 64 + cc * 2; return st * 1024 + (ob ^ (((ob >> 9) & 1) << 5)); }
__host__ __device__ __forceinline__ void stage_rc(int b, int& R, int& C) { const int st = b / 1024, sb = b % 1024, swz = sb ^ (((sb >> 9) & 1) << 5); R = (st >> 1) * 16 + swz / 64; C = (st & 1) * 32 + (swz % 64) / 2; }
__host__ __device__ __forceinline__ int perm32(int rho) { const int n = rho >> 4, i = rho & 15; return 8 * (i >> 2) + 4 * n + (i & 3); }

struct Unit { int pm, pn; };
struct Gemm { const bf16_t* A; const bf16_t* Bt; int M, N, K; };

struct StaticOrder {
    int nM, nN, nwg, G, c;
    __host__ __device__ void init(int M, int N, int G_, int c_) { nM = M / BM; nN = N / BM; nwg = nM * nN; G = G_; c = c_; }
    __host__ __device__ bool next(int i, Unit& u) const {
        const long L = (long)i * G + c; if (L >= nwg) return false;
        int wgid = (int)L; { const int q = nwg / NXCD, r = nwg % NXCD, xcd = wgid % NXCD, off = wgid / NXCD; wgid = (xcd < r ? xcd * (q + 1) : r * (q + 1) + (xcd - r) * q) + off; }
        const int nig = WGM * nN, gid = wgid / nig, fm = gid * WGM, gsz = (nM - fm) < WGM ? (nM - fm) : WGM;
        u.pm = fm + ((wgid % nig) % gsz); u.pn = (wgid % nig) / gsz; return true;
    }
    __device__ __forceinline__ void a_ready(const Unit&) const {}
    __device__ __forceinline__ void done(const Unit&) const {}
};

__device__ __forceinline__ unsigned cvt_pk_bf16(float lo, float hi) { unsigned r; asm volatile("v_cvt_pk_bf16_f32 %0, %1, %2" : "=v"(r) : "v"(lo), "v"(hi)); return r; }
template <class Epi, class Sched, bool ALIGN_EPI = false, bool SP2 = false>
__device__ __forceinline__ void gemm_phase(PG8_LAS unsigned char* lds, const Gemm g, const Sched& S, const Epi& E) {
    const int tid = threadIdx.x, wid = __builtin_amdgcn_readfirstlane(tid >> 6), lane = tid & 63, wr = wid >> 2, wc = wid & 3, fr = lane & 15, fq = lane >> 4;
    const int K = g.K, nt = K / BK;
    unsigned voffA[2], voffB[2];
#pragma unroll
    for (int i = 0; i < 2; ++i) { int R, C; stage_rc(tid * 16 + i * 8192, R, C); const int Rb = Epi::PERM ? ((R & ~31) + perm32(R & 31)) : R;
        voffA[i] = (unsigned)(R * K + C) * 2u; voffB[i] = (unsigned)(Rb * K + C) * 2u; }
    const size_t kstep = (size_t)(BK * 2);
    const size_t hstep = (size_t)HALF * K * 2;
    const size_t tstep = 2 * hstep;
    const unsigned ldsw = (unsigned)wid * 1024u;
    const int aoff = lds_byte(wr * 64 + fr, fq * 8), boff = lds_byte(wc * 32 + fr, fq * 8);
#define PG8_SA(b, h) (((b) * 2 + (h)) * HTB)
#define PG8_SB(b, h) ((4 + (b) * 2 + (h)) * HTB)
#define PG8_STAGE(bufoff, gbase, voff) do { _Pragma("unroll") for (int _i = 0; _i < 2; ++_i) \
        __builtin_amdgcn_global_load_lds((const unsigned*)((const char*)(gbase) + (voff)[_i]), (PG8_LAS unsigned*)(lds + (bufoff) + ldsw + _i * 8192), 16, 0, 0); } while (0)
#define PG8_LDA(dst, b, h) do { _Pragma("unroll") for (int m = 0; m < 4; ++m) _Pragma("unroll") for (int k = 0; k < 2; ++k) dst[m][k] = *(const PG8_LAS bf16x8*)(lds + PG8_SA(b, h) + aoff + m * 2048 + k * 1024); } while (0)
#define PG8_LDB(dst, b, h) do { _Pragma("unroll") for (int n = 0; n < 2; ++n) _Pragma("unroll") for (int k = 0; k < 2; ++k) dst[n][k] = *(const PG8_LAS bf16x8*)(lds + PG8_SB(b, h) + boff + n * 2048 + k * 1024); } while (0)
#define PG8_MMA(ai, bj, At, Bt) do { __builtin_amdgcn_s_setprio(1); _Pragma("unroll") for (int m = 0; m < 4; ++m) _Pragma("unroll") for (int n = 0; n < 2; ++n) _Pragma("unroll") for (int k = 0; k < 2; ++k) \
        acc[ai][bj][m][n] = __builtin_amdgcn_mfma_f32_16x16x32_bf16(Bt[n][k], At[m][k], acc[ai][bj][m][n], 0, 0, 0); __builtin_amdgcn_s_setprio(0); } while (0)
#define PG8_WAIT_V(n) asm volatile("s_waitcnt vmcnt(" #n ")" ::: "memory")
#define PG8_WAIT_L(n) asm volatile("s_waitcnt lgkmcnt(" #n ")" ::: "memory")
#define PG8_BAR __builtin_amdgcn_s_barrier()
#define PG8_SCHED __builtin_amdgcn_sched_barrier(0)
    Unit cur, nxt; int ui = 0;
    if (!S.next(0, cur)) return;
    f32x4 acc[2][2][4][2];
#pragma unroll
    for (int a = 0; a < 2; ++a)
#pragma unroll
        for (int b = 0; b < 2; ++b)
#pragma unroll
            for (int m = 0; m < 4; ++m)
#pragma unroll
                for (int n = 0; n < 2; ++n) acc[a][b][m][n] = (f32x4){0.f, 0.f, 0.f, 0.f};
    bf16x8 At[4][2], B0[2][2], B1[2][2];
    const char* cA = (const char*)g.A + (size_t)cur.pm * tstep; const char* cB = (const char*)g.Bt + (size_t)cur.pn * tstep;
    S.a_ready(cur);
    if constexpr (SP2) {
        PG8_STAGE(PG8_SB(0, 0), cB, voffB); PG8_STAGE(PG8_SB(0, 1), cB + hstep, voffB); PG8_STAGE(PG8_SA(0, 0), cA, voffA); PG8_STAGE(PG8_SA(0, 1), cA + hstep, voffA);
        if (wr == 1) PG8_BAR;
        PG8_WAIT_V(2); PG8_BAR;
        PG8_STAGE(PG8_SB(1, 0), cB + kstep, voffB); PG8_STAGE(PG8_SA(1, 0), cA + kstep, voffA); PG8_STAGE(PG8_SB(1, 1), cB + hstep + kstep, voffB);
        PG8_WAIT_V(6); PG8_BAR;
    } else {
        PG8_STAGE(PG8_SB(0, 0), cB, voffB); PG8_STAGE(PG8_SA(0, 0), cA, voffA); PG8_STAGE(PG8_SB(0, 1), cB + hstep, voffB); PG8_STAGE(PG8_SA(0, 1), cA + hstep, voffA);
        if (wr == 1) PG8_BAR;
        PG8_WAIT_V(4); PG8_BAR;
        PG8_STAGE(PG8_SB(1, 0), cB + kstep, voffB); PG8_STAGE(PG8_SA(1, 0), cA + kstep, voffA); PG8_STAGE(PG8_SB(1, 1), cB + hstep + kstep, voffB);
        PG8_WAIT_V(6); PG8_BAR;
    }
    for (;;) {
        const bool has_next = S.next(ui + 1, nxt);
        const char* nA = has_next ? (const char*)g.A + (size_t)nxt.pm * tstep : cA; const char* nB = has_next ? (const char*)g.Bt + (size_t)nxt.pn * tstep : cB;
        for (int t = 0; t < nt; t += 2) {
            const bool last = (t == nt - 2);
            const char* a1 = cA + (size_t)(t + 1) * kstep;
            const char* a2 = last ? nA : cA + (size_t)(t + 2) * kstep; const char* b2 = last ? nB : cB + (size_t)(t + 2) * kstep;
            const char* a3 = a2 + kstep; const char* b3 = b2 + kstep;
            if (last && has_next) S.a_ready(nxt);
            if constexpr (SP2) {
            PG8_LDB(B0, 0, 0); PG8_LDB(B1, 0, 1); PG8_SCHED; PG8_LDA(At, 0, 0); PG8_STAGE(PG8_SA(1, 1), a1 + hstep, voffA);
            PG8_WAIT_V(8); PG8_WAIT_L(0); PG8_BAR; PG8_MMA(0, 0, At, B0); PG8_MMA(0, 1, At, B1); PG8_BAR; PG8_SCHED;
            PG8_LDA(At, 0, 1); PG8_STAGE(PG8_SB(0, 0), b2, voffB); PG8_STAGE(PG8_SB(0, 1), b2 + hstep, voffB); PG8_STAGE(PG8_SA(0, 0), a2, voffA);
            PG8_WAIT_V(8); PG8_WAIT_L(0); PG8_BAR; PG8_MMA(1, 0, At, B0); PG8_MMA(1, 1, At, B1); PG8_BAR; PG8_SCHED;
            PG8_LDB(B0, 1, 0); PG8_LDB(B1, 1, 1); PG8_SCHED; PG8_LDA(At, 1, 0); PG8_STAGE(PG8_SA(0, 1), a2 + hstep, voffA);
            PG8_WAIT_V(8); PG8_WAIT_L(0); PG8_BAR; PG8_MMA(0, 0, At, B0); PG8_MMA(0, 1, At, B1); PG8_BAR; PG8_SCHED;
            PG8_LDA(At, 1, 1); PG8_STAGE(PG8_SB(1, 0), b3, voffB); PG8_STAGE(PG8_SB(1, 1), b3 + hstep, voffB); PG8_STAGE(PG8_SA(1, 0), a3, voffA);
            PG8_WAIT_V(8); PG8_WAIT_L(0); PG8_BAR; PG8_MMA(1, 0, At, B0); PG8_MMA(1, 1, At, B1); PG8_BAR; PG8_SCHED;
            } else {
            PG8_LDB(B0, 0, 0); PG8_SCHED; PG8_LDA(At, 0, 0); PG8_STAGE(PG8_SA(1, 1), a1 + hstep, voffA);
            PG8_WAIT_L(8); PG8_BAR; PG8_WAIT_L(0); PG8_MMA(0, 0, At, B0); PG8_BAR; PG8_SCHED;
            PG8_LDB(B1, 0, 1); PG8_STAGE(PG8_SB(0, 0), b2, voffB);
            PG8_BAR; PG8_WAIT_L(0); PG8_MMA(0, 1, At, B1); PG8_BAR;
            PG8_LDA(At, 0, 1); PG8_STAGE(PG8_SA(0, 0), a2, voffA);
            PG8_BAR; PG8_WAIT_L(0); PG8_MMA(1, 0, At, B0); PG8_BAR; PG8_SCHED;
            PG8_STAGE(PG8_SB(0, 1), b2 + hstep, voffB);
            PG8_WAIT_V(6); PG8_BAR; PG8_MMA(1, 1, At, B1); PG8_BAR;
            PG8_LDB(B0, 1, 0); PG8_SCHED; PG8_LDA(At, 1, 0); PG8_STAGE(PG8_SA(0, 1), a2 + hstep, voffA);
            PG8_WAIT_L(8); PG8_BAR; PG8_WAIT_L(0); PG8_MMA(0, 0, At, B0); PG8_BAR; PG8_SCHED;
            PG8_LDB(B1, 1, 1); PG8_STAGE(PG8_SB(1, 0), b3, voffB);
            PG8_BAR; PG8_WAIT_L(0); PG8_MMA(0, 1, At, B1); PG8_BAR;
            PG8_LDA(At, 1, 1); PG8_STAGE(PG8_SA(1, 0), a3, voffA);
            PG8_BAR; PG8_WAIT_L(0); PG8_MMA(1, 0, At, B0); PG8_BAR; PG8_SCHED;
            PG8_STAGE(PG8_SB(1, 1), b3 + hstep, voffB);
            PG8_WAIT_V(6); PG8_BAR; PG8_MMA(1, 1, At, B1); PG8_BAR;
            }
        }
        if constexpr (ALIGN_EPI) { if (wr == 0) PG8_BAR; }
        if constexpr (!Epi::AFTER_DRAIN) { E(acc, cur, wr, wc, fr, fq); S.done(cur); }
        if (!has_next) break;
#pragma unroll
        for (int a = 0; a < 2; ++a)
#pragma unroll
            for (int b = 0; b < 2; ++b)
#pragma unroll
                for (int m = 0; m < 4; ++m)
#pragma unroll
                    for (int n = 0; n < 2; ++n) acc[a][b][m][n] = (f32x4){0.f, 0.f, 0.f, 0.f};
        cur = nxt; cA = nA; cB = nB; ++ui;
        if constexpr (ALIGN_EPI) { if (wr == 1) PG8_BAR; }
    }
    PG8_WAIT_V(0);
    if constexpr (!ALIGN_EPI) { if (wr == 0) PG8_BAR; }
    PG8_BAR;
    if constexpr (Epi::AFTER_DRAIN) { E.fused(acc, cur, wr, wc, fr, fq, lds, wid, lane); S.done(cur); }
#undef PG8_SA
#undef PG8_SB
#undef PG8_STAGE
#undef PG8_LDA
#undef PG8_LDB
#undef PG8_MMA
#undef PG8_WAIT_V
#undef PG8_WAIT_L
#undef PG8_BAR
#undef PG8_SCHED
}
}
#ifndef PEER_FP8
#define PEER_FP8 1
#endif
#ifndef MK_N_LAUNCHES
#define MK_N_LAUNCHES 1
#endif
constexpr int NPHASE = 11;
constexpr int N_LAUNCHES = MK_N_LAUNCHES;

constexpr int NB = 8, SEQ = 4096, D = 1024, T = NB * SEQ, CTXL = 256, TC = NB * CTXL, MROWS = T + TC;
constexpr int NCC = 34;
constexpr int IN_COLS = 2576, DT_COL0 = 1536, GLU_COL0 = 1552;
constexpr int NEXP = 16384;
constexpr float EPS = 1e-6f;

constexpr size_t MiB = 1u << 20;
constexpr size_t WS_CTL = 0, CTL_ZERO_BYTES = 64 * 1024;
constexpr size_t WS_MODV = 1 * MiB;
constexpr size_t WS_CS = 2 * MiB;
constexpr size_t WS_DEC = 4 * MiB;
constexpr size_t WS_DT = 5 * MiB;
constexpr size_t WS_USC = 7 * MiB + 256 * 1024, WS_VSC = 7 * MiB + 512 * 1024;
constexpr size_t WS_WIN = 8 * MiB;
constexpr size_t WS_WOUT = 13 * MiB;
constexpr size_t WS_WC = 15 * MiB;
constexpr size_t WS_U = 20 * MiB, WS_V = 52 * MiB;
constexpr size_t WS_XN = 84 * MiB;
constexpr size_t WS_XBC = 152 * MiB;
constexpr size_t WS_ZS = 220 * MiB;
constexpr size_t WS_UGLU = 252 * MiB;
constexpr size_t WS_YD = 284 * MiB;
constexpr size_t WS_SLOC = 316 * MiB;
constexpr size_t WS_CONVO = 384 * MiB;
constexpr size_t WS_CCONV = 416 * MiB;
constexpr size_t WS_SC = 152 * MiB;
constexpr size_t WS_X1B = 284 * MiB;
constexpr size_t WS_EIDX = 432 * MiB;
constexpr size_t WS_GATE = 448 * MiB;
constexpr size_t WS_USA = 464 * MiB;
constexpr size_t WS_END = 480 * MiB;
constexpr int CW_BAR = 4096;

constexpr int RING_BYTES = 131072, LDSCTL_OFF = 143360, MISC_OFF = LDSCTL_OFF + 320, LDS_BYTES = 147456;

#define GAS __attribute__((address_space(1)))
#define LAS __attribute__((address_space(3)))
typedef unsigned short bf16;
typedef unsigned v4u __attribute__((ext_vector_type(4)));
typedef unsigned v2u __attribute__((ext_vector_type(2)));
typedef float f32x4 __attribute__((ext_vector_type(4)));
typedef float f32x2 __attribute__((ext_vector_type(2)));
typedef short bf16x8 __attribute__((ext_vector_type(8)));
typedef GAS unsigned gu32;
#define RLX_AGENT __ATOMIC_RELAXED, __HIP_MEMORY_SCOPE_AGENT
__device__ __forceinline__ unsigned f2bf(float f) { unsigned u = __builtin_bit_cast(unsigned, f); return (u + 0x7fffu + ((u >> 16) & 1u)) >> 16; }
typedef __bf16 bf16x2_t __attribute__((ext_vector_type(2)));
__device__ __forceinline__ unsigned pk2(float lo, float hi) { const f32x2 v = {lo, hi}; return __builtin_bit_cast(unsigned, __builtin_convertvector(v, bf16x2_t)); }
__device__ __forceinline__ float bflo(unsigned u) { return __builtin_bit_cast(float, u << 16); }
__device__ __forceinline__ float bfhi(unsigned u) { return __builtin_bit_cast(float, u & 0xffff0000u); }
template <int CTRL> __device__ __forceinline__ float dppf(float x) { return __builtin_bit_cast(float, __builtin_amdgcn_mov_dpp(__builtin_bit_cast(int, x), CTRL, 0xf, 0xf, true)); }
__device__ __forceinline__ float swapsum32(float a, float b) { auto r = __builtin_amdgcn_permlane32_swap(__builtin_bit_cast(unsigned, a), __builtin_bit_cast(unsigned, b), false, false); const unsigned r0 = r[0], r1 = r[1]; return __uint_as_float(r0) + __uint_as_float(r1); }
__device__ __forceinline__ float swapsum16(float a, float b) { auto r = __builtin_amdgcn_permlane16_swap(__builtin_bit_cast(unsigned, a), __builtin_bit_cast(unsigned, b), false, false); const unsigned r0 = r[0], r1 = r[1]; return __uint_as_float(r0) + __uint_as_float(r1); }
__device__ __forceinline__ float allsumf8(float m) { m += dppf<0xB1>(m); m += dppf<0x4E>(m); m += dppf<0x141>(m); return m; }
__device__ __forceinline__ float allsumf16(float m) { m = allsumf8(m); m += dppf<0x140>(m); return m; }
__device__ __forceinline__ float wave_sum(float v) { v = allsumf16(v); v = swapsum16(v, v); return swapsum32(v, v); }
__device__ __forceinline__ void wave_tsum16(float (&p)[16], int lane) {
#pragma unroll
    for (int k = 0; k < 8; ++k) p[k] = swapsum32(p[k], p[k + 8]);
#pragma unroll
    for (int k = 0; k < 4; ++k) p[k] = swapsum16(p[k], p[k + 4]);
    const bool up = (lane & 8) != 0;
#pragma unroll
    for (int k = 0; k < 2; ++k) { const float snd = up ? p[k] : p[k + 2]; const float keep = up ? p[k + 2] : p[k]; p[k] = keep + dppf<0x128>(snd); }
    p[0] = allsumf8(p[0]); p[1] = allsumf8(p[1]);
}
__device__ __forceinline__ size_t x1b_off(int r, int c) { return ((size_t)(r >> 4) * 32 + (c >> 5)) * 512 + (r & 15) * 32 + (c & 31); }
__device__ __forceinline__ float silu_f(float x) { return x * __builtin_amdgcn_rcpf(1.f + __expf(-x)); }
__device__ __forceinline__ float sigmoid_f(float x) { return __builtin_amdgcn_rcpf(1.f + __expf(-x)); }
__device__ __forceinline__ float softplus_f(float x) { return fmaxf(x, 0.f) + log1pf(__expf(-fabsf(x))); }
__device__ __forceinline__ float gelu_f(float x) { return 0.5f * x * (1.f + erff(x * 0.70710678118654752f)); }

#define XB_TMO      128
#define XB_XCNT(j)  (256  + 64 * (j))
#define XB_XSUB(j)  (1280 + 64 * (j))
#define XB_XGEN(j)  (2304 + 64 * (j))
#define XB_TOP      3328
#define XB_TOPGEN   3392
#define XCD_BAR_WORDS 3456
#define XB_SPIN_CAP (1u << 22)
__device__ __forceinline__ unsigned xb_ld(unsigned* p)              { return __hip_atomic_load(p, __ATOMIC_RELAXED, __HIP_MEMORY_SCOPE_AGENT); }
__device__ __forceinline__ unsigned xb_add(unsigned* p, unsigned v) { return __hip_atomic_fetch_add(p, v, __ATOMIC_RELAXED, __HIP_MEMORY_SCOPE_AGENT); }
__device__ __forceinline__ unsigned xb_xcc_id() { return (unsigned)__builtin_amdgcn_s_getreg((3 << 11) | 20) & 0xFu; }
#define XB_SPIN(cond, bar) do { unsigned _sp = 0; while (cond) { __builtin_amdgcn_s_sleep(1); \
    if ((++_sp & 255u) == 0u) { if (xb_ld(&(bar)[XB_TMO])) break; if (_sp > XB_SPIN_CAP) { atomicAdd(&(bar)[XB_TMO], 1u); break; } } } } while (0)

struct XcdBarrier {
    unsigned* bar; unsigned x;
    volatile LAS unsigned* st;
};

__device__ __forceinline__ XcdBarrier xcd_barrier_post(unsigned* bar, volatile LAS unsigned* st) {
    XcdBarrier b; b.bar = bar; b.x = xb_xcc_id(); b.st = st;
    if (threadIdx.x == 0) (void)xb_add(&bar[XB_XCNT(b.x)], 1u);
    return b;
}
__device__ __forceinline__ void xcd_barrier_complete(unsigned* bar, unsigned x, unsigned& nloc, unsigned& nx) {
    const unsigned G = gridDim.x * gridDim.y * gridDim.z;
    unsigned sum, cnt, mine, sp = 0u;
    for (;;) {
        sum = 0u; cnt = 0u; mine = 0u;
#pragma unroll
        for (unsigned j = 0; j < 16; ++j) { const unsigned c = xb_ld(&bar[XB_XCNT(j)]); sum += c; cnt += (c > 0u) ? 1u : 0u; mine = (j == x) ? c : mine; }
        if (sum == G) break;
        __builtin_amdgcn_s_sleep(1);
        if ((++sp & 255u) == 0u) { if (xb_ld(&bar[XB_TMO])) break; if (sp > XB_SPIN_CAP) { atomicAdd(&bar[XB_TMO], 1u); break; } }
    }
    nloc = mine > 0u ? mine : 1u; nx = cnt > 0u ? cnt : 1u;
}

__device__ __forceinline__ void xcd_barrier(const XcdBarrier& b) {
    asm volatile("s_waitcnt vmcnt(0)" ::: "memory");
    __syncthreads();
    if (threadIdx.x == 0) {
        unsigned* bar = b.bar;
        __builtin_amdgcn_s_waitcnt(0);
        unsigned nloc = b.st[0], nx = b.st[1];
        if (nloc == 0u) { xcd_barrier_complete(bar, b.x, nloc, nx); b.st[0] = nloc; b.st[1] = nx; }
        const unsigned old = xb_add(&bar[XB_XSUB(b.x)], 1u);
        const unsigned gen = old / nloc;
        if (old + 1u == (gen + 1u) * nloc) {
            __builtin_amdgcn_fence(__ATOMIC_RELEASE, "agent");
            asm volatile("s_waitcnt vmcnt(0)" ::: "memory");
            const unsigned og = xb_add(&bar[XB_TOP], 1u);
            const unsigned tg = og / nx;
            if (og + 1u == (tg + 1u) * nx) xb_add(&bar[XB_TOPGEN], 1u);
            else XB_SPIN(xb_ld(&bar[XB_TOPGEN]) == tg, bar);
            __builtin_amdgcn_fence(__ATOMIC_ACQUIRE, "agent");
            xb_add(&bar[XB_XGEN(b.x)], 1u);
            asm volatile("s_waitcnt vmcnt(0)" ::: "memory");
        } else {
            XB_SPIN(xb_ld(&bar[XB_XGEN(b.x)]) == gen, bar);
            __builtin_amdgcn_fence(__ATOMIC_ACQUIRE, "agent");
            asm volatile("s_waitcnt vmcnt(0)" ::: "memory");
        }
    }
    __syncthreads();
}
struct EpiInProj {
    static constexpr bool PERM = true, AFTER_DRAIN = false;
    bf16* ZS; bf16* XBC; bf16* UG;
    __device__ __forceinline__ void operator()(const pg8::f32x4 (&acc)[2][2][4][2], const pg8::Unit& u, int wr, int wc, int fr, int fq) const {
        const int row0 = u.pm * 256 + wr * 64 + fr, cl0 = wc * 32 + 8 * fq;
        if (u.pn < 2) {
#pragma unroll
            for (int ai = 0; ai < 2; ++ai)
#pragma unroll
                for (int m = 0; m < 4; ++m) { bf16* rowp = ZS + (size_t)(row0 + ai * 128 + m * 16) * 512 + u.pn * 256 + cl0;
#pragma unroll
                    for (int bj = 0; bj < 2; ++bj) { const pg8::f32x4 a = acc[ai][bj][m][0], b = acc[ai][bj][m][1]; v4u w;
                        w.x = pk2(silu_f(a[0]), silu_f(a[1])); w.y = pk2(silu_f(a[2]), silu_f(a[3])); w.z = pk2(silu_f(b[0]), silu_f(b[1])); w.w = pk2(silu_f(b[2]), silu_f(b[3]));
                        *(v4u*)(rowp + bj * 128) = w; } }
        } else if (u.pn < 6) {
#pragma unroll
            for (int ai = 0; ai < 2; ++ai)
#pragma unroll
                for (int m = 0; m < 4; ++m) { bf16* rowp = XBC + (size_t)(row0 + ai * 128 + m * 16) * 1024 + (u.pn - 2) * 256 + cl0;
#pragma unroll
                    for (int bj = 0; bj < 2; ++bj) { const pg8::f32x4 a = acc[ai][bj][m][0], b = acc[ai][bj][m][1]; v4u w;
                        w.x = pk2(a[0], a[1]); w.y = pk2(a[2], a[3]); w.z = pk2(b[0], b[1]); w.w = pk2(b[2], b[3]);
                        *(v4u*)(rowp + bj * 128) = w; } }
        } else {
            const int ch0 = 128 * (u.pn - 6) + 16 * wc + 4 * fq;
#pragma unroll
            for (int ai = 0; ai < 2; ++ai)
#pragma unroll
                for (int m = 0; m < 4; ++m) { bf16* rowp = UG + (size_t)(row0 + ai * 128 + m * 16) * 512 + ch0;
#pragma unroll
                    for (int bj = 0; bj < 2; ++bj) { const pg8::f32x4 a = acc[ai][bj][m][0], g = acc[ai][bj][m][1]; v2u w;
                        w.x = pk2(a[0] * sigmoid_f(g[0]), a[1] * sigmoid_f(g[1])); w.y = pk2(a[2] * sigmoid_f(g[2]), a[3] * sigmoid_f(g[3]));
                        *(v2u*)(rowp + bj * 64) = w; } }
        }
    }
};
struct EpiOutProj {
    static constexpr bool PERM = true, AFTER_DRAIN = false;
    const float* X; bf16* X1; float* MODV;
    __device__ __forceinline__ void operator()(const pg8::f32x4 (&acc)[2][2][4][2], const pg8::Unit& u, int wr, int wc, int fr, int fq) const {
        const int row0 = u.pm * 256 + wr * 64 + fr, col0 = u.pn * 256 + wc * 32 + 8 * fq;
        const float* gp = MODV + (size_t)(row0 >> 12) * 6144 + 2 * 1024 + col0;
        pg8::f32x4 g[2][2];
#pragma unroll
        for (int bj = 0; bj < 2; ++bj) { g[bj][0] = *(const pg8::f32x4*)(gp + bj * 128); g[bj][1] = *(const pg8::f32x4*)(gp + bj * 128 + 4); }
#pragma unroll
        for (int ai = 0; ai < 2; ++ai) {
            pg8::f32x4 xv[4][2][2];
#pragma unroll
            for (int m = 0; m < 4; ++m) { const size_t o = (size_t)(row0 + ai * 128 + m * 16) * 1024 + col0;
#pragma unroll
                for (int bj = 0; bj < 2; ++bj) { xv[m][bj][0] = *(const pg8::f32x4*)(X + o + bj * 128); xv[m][bj][1] = *(const pg8::f32x4*)(X + o + bj * 128 + 4); } }
#pragma unroll
            for (int m = 0; m < 4; ++m) { const size_t o = (size_t)(row0 + ai * 128 + m * 16) * 1024 + col0;
#pragma unroll
                for (int bj = 0; bj < 2; ++bj) {
                    const pg8::f32x4 y0 = xv[m][bj][0] + g[bj][0] * acc[ai][bj][m][0], y1 = xv[m][bj][1] + g[bj][1] * acc[ai][bj][m][1];
                    v4u w; w.x = pk2(y0[0], y0[1]); w.y = pk2(y0[2], y0[3]); w.z = pk2(y1[0], y1[1]); w.w = pk2(y1[2], y1[3]);
                    *(v4u*)(X1 + ((size_t)(u.pm * 16 + ai * 8 + wr * 4 + m) * 32 + u.pn * 8 + bj * 4 + wc) * 512 + fr * 32 + 8 * fq) = w; } } }
    }
};
struct EpiScore {
    static constexpr bool PERM = true, AFTER_DRAIN = false;
    _Float16* SC;
    __device__ __forceinline__ void operator()(const pg8::f32x4 (&acc)[2][2][4][2], const pg8::Unit& u, int wr, int wc, int fr, int fq) const {
        const int row0 = u.pm * 256 + wr * 64 + fr, col0 = u.pn * 256 + wc * 32 + 8 * fq;
        typedef _Float16 h8 __attribute__((ext_vector_type(8)));
#pragma unroll
        for (int ai = 0; ai < 2; ++ai)
#pragma unroll
            for (int m = 0; m < 4; ++m) { const int rb = u.pm * 16 + ai * 8 + wr * 4 + m;
#pragma unroll
                for (int bj = 0; bj < 2; ++bj) { const pg8::f32x4 a = acc[ai][bj][m][0], b = acc[ai][bj][m][1]; const int cb = u.pn * 8 + bj * 4 + wc;
                    h8 o = {(_Float16)a[0], (_Float16)a[1], (_Float16)a[2], (_Float16)a[3], (_Float16)b[0], (_Float16)b[1], (_Float16)b[2], (_Float16)b[3]};
                    *(h8*)(SC + ((size_t)rb * (T / 32) + cb) * 512 + fr * 32 + 8 * fq) = o; } }
    }
};
struct InProjOrder {
    pg8::StaticOrder S; int G, c;
    __device__ void init(int G_, int c_) { S.init(T, 2560, G_, c_); G = G_; c = c_; }
    __device__ bool next(int i, pg8::Unit& u) const {
        const long L = (long)i * G + c;
        if (L < 1280) return S.next(i, u);
        if (L >= 1312) return false;
        const int l2 = (int)L - 1280; u.pm = 128 + (l2 >> 2); u.pn = 2 + (l2 & 3); return true;
    }
    __device__ __forceinline__ void a_ready(const pg8::Unit&) const {}
    __device__ __forceinline__ void done(const pg8::Unit&) const {}
};
struct Args { const float* in[25]; float* out; unsigned char* ws; int ph_lo, ph_hi, li, pad; };
enum { I_X = 0, I_C, I_CTX, I_CCTX, I_ADAW, I_ADAB, I_N1W, I_N2W, I_WIN, I_SCW, I_SCB, I_DTB, I_ALOG, I_SSD, I_SNW, I_CCW, I_CCB, I_CLW, I_CLB, I_WOUT, I_WQ, I_SK, I_PU, I_PV, I_FNW };

__device__ __forceinline__ void p0_mod(const Args& A, LAS unsigned char* lds, int tid) {
    LAS float* s = (LAS float*)lds;
    LAS float* red = (LAS float*)(lds + 36864);
    const float* c = A.in[I_C]; const float* cctx = A.in[I_CCTX]; const float* adaw = A.in[I_ADAW]; const float* adab = A.in[I_ADAB];
    float* MODV = (float*)(A.ws + WS_MODV);
    for (int item = blockIdx.x; item < 192; item += gridDim.x) {
        for (int i = tid; i < 9 * 1024; i += 512) { const int b = i >> 10, k = i & 1023; const float v = (b < 8) ? c[b * 1024 + k] : cctx[k]; s[i] = silu_f(v); }
        __syncthreads();
        const int chunk = tid & 7, rg = tid >> 3, col = item * 32 + chunk * 4;
        f32x4 acc[9];
#pragma unroll
        for (int b = 0; b < 9; ++b) acc[b] = (f32x4){0.f, 0.f, 0.f, 0.f};
#pragma unroll 4
        for (int i = 0; i < 16; ++i) { const int r = rg + 64 * i; const f32x4 w = *(const f32x4*)(adaw + (size_t)r * 6144 + col);
#pragma unroll
            for (int b = 0; b < 9; ++b) acc[b] += w * s[b * 1024 + r]; }
#pragma unroll
        for (int b = 0; b < 9; ++b) *(LAS f32x4*)(red + (rg * 9 + b) * 32 + chunk * 4) = acc[b];
        __syncthreads();
        if (tid < 288) { const int b = tid >> 5, cc = tid & 31; float sum = 0.f;
            for (int r2 = 0; r2 < 64; ++r2) sum += red[(r2 * 9 + b) * 32 + cc];
            MODV[b * 6144 + item * 32 + cc] = sum + adab[item * 32 + cc]; }
        __syncthreads();
    }
}
__device__ __forceinline__ int win_dest(int n) {
    if (n < 1536) return n;
    int ch = n - GLU_COL0;
    if (ch < 512) return 1536 + 8 * (ch >> 2) + (ch & 3);
    ch -= 512; return 1536 + 8 * (ch >> 2) + 4 + (ch & 3);
}
template <int MODE>
__device__ __forceinline__ void transpose_item(const float* W, int ldw, int k0, int n0, bf16* WT, LAS float* scr, int lane) {
#pragma unroll 8
    for (int i = 0; i < 32; ++i) { const int kk = 2 * i + (lane >> 5); scr[kk * 33 + (lane & 31)] = W[(size_t)(k0 + kk) * ldw + n0 + (lane & 31)]; }
    asm volatile("s_waitcnt lgkmcnt(0)" ::: "memory");
    const int c = lane & 7;
#pragma unroll
    for (int j = 0; j < 4; ++j) { const int n = (lane >> 3) + 8 * j; const LAS float* sp = scr + (8 * c) * 33 + n;
        v4u o; o.x = pk2(sp[0 * 33], sp[1 * 33]); o.y = pk2(sp[2 * 33], sp[3 * 33]); o.z = pk2(sp[4 * 33], sp[5 * 33]); o.w = pk2(sp[6 * 33], sp[7 * 33]);
        const int row = (MODE == 1) ? win_dest(n0 + n) : (n0 + n);
        *(v4u*)(WT + (size_t)row * 1024 + k0 + 8 * c) = o; }
    asm volatile("s_waitcnt lgkmcnt(0)" ::: "memory");
}
__device__ __forceinline__ void p0_weights(const Args& A, LAS unsigned char* lds, int tid, int wave, int lane) {
    LAS float* scr = (LAS float*)(lds + wave * 16384);
    const int gw = blockIdx.x * 8 + wave, NGW = gridDim.x * 8;
    bf16* WIN = (bf16*)(A.ws + WS_WIN); bf16* WOUT = (bf16*)(A.ws + WS_WOUT);
    for (int it = gw; it < 80 * 16 + 32 * 16; it += NGW) {
        if (it < 80 * 16) { const int nb = it >> 4, kb = it & 15; const int n0 = nb < 48 ? 32 * nb : GLU_COL0 + 32 * (nb - 48);
            transpose_item<1>(A.in[I_WIN], IN_COLS, 64 * kb, n0, WIN, scr, lane); }
        else { const int r = it - 80 * 16; transpose_item<0>(A.in[I_WOUT], 1024, 64 * (r & 15), 32 * (r >> 4), WOUT, scr, lane); }
    }
    const float* pu = A.in[I_PU]; const float* pv = A.in[I_PV];
#if PEER_FP8
    for (int row = gw; row < 2 * NEXP; row += NGW) {
        const int r = row & (NEXP - 1); const bool isv = row >= NEXP;
        const float* src = (isv ? pv : pu) + (size_t)r * 1024 + 4 * lane;
        f32x4 v[4]; float am = 0.f;
#pragma unroll
        for (int j = 0; j < 4; ++j) { v[j] = *(const f32x4*)(src + 256 * j); am = fmaxf(am, fmaxf(fmaxf(fabsf(v[j][0]), fabsf(v[j][1])), fmaxf(fabsf(v[j][2]), fabsf(v[j][3])))); }
#pragma unroll
        for (int o = 1; o < 64; o <<= 1) am = fmaxf(am, __shfl_xor(am, o));
        const float inv = am > 0.f ? 440.f / am : 0.f;
        unsigned char* dst = A.ws + (isv ? WS_V : WS_U) + (size_t)r * 1024 + 4 * lane;
        if (isv) {
#pragma unroll
            for (int j = 0; j < 4; ++j) { int w = __builtin_amdgcn_cvt_pk_fp8_f32(v[j][0] * inv, v[j][1] * inv, 0, false); w = __builtin_amdgcn_cvt_pk_fp8_f32(v[j][2] * inv, v[j][3] * inv, w, true);
                *(unsigned*)(dst + 256 * j) = (unsigned)w; }
            if (lane == 0) ((float*)(A.ws + WS_VSC))[r] = am * (1.f / 440.f);
        } else {
            const float inv8 = am > 0.f ? 127.f / am : 0.f;
#pragma unroll
            for (int j = 0; j < 4; ++j) { const unsigned w = ((unsigned)__float2int_rn(v[j][0] * inv8) & 255u) | (((unsigned)__float2int_rn(v[j][1] * inv8) & 255u) << 8)
                                                        | (((unsigned)__float2int_rn(v[j][2] * inv8) & 255u) << 16) | (((unsigned)__float2int_rn(v[j][3] * inv8) & 255u) << 24);
                *(unsigned*)(dst + 256 * j) = w; }
            if (lane == 0) ((float*)(A.ws + WS_USC))[r] = am * (1.f / 127.f);
        }
    }
#else
    bf16* U = (bf16*)(A.ws + WS_U); bf16* V = (bf16*)(A.ws + WS_V);
    const size_t nthr = (size_t)gridDim.x * 512, gt = (size_t)blockIdx.x * 512 + tid;
    for (size_t i = gt; i < (size_t)NEXP * 1024 / 8; i += nthr) {
        const f32x4 a = *(const f32x4*)(pu + i * 8), b = *(const f32x4*)(pu + i * 8 + 4);
        v4u o; o.x = pk2(a[0], a[1]); o.y = pk2(a[2], a[3]); o.z = pk2(b[0], b[1]); o.w = pk2(b[2], b[3]); *(v4u*)(U + i * 8) = o;
        const f32x4 c2 = *(const f32x4*)(pv + i * 8), d2 = *(const f32x4*)(pv + i * 8 + 4);
        v4u q; q.x = pk2(c2[0], c2[1]); q.y = pk2(c2[2], c2[3]); q.z = pk2(d2[0], d2[1]); q.w = pk2(d2[2], d2[3]); *(v4u*)(V + i * 8) = q;
    }
#endif
}
__device__ __forceinline__ void p0_wc(const Args& A, LAS unsigned char* lds, int tid) {
    LAS float* wqs = (LAS float*)lds;
    LAS float* sks = (LAS float*)(lds + 32768);
    const float* wq = A.in[I_WQ]; const float* sk = A.in[I_SK]; bf16* WC = (bf16*)(A.ws + WS_WC);
    for (int item = blockIdx.x; item < 256; item += gridDim.x) {
        const int hp = item >> 4, k0 = (item & 15) * 64;
        __syncthreads();
        for (int i = tid; i < 64 * 32; i += 512) { const int kk = i >> 5, d4 = i & 31; *(LAS f32x4*)(wqs + kk * 128 + 4 * d4) = *(const f32x4*)(wq + (size_t)(k0 + kk) * 2048 + hp * 128 + 4 * d4); }
        for (int i = tid; i < 128 * 32; i += 512) { const int j = i >> 5, d4 = i & 31; *(LAS f32x4*)(sks + j * 132 + 4 * d4) = *(const f32x4*)(sk + (size_t)(hp * 128 + j) * 128 + 4 * d4); }
        __syncthreads();
        const int j = tid & 127, kq = tid >> 7;
        float acc[16];
#pragma unroll
        for (int i = 0; i < 16; ++i) acc[i] = 0.f;
        for (int d4 = 0; d4 < 32; ++d4) { const f32x4 sv = *(LAS f32x4*)(sks + j * 132 + 4 * d4);
#pragma unroll
            for (int i = 0; i < 16; ++i) { const f32x4 wv = *(LAS f32x4*)(wqs + (kq * 16 + i) * 128 + 4 * d4); acc[i] += sv[0] * wv[0] + sv[1] * wv[1] + sv[2] * wv[2] + sv[3] * wv[3]; } }
        v4u o0, o1; o0.x = pk2(acc[0], acc[1]); o0.y = pk2(acc[2], acc[3]); o0.z = pk2(acc[4], acc[5]); o0.w = pk2(acc[6], acc[7]);
        o1.x = pk2(acc[8], acc[9]); o1.y = pk2(acc[10], acc[11]); o1.z = pk2(acc[12], acc[13]); o1.w = pk2(acc[14], acc[15]);
        bf16* dst = WC + (size_t)(hp * 128 + j) * 1024 + k0 + kq * 16;
        *(v4u*)dst = o0; *(v4u*)(dst + 8) = o1;
    }
}

__device__ __forceinline__ void p1_norm(const Args& A, LAS unsigned char* lds, int tid, int wave, int lane, int wg0) {
    LAS float* wdt = (LAS float*)lds;
    const float* win = A.in[I_WIN];
    for (int i = tid; i < 16384; i += 512) { const int k = i >> 4, c = i & 15; wdt[c * 1024 + k] = win[(size_t)k * IN_COLS + DT_COL0 + c]; }
    __syncthreads();
    const float* x = A.in[I_X]; const float* ctx = A.in[I_CTX]; const float* n1w = A.in[I_N1W]; const float* dtb = A.in[I_DTB];
    float* MODV = (float*)(A.ws + WS_MODV); bf16* XN = (bf16*)(A.ws + WS_XN); float* DT = (float*)(A.ws + WS_DT);
    const int gw = ((int)blockIdx.x - wg0) * 8 + wave, NGW = ((int)gridDim.x - wg0) * 8;
    f32x4 nx[4];
    if (gw < MROWS) { const float* xr = gw < T ? x + (size_t)gw * 1024 : ctx + (size_t)(gw - T) * 1024;
#pragma unroll
        for (int j = 0; j < 4; ++j) nx[j] = *(const f32x4*)(xr + 4 * lane + 256 * j); }
    const int myc = 8 * ((lane >> 5) & 1) + 4 * ((lane >> 4) & 1) + 2 * ((lane >> 3) & 1) + (lane & 1);
    const float mybias = dtb[myc];
    for (int row = gw; row < MROWS; row += NGW) {
        const float* mp = MODV + (size_t)(row < T ? (row >> 12) : 8) * 6144;
        f32x4 v[4]; float ss = 0.f;
#pragma unroll
        for (int j = 0; j < 4; ++j) { v[j] = nx[j]; ss += v[j][0] * v[j][0] + v[j][1] * v[j][1] + v[j][2] * v[j][2] + v[j][3] * v[j][3]; }
        { const int rn = row + NGW < MROWS ? row + NGW : row;
          const float* xr = rn < T ? x + (size_t)rn * 1024 : ctx + (size_t)(rn - T) * 1024;
#pragma unroll
          for (int j = 0; j < 4; ++j) nx[j] = *(const f32x4*)(xr + 4 * lane + 256 * j); }
        const float rstd = rsqrtf(wave_sum(ss) * (1.f / 1024.f) + EPS);
#pragma unroll
        for (int j = 0; j < 4; ++j) { const int col = 4 * lane + 256 * j;
            const f32x4 nw = *(const f32x4*)(n1w + col), sh = *(const f32x4*)(mp + col), sc = *(const f32x4*)(mp + 1024 + col);
            v[j] = v[j] * rstd * nw * (sc + 1.f) + sh;
            v2u o; o.x = pk2(v[j][0], v[j][1]); o.y = pk2(v[j][2], v[j][3]); *(v2u*)(XN + (size_t)row * 1024 + col) = o; }
        float p[16];
#pragma unroll
        for (int c = 0; c < 16; ++c) { float q = 0.f;
            if ((c & 3) == 0) asm volatile("" ::: "memory");
#pragma unroll
            for (int j = 0; j < 4; ++j) { const f32x4 w4 = *(LAS f32x4*)(wdt + c * 1024 + 4 * lane + 256 * j); q += v[j][0] * w4[0] + v[j][1] * w4[1] + v[j][2] * w4[2] + v[j][3] * w4[3]; }
            p[c] = q; }
        wave_tsum16(p, lane);
        if ((lane & 6) == 0) DT[(size_t)row * 16 + myc] = softplus_f(((lane & 1) ? p[1] : p[0]) + mybias);
    }
}
constexpr int LROW = 272;
constexpr int XT_OFF = 0, BM_OFF = 17408, BT_OFF = 52224, CM_OFF = 87040, SCAL_OFF = 121856;
__device__ __forceinline__ float bfe(const v4u& v, int i) { const unsigned w = v[i >> 1]; return (i & 1) ? bfhi(w) : bflo(w); }
__device__ __forceinline__ pg8::f32x4 mfma16(const v4u& a, const v4u& b, const pg8::f32x4& c) {
    return __builtin_amdgcn_mfma_f32_16x16x32_bf16(__builtin_bit_cast(bf16x8, a), __builtin_bit_cast(bf16x8, b), c, 0, 0, 0); }

__device__ __forceinline__ void ssd_stage_kind(const Args& A, LAS unsigned char* lds, int kind, int h, int g, size_t row0, int t0, int L, int tid) {
    if (kind == 0 && tid >= 256) return;
    const bf16* XBC = (const bf16*)(A.ws + WS_XBC);
    const int pair = kind == 0 ? (tid & 31) : (tid & 63), sg = kind == 0 ? (tid >> 5) : (tid >> 6);
    const int nl = 2 * pair;
    const int gch = (kind == 0 ? 64 * h : (kind == 1 ? 512 + 128 * g : 768 + 128 * g)) + nl;
    const float* scw = A.in[I_SCW] + gch; const float* scb = A.in[I_SCB] + gch;
    float w0[5], w1[5];
#pragma unroll
    for (int k = 0; k < 5; ++k) { w0[k] = scw[k * 1024]; w1[k] = scw[k * 1024 + 1]; }
    const float b0 = scb[0], b1 = scb[1];
    float lo[20], hi[20];
#pragma unroll
    for (int i = 0; i < 20; ++i) { const int tl = t0 + 16 * sg - 2 + i;
        const unsigned raw = (tl >= 0 && tl < L) ? *(const unsigned*)(XBC + (row0 + tl) * 1024 + gch) : 0u;
        lo[i] = bflo(raw); hi[i] = bfhi(raw); }
    float s0[16], s1[16];
#pragma unroll
    for (int o = 0; o < 16; ++o) { float a0 = b0, a1 = b1;
#pragma unroll
        for (int k = 0; k < 5; ++k) { a0 += w0[k] * lo[o + k]; a1 += w1[k] * hi[o + k]; }
        s0[o] = silu_f(a0); s1[o] = silu_f(a1); }
    if (kind != 2) {
        LAS unsigned char* base = lds + (kind == 0 ? XT_OFF : BT_OFF) + nl * LROW + 32 * sg;
        v4u a, bb, c2, d2;
        a.x = pk2(s0[0], s0[1]); a.y = pk2(s0[2], s0[3]); a.z = pk2(s0[4], s0[5]); a.w = pk2(s0[6], s0[7]);
        bb.x = pk2(s0[8], s0[9]); bb.y = pk2(s0[10], s0[11]); bb.z = pk2(s0[12], s0[13]); bb.w = pk2(s0[14], s0[15]);
        c2.x = pk2(s1[0], s1[1]); c2.y = pk2(s1[2], s1[3]); c2.z = pk2(s1[4], s1[5]); c2.w = pk2(s1[6], s1[7]);
        d2.x = pk2(s1[8], s1[9]); d2.y = pk2(s1[10], s1[11]); d2.z = pk2(s1[12], s1[13]); d2.w = pk2(s1[14], s1[15]);
        *(LAS v4u*)base = a; *(LAS v4u*)(base + 16) = bb; *(LAS v4u*)(base + LROW) = c2; *(LAS v4u*)(base + LROW + 16) = d2;
    }
    if (kind != 0) {
        LAS unsigned char* base = lds + (kind == 1 ? BM_OFF : CM_OFF) + (16 * sg) * LROW + nl * 2;
#pragma unroll
        for (int o = 0; o < 16; ++o) *(LAS unsigned*)(base + o * LROW) = pk2(s0[o], s1[o]);
    }
}

__device__ __forceinline__ void ssd_stage_x(const Args& A, LAS unsigned char* lds, int h, size_t row0, int t0, int L, int tid) {
    const bf16* XBC = (const bf16*)(A.ws + WS_XBC);
    const int pair = tid & 31, sg = tid >> 5, nl = 2 * pair, gch = 64 * h + nl;
    const float* scw = A.in[I_SCW] + gch; const float* scb = A.in[I_SCB] + gch;
    float w0[5], w1[5];
#pragma unroll
    for (int k = 0; k < 5; ++k) { w0[k] = scw[k * 1024]; w1[k] = scw[k * 1024 + 1]; }
    const float b0 = scb[0], b1 = scb[1];
    float lo[12], hi[12];
#pragma unroll
    for (int i = 0; i < 12; ++i) { const int tl = t0 + 8 * sg - 2 + i;
        const unsigned raw = (tl >= 0 && tl < L) ? *(const unsigned*)(XBC + (row0 + tl) * 1024 + gch) : 0u;
        lo[i] = bflo(raw); hi[i] = bfhi(raw); }
    float s0[8], s1[8];
#pragma unroll
    for (int o = 0; o < 8; ++o) { float a0 = b0, a1 = b1;
#pragma unroll
        for (int k = 0; k < 5; ++k) { a0 += w0[k] * lo[o + k]; a1 += w1[k] * hi[o + k]; }
        s0[o] = silu_f(a0); s1[o] = silu_f(a1); }
    LAS unsigned char* base = lds + XT_OFF + nl * LROW + 16 * sg;
    v4u a, c2;
    a.x = pk2(s0[0], s0[1]); a.y = pk2(s0[2], s0[3]); a.z = pk2(s0[4], s0[5]); a.w = pk2(s0[6], s0[7]);
    c2.x = pk2(s1[0], s1[1]); c2.y = pk2(s1[2], s1[3]); c2.z = pk2(s1[4], s1[5]); c2.w = pk2(s1[6], s1[7]);
    *(LAS v4u*)base = a; *(LAS v4u*)(base + LROW) = c2;
}

__device__ __forceinline__ void ssd_local_item(const Args& A, LAS unsigned char* lds, int item, int tid, int wave, int lane) {
    int b, cc, g;
    if (item < NB * 32 * 2) { b = item >> 6; cc = 2 + ((item >> 1) & 31); g = item & 1; }
    else { const int j = item - NB * 32 * 2; b = j >> 2; cc = (j >> 1) & 1; g = j & 1; }
    const bool is_ctx = cc < 2; const int L = is_ctx ? CTXL : SEQ, c = is_ctx ? cc : cc - 2;
    const size_t row0 = is_ctx ? (size_t)T + (size_t)b * CTXL : (size_t)b * SEQ; const int t0 = c * 128;
    float* DT = (float*)(A.ws + WS_DT);
    LAS float* csf = (LAS float*)(lds + SCAL_OFF); LAS float* csb = csf + 128; LAS float* dtf = csf + 256; LAS float* dtb = csf + 384;
    const int fr = lane & 15, fq = lane >> 4;
    __syncthreads();
    ssd_stage_kind(A, lds, 1, 0, g, row0, t0, L, tid);
    if (!is_ctx) ssd_stage_kind(A, lds, 2, 0, g, row0, t0, L, tid);
    __syncthreads();
    if (!is_ctx) {
        v4u cf[4];
#pragma unroll
        for (int ks = 0; ks < 4; ++ks) cf[ks] = *(const LAS v4u*)(lds + CM_OFF + (16 * wave + fr) * LROW + (32 * ks + 8 * fq) * 2);
        pg8::f32x4 acc[8];
#pragma unroll
        for (int j = 0; j < 8; ++j) { acc[j] = (pg8::f32x4){0.f, 0.f, 0.f, 0.f};
#pragma unroll
            for (int ks = 0; ks < 4; ++ks) { const v4u bfv = *(const LAS v4u*)(lds + BM_OFF + (16 * j + fr) * LROW + (32 * ks + 8 * fq) * 2); acc[j] = mfma16(bfv, cf[ks], acc[j]); } }
        __syncthreads();
#pragma unroll
        for (int j = 0; j < 8; ++j) { v2u w; w.x = pk2(acc[j][0], acc[j][1]); w.y = pk2(acc[j][2], acc[j][3]);
            *(LAS v2u*)(lds + BM_OFF + (16 * wave + fr) * LROW + (16 * j + 4 * fq) * 2) = w; }
        bf16* CC = (bf16*)(A.ws + WS_CCONV);
        for (int i = tid; i < 128 * 16; i += 512) { const int r = i >> 4, c8 = i & 15;
            *(v4u*)(CC + (row0 + t0 + r) * 256 + g * 128 + c8 * 8) = *(const LAS v4u*)(lds + CM_OFF + r * LROW + c8 * 16); }
    }
#pragma unroll 1
    for (int hl = 0; hl < 4; ++hl) {
        const int h = 4 * g + hl;
        __syncthreads();
        if (wave == 5) {
            const float Af = -__expf(A.in[I_ALOG][h]);
            const float* dtp = DT + (row0 + t0) * 16 + h;
            const float d0 = dtp[(2 * lane) * 16], d1 = dtp[(2 * lane + 1) * 16];
            const float a0 = d0 * Af, x = a0 + d1 * Af; float incl = x;
#pragma unroll
            for (int o = 1; o < 64; o <<= 1) { const float v = __shfl_up(incl, o); if (lane >= o) incl += v; }
            const float excl = incl - x;
            csf[2 * lane] = excl + a0; csf[2 * lane + 1] = incl; dtf[2 * lane] = d0; dtf[2 * lane + 1] = d1;
            if (lane == 63) ((float*)(A.ws + WS_DEC))[((size_t)(b * NCC + cc) * 8 + h) * 2 + 0] = __expf(incl);
            if (!is_ctx) { float* CS = (float*)(A.ws + WS_CS) + (((size_t)(b * 32 + c) * 8 + h) * 2 + 0) * 128; CS[2 * lane] = excl + a0; CS[2 * lane + 1] = incl; }
        } else if (wave == 6) {
            const float Ab = -__expf(A.in[I_ALOG][8 + h]);
            const float* dtp = DT + (row0 + t0) * 16 + 8 + h;
            const float d0 = dtp[(2 * lane) * 16], d1 = dtp[(2 * lane + 1) * 16];
            const float a1 = d1 * Ab, x = d0 * Ab + a1; float incl = x;
#pragma unroll
            for (int o = 1; o < 64; o <<= 1) { const float v = __shfl_down(incl, o); if (lane + o < 64) incl += v; }
            const float excl = incl - x;
            csb[2 * lane + 1] = excl + a1; csb[2 * lane] = incl; dtb[2 * lane] = d0; dtb[2 * lane + 1] = d1;
            if (lane == 0) ((float*)(A.ws + WS_DEC))[((size_t)(b * NCC + cc) * 8 + h) * 2 + 1] = __expf(incl);
            if (!is_ctx) { float* CS = (float*)(A.ws + WS_CS) + (((size_t)(b * 32 + c) * 8 + h) * 2 + 1) * 128; CS[2 * lane + 1] = excl + a1; CS[2 * lane] = incl; }
        }
        ssd_stage_x(A, lds, h, row0, t0, L, tid);
        __syncthreads();
        if (!is_ctx) {
            const float Dh = A.in[I_SSD][h]; const int l = 16 * wave + fr; const float csfl = csf[l], csbl = csb[l];
            pg8::f32x4 yacc[4];
#pragma unroll
            for (int j = 0; j < 4; ++j) yacc[j] = (pg8::f32x4){0.f, 0.f, 0.f, 0.f};
#pragma unroll 2
            for (int ks = 0; ks < 4; ++ks) { const int s0 = 32 * ks + 8 * fq;
                const v4u g4 = *(const LAS v4u*)(lds + BM_OFF + l * LROW + s0 * 2);
                const f32x4 cfa = *(const LAS f32x4*)(csf + s0), cfb = *(const LAS f32x4*)(csf + s0 + 4), cba = *(const LAS f32x4*)(csb + s0), cbb = *(const LAS f32x4*)(csb + s0 + 4);
                const f32x4 dfa = *(const LAS f32x4*)(dtf + s0), dfb = *(const LAS f32x4*)(dtf + s0 + 4), dba = *(const LAS f32x4*)(dtb + s0), dbb = *(const LAS f32x4*)(dtb + s0 + 4);
                float m[8];
#pragma unroll
                for (int i = 0; i < 8; ++i) { const int s = s0 + i;
                    const float cfs = i < 4 ? cfa[i & 3] : cfb[i & 3], cbs = i < 4 ? cba[i & 3] : cbb[i & 3], dfs = i < 4 ? dfa[i & 3] : dfb[i & 3], dbs = i < 4 ? dba[i & 3] : dbb[i & 3];
                    const float arg = (s < l) ? csfl - cfs : csbl - cbs; const float dtv = (s < l) ? dfs : dbs;
                    float w = __expf(arg) * dtv; w = (s == l) ? dfs + dbs : w;
                    m[i] = bfe(g4, i) * w + ((s == l) ? Dh : 0.f); }
                v4u mf; mf.x = pk2(m[0], m[1]); mf.y = pk2(m[2], m[3]); mf.z = pk2(m[4], m[5]); mf.w = pk2(m[6], m[7]);
#pragma unroll
                for (int j = 0; j < 4; ++j) { const v4u af = *(const LAS v4u*)(lds + XT_OFF + (16 * j + fr) * LROW + s0 * 2); yacc[j] = mfma16(af, mf, yacc[j]); } }
            LAS unsigned char* st = lds + CM_OFF + wave * 4352;
#pragma unroll
            for (int j = 0; j < 4; ++j) { v2u w; w.x = pk2(yacc[j][0], yacc[j][1]); w.y = pk2(yacc[j][2], yacc[j][3]); *(LAS v2u*)(st + fr * 144 + (16 * j + 4 * fq) * 2) = w; }
            bf16* YD = (bf16*)(A.ws + WS_YD) + (row0 + t0 + 16 * wave) * 512 + 64 * h;
#pragma unroll
            for (int q = 0; q < 2; ++q) { const int r = 8 * q + (lane >> 3), ch = lane & 7; *(v4u*)(YD + (size_t)r * 512 + ch * 8) = *(const LAS v4u*)(st + r * 144 + ch * 16); }
        }
        {
            const int dir = wave >> 2, p = 16 * (wave & 3) + fr; LAS float* cs = dir ? csb : csf; LAS float* dtv = dir ? dtb : dtf;
            const float cend = dir ? csb[0] : csf[127];
            pg8::f32x4 sacc[8];
#pragma unroll
            for (int j = 0; j < 8; ++j) sacc[j] = (pg8::f32x4){0.f, 0.f, 0.f, 0.f};
#pragma unroll 2
            for (int ks = 0; ks < 4; ++ks) { const int s0 = 32 * ks + 8 * fq;
                const v4u x4 = *(const LAS v4u*)(lds + XT_OFF + p * LROW + s0 * 2);
                const f32x4 ca = *(const LAS f32x4*)(cs + s0), cb = *(const LAS f32x4*)(cs + s0 + 4), da = *(const LAS f32x4*)(dtv + s0), db = *(const LAS f32x4*)(dtv + s0 + 4);
                float m[8];
#pragma unroll
                for (int i = 0; i < 8; ++i) m[i] = bfe(x4, i) * (__expf(cend - (i < 4 ? ca[i & 3] : cb[i & 3])) * (i < 4 ? da[i & 3] : db[i & 3]));
                v4u xf; xf.x = pk2(m[0], m[1]); xf.y = pk2(m[2], m[3]); xf.z = pk2(m[4], m[5]); xf.w = pk2(m[6], m[7]);
#pragma unroll
                for (int j = 0; j < 8; ++j) { const v4u af = *(const LAS v4u*)(lds + BT_OFF + (16 * j + fr) * LROW + s0 * 2); sacc[j] = mfma16(af, xf, sacc[j]); } }
            LAS unsigned char* st = lds + CM_OFF + wave * 4352;
#pragma unroll
            for (int j = 0; j < 8; ++j) { v2u w; w.x = pk2(sacc[j][0], sacc[j][1]); w.y = pk2(sacc[j][2], sacc[j][3]); *(LAS v2u*)(st + fr * 272 + (16 * j + 4 * fq) * 2) = w; }
            bf16* SL = (bf16*)(A.ws + WS_SLOC) + ((((size_t)(b * NCC + cc) * 8 + h) * 2 + dir) * 64 + 16 * (wave & 3)) * 128;
#pragma unroll
            for (int q = 0; q < 4; ++q) { const int r = 4 * q + (lane >> 4), ch = lane & 15; *(v4u*)(SL + (size_t)r * 128 + ch * 8) = *(const LAS v4u*)(st + r * 272 + ch * 16); }
        }
    }
}

__device__ __forceinline__ void cfm_conv_item(const Args& A, int item, int tid) {
    const int line = item & 63, dir = (item >> 6) & 1, b = item >> 7;
    const int seg = tid >> 7, cp = tid & 127, ch = 256 * dir + 2 * cp;
    const bf16* UG = (const bf16*)(A.ws + WS_UGLU) + (size_t)b * SEQ * 512 + ch;
    const int tstride = dir ? 64 : 1, tbase = dir ? line : line * 64;
    unsigned raw[46];
#pragma unroll
    for (int ii = 0; ii < 46; ++ii) { const int pos = 16 * seg - 15 + ii;
        raw[ii] = (pos >= 0 && pos < 64) ? *(const unsigned*)(UG + (size_t)(tbase + pos * tstride) * 512) : 0u; }
    const float* ccw = A.in[I_CCW] + ch; const float* ccb = A.in[I_CCB] + ch;
    float w0[31], w1[31];
#pragma unroll
    for (int k = 0; k < 31; ++k) { w0[k] = ccw[k * 512]; w1[k] = ccw[k * 512 + 1]; }
    float a0[16], a1[16];
#pragma unroll
    for (int o = 0; o < 16; ++o) { a0[o] = ccb[0]; a1[o] = ccb[1]; }
#pragma unroll
    for (int ii = 0; ii < 46; ++ii) { const float lo = bflo(raw[ii]), hi = bfhi(raw[ii]);
#pragma unroll
        for (int o = 0; o < 16; ++o) { const int k = ii - o; if (k >= 0 && k <= 30) { a0[o] += w0[k] * lo; a1[o] += w1[k] * hi; } } }
    bf16* CO = (bf16*)(A.ws + WS_CONVO) + (size_t)b * SEQ * 512 + ch;
#pragma unroll
    for (int o = 0; o < 16; ++o) *(unsigned*)(CO + (size_t)(tbase + (16 * seg + o) * tstride) * 512) = pk2(a0[o], a1[o]);
}

__device__ __forceinline__ void p4_recur(const Args& A, int tid) {
    bf16* SLOC = (bf16*)(A.ws + WS_SLOC); float* DEC = (float*)(A.ws + WS_DEC);
    const int nthr = gridDim.x * 512;
    for (int idx = blockIdx.x * 512 + tid; idx < NB * 8 * 2 * 64 * 32; idx += nthr) {
        const int n4 = idx & 31, p = (idx >> 5) & 63, dir = (idx >> 11) & 1, h = (idx >> 12) & 7, b = idx >> 15;
        float S0 = 0.f, S1 = 0.f, S2 = 0.f, S3 = 0.f;
#pragma unroll 1
        for (int half = 0; half < 2; ++half) {
            v2u loc[17]; float dec[17];
#pragma unroll
            for (int s = 0; s < 17; ++s) { const int step = 17 * half + s;
                const int cc = dir == 0 ? step : (step < 2 ? 1 - step : 35 - step);
                const size_t slot = ((size_t)(b * NCC + cc) * 8 + h) * 2 + dir;
                loc[s] = *(const v2u*)(SLOC + slot * 8192 + p * 128 + 4 * n4); dec[s] = DEC[slot]; }
#pragma unroll
            for (int s = 0; s < 17; ++s) { const int step = 17 * half + s;
                const int cc = dir == 0 ? step : (step < 2 ? 1 - step : 35 - step);
                const size_t slot = ((size_t)(b * NCC + cc) * 8 + h) * 2 + dir;
                if (cc >= 2) { v2u o; o.x = pk2(S0, S1); o.y = pk2(S2, S3); *(v2u*)(SLOC + slot * 8192 + p * 128 + 4 * n4) = o; }
                S0 = dec[s] * S0 + bflo(loc[s].x); S1 = dec[s] * S1 + bfhi(loc[s].x); S2 = dec[s] * S2 + bflo(loc[s].y); S3 = dec[s] * S3 + bfhi(loc[s].y); }
        }
    }
}
__device__ __forceinline__ void ssd_out_item(const Args& A, LAS unsigned char* lds, int item, int tid, int wave, int lane) {
    const int g = item & 1, c = (item >> 1) & 31, b = item >> 6;
    LAS float* ECS = (LAS float*)(lds + 34816);
    LAS float* RED = (LAS float*)(lds + 38912);
    const size_t row0 = (size_t)b * SEQ + c * 128;
    const int fr = lane & 15, fq = lane >> 4;
    __syncthreads();
    { const bf16* CC = (const bf16*)(A.ws + WS_CCONV);
      for (int i = tid; i < 128 * 16; i += 512) { const int r = i >> 4, c8 = i & 15;
          *(LAS v4u*)(lds + r * LROW + c8 * 16) = *(const v4u*)(CC + (row0 + r) * 256 + g * 128 + c8 * 8); }
      const float* CS = (const float*)(A.ws + WS_CS) + ((size_t)(b * 32 + c) * 8 + 4 * g) * 256;
      for (int i = tid; i < 1024; i += 512) ECS[i] = __expf(CS[i]); }
    __syncthreads();
    const int hl = wave >> 1, ph = wave & 1, h = 4 * g + hl;
    v4u sf[2][2][4];
#pragma unroll
    for (int dir = 0; dir < 2; ++dir) { const bf16* SL = (const bf16*)(A.ws + WS_SLOC) + (((size_t)(b * NCC + c + 2) * 8 + h) * 2 + dir) * 8192;
#pragma unroll
        for (int jt = 0; jt < 2; ++jt)
#pragma unroll
            for (int ks = 0; ks < 4; ++ks) sf[dir][jt][ks] = *(const v4u*)(SL + (32 * ph + 16 * jt + fr) * 128 + 32 * ks + 8 * fq); }
    const bf16* YD = (const bf16*)(A.ws + WS_YD); const bf16* ZS = (const bf16*)(A.ws + WS_ZS);
    const int chb = 256 * g + 64 * hl + 32 * ph + 4 * fq;
    const float* snw = A.in[I_SNW]; bf16* A2 = (bf16*)(A.ws + WS_XN);
    f32x4 nw[2];
#pragma unroll
    for (int jt = 0; jt < 2; ++jt) nw[jt] = *(const f32x4*)(snw + chb + 16 * jt);
#pragma unroll 1
    for (int half = 0; half < 2; ++half) {
        float gv[4][2][4]; float ssq[4];
#pragma unroll
        for (int l4 = 0; l4 < 4; ++l4) { const int lt = 4 * half + l4;
            v4u cfr[4];
#pragma unroll
            for (int ks = 0; ks < 4; ++ks) cfr[ks] = *(const LAS v4u*)(lds + (16 * lt + fr) * LROW + (32 * ks + 8 * fq) * 2);
            pg8::f32x4 af[2], ab[2];
#pragma unroll
            for (int jt = 0; jt < 2; ++jt) { af[jt] = (pg8::f32x4){0.f, 0.f, 0.f, 0.f}; ab[jt] = (pg8::f32x4){0.f, 0.f, 0.f, 0.f};
#pragma unroll
                for (int ks = 0; ks < 4; ++ks) { af[jt] = mfma16(sf[0][jt][ks], cfr[ks], af[jt]); ab[jt] = mfma16(sf[1][jt][ks], cfr[ks], ab[jt]); } }
            const int l = 16 * lt + fr; const float ef = ECS[(hl * 2 + 0) * 128 + l], eb = ECS[(hl * 2 + 1) * 128 + l];
            float sq = 0.f;
#pragma unroll
            for (int jt = 0; jt < 2; ++jt) { const size_t o = (row0 + l) * 512 + chb + 16 * jt;
                const v2u yd = *(const v2u*)(YD + o), zs = *(const v2u*)(ZS + o);
                const float y0 = ef * af[jt][0] + eb * ab[jt][0] + bflo(yd.x), y1 = ef * af[jt][1] + eb * ab[jt][1] + bfhi(yd.x);
                const float y2 = ef * af[jt][2] + eb * ab[jt][2] + bflo(yd.y), y3 = ef * af[jt][3] + eb * ab[jt][3] + bfhi(yd.y);
                gv[l4][jt][0] = y0 * bflo(zs.x); gv[l4][jt][1] = y1 * bfhi(zs.x); gv[l4][jt][2] = y2 * bflo(zs.y); gv[l4][jt][3] = y3 * bfhi(zs.y);
#pragma unroll
                for (int r = 0; r < 4; ++r) sq += gv[l4][jt][r] * gv[l4][jt][r]; }
            sq += __shfl_xor(sq, 16); sq += __shfl_xor(sq, 32); ssq[l4] = sq;
        }
        __syncthreads();
        if (fq == 0) {
#pragma unroll
            for (int l4 = 0; l4 < 4; ++l4) RED[wave * 64 + 16 * l4 + fr] = ssq[l4]; }
        __syncthreads();
#pragma unroll
        for (int l4 = 0; l4 < 4; ++l4) { const int l = 16 * (4 * half + l4) + fr; float tot = 0.f;
#pragma unroll
            for (int w = 0; w < 8; ++w) tot += RED[w * 64 + 16 * l4 + fr];
            const float rstd = rsqrtf(tot * (1.f / 256.f) + EPS);
#pragma unroll
            for (int jt = 0; jt < 2; ++jt) { v2u o; o.x = pk2(gv[l4][jt][0] * rstd * nw[jt][0], gv[l4][jt][1] * rstd * nw[jt][1]); o.y = pk2(gv[l4][jt][2] * rstd * nw[jt][2], gv[l4][jt][3] * rstd * nw[jt][3]);
                *(v2u*)(A2 + (row0 + l) * 1024 + chb + 16 * jt) = o; } }
    }
}
__device__ __forceinline__ void cfm_ln_rows(const Args& A, int wave, int lane) {
    const bf16* CO = (const bf16*)(A.ws + WS_CONVO); bf16* A2 = (bf16*)(A.ws + WS_XN);
    const float* clw = A.in[I_CLW] + 8 * lane; const float* clb = A.in[I_CLB] + 8 * lane;
    const f32x4 w0 = *(const f32x4*)clw, w1 = *(const f32x4*)(clw + 4), b0 = *(const f32x4*)clb, b1 = *(const f32x4*)(clb + 4);
    const int gw = blockIdx.x * 8 + wave, NGW = gridDim.x * 8;
    for (int t = gw; t < T; t += NGW) {
        const v4u raw = *(const v4u*)(CO + (size_t)t * 512 + 8 * lane);
        float v[8]; float s = 0.f;
#pragma unroll
        for (int i = 0; i < 8; ++i) { v[i] = bfe(raw, i); s += v[i]; }
        const float mean = wave_sum(s) * (1.f / 512.f); float s2 = 0.f;
#pragma unroll
        for (int i = 0; i < 8; ++i) { v[i] -= mean; s2 += v[i] * v[i]; }
        const float rstd = rsqrtf(wave_sum(s2) * (1.f / 512.f) + EPS);
        float o[8];
#pragma unroll
        for (int i = 0; i < 8; ++i) o[i] = silu_f(v[i] * rstd * (i < 4 ? w0[i & 3] : w1[i & 3]) + (i < 4 ? b0[i & 3] : b1[i & 3]));
        v4u q; q.x = pk2(o[0], o[1]); q.y = pk2(o[2], o[3]); q.z = pk2(o[4], o[5]); q.w = pk2(o[6], o[7]);
        *(v4u*)(A2 + (size_t)t * 1024 + 512 + 8 * lane) = q;
    }
}

__device__ __forceinline__ void p7_norm2(const Args& A, int wave, int lane) {
    const bf16* X1 = (const bf16*)(A.ws + WS_X1B); const float* n2w = A.in[I_N2W]; float* MODV = (float*)(A.ws + WS_MODV); bf16* XN = (bf16*)(A.ws + WS_XN);
    const int gw = blockIdx.x * 8 + wave, NGW = gridDim.x * 8;
    v4u nx[2];
    if (gw < T) { nx[0] = *(const v4u*)(X1 + x1b_off(gw, 8 * lane)); nx[1] = *(const v4u*)(X1 + x1b_off(gw, 512 + 8 * lane)); }
    for (int row = gw; row < T; row += NGW) {
        const float* mp = MODV + (size_t)(row >> 12) * 6144;
        float v[16]; float ss = 0.f;
#pragma unroll
        for (int j = 0; j < 4; ++j) { v[2 * j] = bflo(nx[0][j]); v[2 * j + 1] = bfhi(nx[0][j]); v[8 + 2 * j] = bflo(nx[1][j]); v[8 + 2 * j + 1] = bfhi(nx[1][j]); }
#pragma unroll
        for (int i = 0; i < 16; ++i) ss += v[i] * v[i];
        { const int rn = row + NGW < T ? row + NGW : row;
          nx[0] = *(const v4u*)(X1 + x1b_off(rn, 8 * lane)); nx[1] = *(const v4u*)(X1 + x1b_off(rn, 512 + 8 * lane)); }
        const float rstd = rsqrtf(wave_sum(ss) * (1.f / 1024.f) + EPS);
#pragma unroll
        for (int hf = 0; hf < 2; ++hf) { const int col = 512 * hf + 8 * lane; float hv[8];
#pragma unroll
            for (int q = 0; q < 2; ++q) { const f32x4 nw = *(const f32x4*)(n2w + col + 4 * q), sh = *(const f32x4*)(mp + 3 * 1024 + col + 4 * q), sc = *(const f32x4*)(mp + 4 * 1024 + col + 4 * q);
#pragma unroll
                for (int i = 0; i < 4; ++i) hv[4 * q + i] = v[8 * hf + 4 * q + i] * rstd * nw[i] * (sc[i] + 1.f) + sh[i]; }
            v4u o; o.x = pk2(hv[0], hv[1]); o.y = pk2(hv[2], hv[3]); o.z = pk2(hv[4], hv[5]); o.w = pk2(hv[6], hv[7]);
            *(v4u*)(XN + (size_t)row * 1024 + col) = o; }
    }
}
constexpr int PEER_RV = PEER_FP8 ? 1 : 2;
__device__ __forceinline__ unsigned fkey(float s) { const unsigned u = __builtin_bit_cast(unsigned, s); return (u & 0x80000000u) ? ~u : (u | 0x80000000u); }
__device__ __forceinline__ float fkey_inv(unsigned k) { const unsigned u = (k & 0x80000000u) ? (k & 0x7fffffffu) : ~k; return __builtin_bit_cast(float, u); }
__device__ __forceinline__ unsigned umax_(unsigned a, unsigned b) { return a > b ? a : b; }
template <int CTRL> __device__ __forceinline__ unsigned dppu(unsigned x) { return (unsigned)__builtin_amdgcn_mov_dpp((int)x, CTRL, 0xf, 0xf, true); }
__device__ __forceinline__ unsigned allmax16(unsigned m) { m = umax_(m, dppu<0xB1>(m)); m = umax_(m, dppu<0x4E>(m)); m = umax_(m, dppu<0x141>(m)); m = umax_(m, dppu<0x140>(m)); return m; }
__device__ __forceinline__ unsigned allmax32(unsigned m) { m = allmax16(m); auto s = __builtin_amdgcn_permlane16_swap(m, m, false, false); const unsigned s0 = s[0], s1 = s[1]; return umax_(s0, s1); }
__device__ __forceinline__ unsigned allmax64(unsigned m) { m = allmax32(m); auto s = __builtin_amdgcn_permlane32_swap(m, m, false, false); const unsigned s0 = s[0], s1 = s[1]; return umax_(s0, s1); }
__device__ __forceinline__ float allmaxf16(float m) { m = fmaxf(m, dppf<0xB1>(m)); m = fmaxf(m, dppf<0x4E>(m)); m = fmaxf(m, dppf<0x141>(m)); m = fmaxf(m, dppf<0x140>(m)); return m; }
__device__ __forceinline__ float dot2bf(unsigned a, unsigned b, float acc) { return __builtin_amdgcn_fdot2_f32_bf16(__builtin_bit_cast(bf16x2_t, a), __builtin_bit_cast(bf16x2_t, b), acc, false); }

struct PeerRow { v4u r[PEER_RV]; };
__device__ __forceinline__ PeerRow peer_load(const unsigned char* tab, unsigned e, int lane) {
    PeerRow o; const unsigned char* p = tab + (size_t)e * (PEER_FP8 ? 1024 : 2048) + 16 * lane;
    o.r[0] = *(const v4u*)p;
    if (!PEER_FP8) o.r[PEER_RV - 1] = *(const v4u*)(p + 1024);
    return o;
}
__device__ __forceinline__ float peer_dot(const PeerRow& w, const unsigned (&xp)[8], const float (&xf)[16]) {
    if (PEER_FP8) {
        f32x2 a0 = {0.f, 0.f}, a1 = {0.f, 0.f};
#pragma unroll
        for (int j = 0; j < 4; ++j) { const f32x2 lo = __builtin_amdgcn_cvt_pk_f32_fp8((int)w.r[0][j], false), hi = __builtin_amdgcn_cvt_pk_f32_fp8((int)w.r[0][j], true);
            a0 += lo * (f32x2){xf[4 * j], xf[4 * j + 1]}; a1 += hi * (f32x2){xf[4 * j + 2], xf[4 * j + 3]}; }
        return (a0.x + a0.y) + (a1.x + a1.y);
    } else {
        float s0 = 0.f, s1 = 0.f;
#pragma unroll
        for (int j = 0; j < 4; ++j) { s0 = dot2bf(w.r[0][j], xp[j], s0); s1 = dot2bf(w.r[PEER_RV - 1][j], xp[4 + j], s1); }
        return s0 + s1;
    }
}
__device__ __forceinline__ void peer_axpy(const PeerRow& w, float c, f32x2 (&acc)[8]) {
    const f32x2 cc = {c, c};
    if (PEER_FP8) {
#pragma unroll
        for (int j = 0; j < 4; ++j) { acc[2 * j] += cc * __builtin_amdgcn_cvt_pk_f32_fp8((int)w.r[0][j], false); acc[2 * j + 1] += cc * __builtin_amdgcn_cvt_pk_f32_fp8((int)w.r[0][j], true); }
    } else {
#pragma unroll
        for (int j = 0; j < 4; ++j) { acc[j] += cc * (f32x2){bflo(w.r[0][j]), bfhi(w.r[0][j])}; acc[4 + j] += cc * (f32x2){bflo(w.r[PEER_RV - 1][j]), bfhi(w.r[PEER_RV - 1][j])}; }
    }
}

__device__ __forceinline__ unsigned umin_(unsigned a, unsigned b) { return a < b ? a : b; }
template <int N> __device__ __forceinline__ void bitonic_sort_desc(unsigned (&a)[N]) {
#pragma unroll
    for (int k = 2; k <= N; k <<= 1)
#pragma unroll
        for (int j = k >> 1; j > 0; j >>= 1)
#pragma unroll
            for (int i = 0; i < N; ++i) { const int l = i ^ j; if (l > i) { const unsigned mx = umax_(a[i], a[l]), mn = umin_(a[i], a[l]); const bool up = (i & k) == 0; a[i] = up ? mx : mn; a[l] = up ? mn : mx; } }
}
template <int N> __device__ __forceinline__ void bitonic_merge_desc(unsigned (&a)[N]) {
#pragma unroll
    for (int j = N >> 1; j > 0; j >>= 1)
#pragma unroll
        for (int i = 0; i < N; ++i) { const int l = i ^ j; if (l > i) { const unsigned mx = umax_(a[i], a[l]), mn = umin_(a[i], a[l]); a[i] = mx; a[l] = mn; } }
}
__device__ __forceinline__ void top16_merge(unsigned (&t)[16], const unsigned (&g)[16]) {
#pragma unroll
    for (int i = 0; i < 16; ++i) t[i] = umax_(t[i], g[15 - i]);
    bitonic_merge_desc<16>(t);
}
__device__ __forceinline__ void top16_of_128(const _Float16* col  , unsigned (&t)[16]) {
    _Float16 nx[16];
#pragma unroll
    for (int i = 0; i < 16; ++i) nx[i] = col[i * 32];
#pragma unroll 1
    for (int g = 0; g < 8; ++g) { unsigned q[16];
#pragma unroll
        for (int i = 0; i < 16; ++i) q[i] = (fkey((float)nx[i]) & ~127u) | (unsigned)(127 - 16 * g - i);
        { const int gn = g < 7 ? g + 1 : 7;
#pragma unroll
          for (int i = 0; i < 16; ++i) nx[i] = col[(size_t)gn * (T / 32) * 512 + i * 32]; }
        bitonic_sort_desc<16>(q);
        if (g == 0) {
#pragma unroll
            for (int i = 0; i < 16; ++i) t[i] = q[i];
        } else top16_merge(t, q); }
}
__host__ __device__ constexpr int stair_r1(int idx) {
    const int th[15] = {16, 24, 29, 33, 36, 38, 40, 42, 43, 44, 45, 46, 47, 48, 49}; int r = 0; for (int i = 0; i < 15; ++i) r += (idx >= th[i]) ? 1 : 0; return r; }
__host__ __device__ constexpr int stair_r2(int idx) {
    const int st[16] = {0, 16, 24, 29, 33, 36, 38, 40, 42, 43, 44, 45, 46, 47, 48, 49}; return idx - st[stair_r1(idx)]; }
__device__ __forceinline__ void p9_select_init(LAS unsigned char* lds, int tid) {
    LAS unsigned* TAB = (LAS unsigned*)(lds + 65536);
    if (tid < 64) { const int idx = tid < 50 ? tid : 49; int r1 = 0; const int th[15] = {16, 24, 29, 33, 36, 38, 40, 42, 43, 44, 45, 46, 47, 48, 49};
#pragma unroll
        for (int i = 0; i < 15; ++i) r1 += (idx >= th[i]) ? 1 : 0;
        const int st[16] = {0, 16, 24, 29, 33, 36, 38, 40, 42, 43, 44, 45, 46, 47, 48, 49}; int s0 = 0;
#pragma unroll
        for (int i = 0; i < 16; ++i) s0 = (r1 == i) ? st[i] : s0;
        TAB[tid] = (unsigned)r1 | ((unsigned)(idx - s0) << 8); }
}
__device__ __forceinline__ void p9_select_one(const Args& A, LAS unsigned char* lds, int tid, int token, int h) {
    const _Float16* SCT = (const _Float16*)(A.ws + WS_SC); unsigned* EIDX = (unsigned*)(A.ws + WS_EIDX); float* GATE = (float*)(A.ws + WS_GATE);
    LAS unsigned* KL = (LAS unsigned*)lds;
    LAS unsigned* TAB = (LAS unsigned*)(lds + 65536);
    {
        unsigned k1[16], k2[16];
        top16_of_128(SCT + ((size_t)(2 * h) * 8 * (T / 32) + (token >> 5)) * 512 + (token & 31), k1);
        top16_of_128(SCT + ((size_t)(2 * h + 1) * 8 * (T / 32) + (token >> 5)) * 512 + (token & 31), k2);
        float v1[16], v2[16];
#pragma unroll
        for (int i = 0; i < 16; ++i) { KL[i * 512 + tid] = k1[i]; KL[(16 + i) * 512 + tid] = k2[i]; v1[i] = fkey_inv(k1[i] & ~127u); v2[i] = fkey_inv(k2[i] & ~127u); }
        unsigned c[16], q[16];
#pragma unroll
        for (int i = 0; i < 16; ++i) c[i] = (fkey(v1[stair_r1(i)] + v2[stair_r2(i)]) & ~63u) | (unsigned)(63 - i);
        bitonic_sort_desc<16>(c);
#pragma unroll
        for (int i = 0; i < 16; ++i) q[i] = (fkey(v1[stair_r1(16 + i)] + v2[stair_r2(16 + i)]) & ~63u) | (unsigned)(63 - 16 - i);
        bitonic_sort_desc<16>(q); top16_merge(c, q);
#pragma unroll
        for (int i = 0; i < 16; ++i) q[i] = (fkey(v1[stair_r1(32 + i)] + v2[stair_r2(32 + i)]) & ~63u) | (unsigned)(63 - 32 - i);
        bitonic_sort_desc<16>(q); top16_merge(c, q);
#pragma unroll
        for (int i = 0; i < 16; ++i) q[i] = (i < 2) ? ((fkey(v1[stair_r1(48 + (i < 2 ? i : 0))] + v2[stair_r2(48 + (i < 2 ? i : 0))]) & ~63u) | (unsigned)(63 - 48 - i)) : 0u;
        bitonic_sort_desc<16>(q); top16_merge(c, q);
        unsigned eid[16]; float ex[16]; const float mx = fkey_inv(c[0] & ~63u); float sm = 0.f;
#pragma unroll
        for (int i = 0; i < 16; ++i) { const unsigned rr = TAB[63 - (c[i] & 63u)];
            const unsigned ka = KL[(rr & 255u) * 512 + tid], kb = KL[(16 + (rr >> 8)) * 512 + tid];
            eid[i] = (127u - (ka & 127u)) * 128u + (127u - (kb & 127u));
            ex[i] = __expf(fkey_inv(c[i] & ~63u) - mx); sm += ex[i]; }
        const float inv = 1.f / sm;
        unsigned* ep = EIDX + (size_t)token * 128 + 16 * h; float* gp = GATE + (size_t)token * 128 + 16 * h; float* up = (float*)(A.ws + WS_USA) + (size_t)token * 128 + 16 * h;
        const float* USC = (const float*)(A.ws + WS_USC); const float* VSC = (const float*)(A.ws + WS_VSC);
        float us[16];
#pragma unroll
        for (int i = 0; i < 16; ++i) { us[i] = USC[eid[i]]; ex[i] = ex[i] * inv * VSC[eid[i]]; }
#pragma unroll
        for (int i = 0; i < 4; ++i) { *(v4u*)(ep + 4 * i) = (v4u){eid[4 * i], eid[4 * i + 1], eid[4 * i + 2], eid[4 * i + 3]};
            *(f32x4*)(gp + 4 * i) = (f32x4){ex[4 * i], ex[4 * i + 1], ex[4 * i + 2], ex[4 * i + 3]};
            *(f32x4*)(up + 4 * i) = (f32x4){us[4 * i], us[4 * i + 1], us[4 * i + 2], us[4 * i + 3]}; }
    }
}

#define PEER_LOAD8(buf, tab, ev, lb_) do { _Pragma("unroll") for (int i_ = 0; i_ < 8; ++i_) buf[i_] = peer_load(tab, (unsigned)__builtin_amdgcn_readlane((int)(ev), (lb_) + i_), lane); } while (0)
#define PEER_DOT8(buf, off_) do { _Pragma("unroll") for (int i_ = 0; i_ < 8; ++i_) p[(off_) + i_] = peer_dot(buf[i_], xp, xf); } while (0)
#define PEER_UFIN(hb_) do { wave_tsum16(p, lane); \
            const float d0 = __shfl(p[0], srcl), d1 = __shfl(p[1], srcl); \
            float dot = (i16 & 1) ? d1 : d0; \
            const unsigned eS_ = (hb_) < 4 ? eA : eB; const float gS = (hb_) < 4 ? gA : gB; \
            float wv; if (PEER_FP8) { dot *= USC[eS_]; wv = gS * gelu_f(dot) * VSC[eS_]; } else { wv = gS * gelu_f(dot); } \
            const bool mine = (lane >> 4) == ((hb_) & 3); \
            if ((hb_) < 4) wA = mine ? wv : wA; else wB = mine ? wv : wB; } while (0)
#define PEER_AXPY8(buf, wS_, lb_) do { _Pragma("unroll") for (int i_ = 0; i_ < 8; ++i_) peer_axpy(buf[i_], __builtin_bit_cast(float, __builtin_amdgcn_readlane(__builtin_bit_cast(int, (wS_)), (lb_) + i_)), acc); } while (0)
template <bool DUMMY> __device__ __forceinline__ void p9_peer(const Args& A, int wave, int lane, unsigned emask) {
    unsigned* EIDX = (unsigned*)(A.ws + WS_EIDX); float* GATE = (float*)(A.ws + WS_GATE); const bf16* XN = (const bf16*)(A.ws + WS_XN);
    const unsigned char* U = A.ws + WS_U; const unsigned char* V = A.ws + WS_V;
    const float* USC = (const float*)(A.ws + WS_USC); const float* VSC = (const float*)(A.ws + WS_VSC);
    float* MODV = (float*)(A.ws + WS_MODV); float* OUT = A.out; const float* fnw = A.in[I_FNW];
    const int i16 = lane & 15;
    const int srcl = 32 * ((i16 >> 3) & 1) + 16 * ((i16 >> 2) & 1) + 8 * ((i16 >> 1) & 1);
    const int gw = blockIdx.x * 8 + wave, NGW = gridDim.x * 8;
    PeerRow bufa[8], bufb[8];
    unsigned eA = 0, eB = 0; float gA = 0.f, gB = 0.f;
    if (gw < T) { eA = EIDX[(size_t)gw * 128 + lane] & emask; eB = EIDX[(size_t)gw * 128 + 64 + lane] & emask; gA = GATE[(size_t)gw * 128 + lane]; gB = GATE[(size_t)gw * 128 + 64 + lane];
        PEER_LOAD8(bufa, U, eA, 0); }
    for (int t = gw; t < T; t += NGW) {
        const int tn = (t + NGW < T) ? t + NGW : t;
        unsigned xp[8]; float xf[16];
        if (PEER_FP8) {
            const v4u a = *(const v4u*)(XN + (size_t)t * 1024 + 16 * lane), b2 = *(const v4u*)(XN + (size_t)t * 1024 + 16 * lane + 8);
#pragma unroll
            for (int j = 0; j < 4; ++j) { xf[2 * j] = bflo(a[j]); xf[2 * j + 1] = bfhi(a[j]); xf[8 + 2 * j] = bflo(b2[j]); xf[8 + 2 * j + 1] = bfhi(b2[j]); xp[j] = 0u; xp[4 + j] = 0u; }
        } else {
            const v4u a = *(const v4u*)(XN + (size_t)t * 1024 + 8 * lane), b2 = *(const v4u*)(XN + (size_t)t * 1024 + 512 + 8 * lane);
#pragma unroll
            for (int j = 0; j < 4; ++j) { xp[j] = a[j]; xp[4 + j] = b2[j]; }
#pragma unroll
            for (int j = 0; j < 16; ++j) xf[j] = 0.f;
        }
        float wA = 0.f, wB = 0.f;
#pragma unroll 1
        for (int hb = 0; hb < 8; ++hb) {
            const unsigned eS = hb < 4 ? eA : eB; const int lb = 16 * (hb & 3);
            float p[16];
            PEER_LOAD8(bufb, U, eS, lb + 8);
            PEER_DOT8(bufa, 0);
            if (hb < 7) { const unsigned eN = hb < 3 ? eA : eB; PEER_LOAD8(bufa, U, eN, 16 * ((hb + 1) & 3)); }
            else PEER_LOAD8(bufa, V, eA, 0);
            PEER_DOT8(bufb, 8);
            PEER_UFIN(hb);
        }
        const unsigned eAn = EIDX[(size_t)tn * 128 + lane] & emask;
        f32x2 acc[8];
#pragma unroll
        for (int i = 0; i < 8; ++i) acc[i] = (f32x2){0.f, 0.f};
#pragma unroll 1
        for (int hb = 0; hb < 8; ++hb) {
            const unsigned eS = hb < 4 ? eA : eB; const float wS = hb < 4 ? wA : wB; const int lb = 16 * (hb & 3);
            PEER_LOAD8(bufb, V, eS, lb + 8);
            PEER_AXPY8(bufa, wS, lb);
            if (hb < 7) { const unsigned eN = hb < 3 ? eA : eB; PEER_LOAD8(bufa, V, eN, 16 * ((hb + 1) & 3)); }
            else if (tn != t) PEER_LOAD8(bufa, U, eAn, 0);
            PEER_AXPY8(bufb, wS, lb + 8);
        }
        float* orow = OUT + (size_t)t * 1024; const float* g5 = MODV + (size_t)(t >> 12) * 6144 + 5 * 1024;
        float x2[16]; float ss = 0.f;
#pragma unroll
        for (int q = 0; q < 4; ++q) { const int col = PEER_FP8 ? 16 * lane + 4 * q : (q < 2 ? 8 * lane + 4 * q : 512 + 8 * lane + 4 * (q - 2));
            const f32x4 a = *(const f32x4*)(orow + col), ga = *(const f32x4*)(g5 + col);
            x2[4 * q] = a[0] + ga[0] * acc[2 * q].x; x2[4 * q + 1] = a[1] + ga[1] * acc[2 * q].y; x2[4 * q + 2] = a[2] + ga[2] * acc[2 * q + 1].x; x2[4 * q + 3] = a[3] + ga[3] * acc[2 * q + 1].y; }
#pragma unroll
        for (int i = 0; i < 16; ++i) ss += x2[i] * x2[i];
        const float rstd = rsqrtf(wave_sum(ss) * (1.f / 1024.f) + EPS);
#pragma unroll
        for (int q = 0; q < 4; ++q) { const int col = PEER_FP8 ? 16 * lane + 4 * q : (q < 2 ? 8 * lane + 4 * q : 512 + 8 * lane + 4 * (q - 2));
            const f32x4 wa = *(const f32x4*)(fnw + col); f32x4 oa;
#pragma unroll
            for (int k = 0; k < 4; ++k) oa[k] = x2[4 * q + k] * rstd * wa[k];
            if (!DUMMY || rstd == 123.456f) *(f32x4*)(orow + col) = oa; }
        eA = eAn; eB = EIDX[(size_t)tn * 128 + 64 + lane] & emask; gA = GATE[(size_t)tn * 128 + lane]; gB = GATE[(size_t)tn * 128 + 64 + lane];
    }
}
#if PEER_FP8
#ifndef GL_PROBE_SKIP
#define GL_PROBE_SKIP 0
#endif
#ifndef GL_HALF_PROBE
#define GL_HALF_PROBE 0
#endif
constexpr int GL_RSH = 11, GL_KB = 2;
constexpr int GL_TG = 4, GL_NE = 128 * GL_TG, GL_NBT = GL_NE / 8;
constexpr int GL_L = 0, GL_W = 4 * GL_NE, GL_CNT = 8 * GL_NE, GL_OFF = GL_CNT + 256, GL_US = GL_OFF + 256, GL_D = GL_US + 4 * GL_NE, GL_X = GL_D + 4 * GL_NE, GL_K = GL_X + 2048 * GL_TG, GL_WAVE_BYTES = GL_K + GL_NE;
constexpr int GL_ACC = GL_US;
static_assert(GL_K - GL_ACC >= 4096 * (GL_TG - 1), "parked accumulators fit");
static_assert(8 * GL_WAVE_BYTES <= LDSCTL_OFF && GL_NBT % 4 == 0, "gather LDS map");
template <bool CHEAP = false> __device__ __forceinline__ void gl_axpy(const v4u& w, float c, f32x2 (&acc)[8]) {
    const f32x2 cc = {c, c};
    if (CHEAP) {
#pragma unroll
        for (int j = 0; j < 4; ++j) { acc[2 * j] += cc * __builtin_bit_cast(f32x2, (v2u){w[j], w[j] << 3}); acc[2 * j + 1] += cc * __builtin_bit_cast(f32x2, (v2u){w[j] << 5, w[j] << 7}); }
        return; }
#pragma unroll
    for (int j = 0; j < 4; ++j) { acc[2 * j] += cc * __builtin_amdgcn_cvt_pk_f32_fp8((int)w[j], false); acc[2 * j + 1] += cc * __builtin_amdgcn_cvt_pk_f32_fp8((int)w[j], true); }
}
__device__ __forceinline__ float swapmax16(float a) { auto r = __builtin_amdgcn_permlane16_swap(__builtin_bit_cast(unsigned, a), __builtin_bit_cast(unsigned, a), false, false); const unsigned r0 = r[0], r1 = r[1]; return fmaxf(__uint_as_float(r0), __uint_as_float(r1)); }
__device__ __forceinline__ float swapmax32(float a) { auto r = __builtin_amdgcn_permlane32_swap(__builtin_bit_cast(unsigned, a), __builtin_bit_cast(unsigned, a), false, false); const unsigned r0 = r[0], r1 = r[1]; return fmaxf(__uint_as_float(r0), __uint_as_float(r1)); }
__device__ __forceinline__ float wave_max(float v) { v = fmaxf(v, dppf<0xB1>(v)); v = fmaxf(v, dppf<0x4E>(v)); v = fmaxf(v, dppf<0x141>(v)); v = fmaxf(v, dppf<0x140>(v)); return swapmax32(swapmax16(v)); }
#define GL_WAIT() asm volatile("s_waitcnt lgkmcnt(0)" ::: "memory")
typedef const __attribute__((address_space(1))) unsigned char* gl_gptr;
#define GL_LOAD1(bufl, tab, entl_, j_) do { const unsigned vo_ = (unsigned)__builtin_amdgcn_readlane((int)(entl_), 8 * (j_)) + lane16; bufl[j_] = *(const __attribute__((address_space(1))) v4u*)((gl_gptr)(tab) + vo_); } while (0)
#define GL_RLOAD(buf, tab, bidx) do { const unsigned ent_ = Ls[8 * (bidx) + (lane >> 3)]; \
    _Pragma("unroll") for (int j_ = 0; j_ < 8; ++j_) GL_LOAD1(buf, tab, ent_, j_); } while (0)
#define GL_VSWITCH(kn_) do { const int s_ = (mapbits >> (2 * (kn_))) & 3; LAS unsigned char* sp_ = ACCS + s_ * 4096 + 64 * lane; \
    const f32x4 t0_ = *(const LAS f32x4*)sp_, t1_ = *(const LAS f32x4*)(sp_ + 16), t2_ = *(const LAS f32x4*)(sp_ + 32), t3_ = *(const LAS f32x4*)(sp_ + 48); \
    *(LAS f32x4*)sp_ = (f32x4){cur[0].x, cur[0].y, cur[1].x, cur[1].y}; *(LAS f32x4*)(sp_ + 16) = (f32x4){cur[2].x, cur[2].y, cur[3].x, cur[3].y}; \
    *(LAS f32x4*)(sp_ + 32) = (f32x4){cur[4].x, cur[4].y, cur[5].x, cur[5].y}; *(LAS f32x4*)(sp_ + 48) = (f32x4){cur[6].x, cur[6].y, cur[7].x, cur[7].y}; \
    cur[0] = (f32x2){t0_[0], t0_[1]}; cur[1] = (f32x2){t0_[2], t0_[3]}; cur[2] = (f32x2){t1_[0], t1_[1]}; cur[3] = (f32x2){t1_[2], t1_[3]}; \
    cur[4] = (f32x2){t2_[0], t2_[1]}; cur[5] = (f32x2){t2_[2], t2_[3]}; cur[6] = (f32x2){t3_[0], t3_[1]}; cur[7] = (f32x2){t3_[2], t3_[3]}; \
    mapbits = (mapbits & ~(3 << (2 * kcur))) | (s_ << (2 * kcur)); kcur = (kn_); } while (0)
template <int CTRL> __device__ __forceinline__ int dppi(int x) { return __builtin_amdgcn_mov_dpp(x, CTRL, 0xf, 0xf, true); }
__device__ __forceinline__ int swapsum32i(int a, int b) { auto r = __builtin_amdgcn_permlane32_swap((unsigned)a, (unsigned)b, false, false); const unsigned r0 = r[0], r1 = r[1]; return (int)(r0 + r1); }
__device__ __forceinline__ int swapsum16i(int a, int b) { auto r = __builtin_amdgcn_permlane16_swap((unsigned)a, (unsigned)b, false, false); const unsigned r0 = r[0], r1 = r[1]; return (int)(r0 + r1); }
#define GL_USTEP(bufc, bufl, bc, bl) do { const unsigned entc_ = Ks[8 * (bc) + (lane >> 3)], entl_ = Ls[8 * (bl) + (lane >> 3)]; int p[8]; \
    _Pragma("unroll") for (int j_ = 0; j_ < 8; ++j_) { GL_LOAD1(bufl, U, entl_, j_); \
        const int kk_ = __builtin_amdgcn_readlane((int)entc_, 8 * j_); \
        if (kk_ != kcu) { asm volatile("" ::: "memory"); xcur = kk_ == 0 ? xr[0] : kk_ == 1 ? xr[1] : kk_ == 2 ? xr[2] : xr[3]; kcu = kk_; } \
        int s_; asm volatile("v_dot4_i32_i8 %0, %1, %2, 0" : "=v"(s_) : "v"(bufc[j_][0]), "v"(xcur[0])); \
        asm volatile("v_dot4_i32_i8 %0, %1, %2, %0" : "+v"(s_) : "v"(bufc[j_][1]), "v"(xcur[1])); asm volatile("v_dot4_i32_i8 %0, %1, %2, %0" : "+v"(s_) : "v"(bufc[j_][2]), "v"(xcur[2])); \
        asm volatile("v_dot4_i32_i8 %0, %1, %2, %0" : "+v"(s_) : "v"(bufc[j_][3]), "v"(xcur[3])); p[j_] = s_; } \
    asm volatile("s_nop 2" : "+v"(p[0]), "+v"(p[1]), "+v"(p[2]), "+v"(p[3]), "+v"(p[4]), "+v"(p[5]), "+v"(p[6]), "+v"(p[7]));        \
    _Pragma("unroll") for (int q_ = 0; q_ < 4; ++q_) p[q_] = swapsum32i(p[q_], p[q_ + 4]); \
    _Pragma("unroll") for (int q_ = 0; q_ < 2; ++q_) p[q_] = swapsum16i(p[q_], p[q_ + 2]); \
    { const bool up_ = (lane & 8) != 0; const int snd_ = up_ ? p[0] : p[1]; const int keep_ = up_ ? p[1] : p[0]; p[0] = keep_ + dppi<0x128>(snd_); } \
    p[0] += dppi<0xB1>(p[0]); p[0] += dppi<0x4E>(p[0]); p[0] += dppi<0x141>(p[0]);        \
    if ((lane & 7) == 0) Ds[8 * (bc) + (lane >> 3)] = (float)p[0]; } while (0)
#define GL_VSTEP(bufc, bufl, bc, bl) do { const unsigned entc_ = Ks[8 * (bc) + (lane >> 3)], entl_ = Ls[8 * (bl) + (lane >> 3)]; const float wv_ = Ws[8 * (bc) + (lane >> 3)]; \
    _Pragma("unroll") for (int j_ = 0; j_ < 8; ++j_) { GL_LOAD1(bufl, V, entl_, j_); \
        const int kk_ = __builtin_amdgcn_readlane((int)entc_, 8 * j_); \
        const float w_ = __builtin_bit_cast(float, __builtin_amdgcn_readlane(__builtin_bit_cast(int, wv_), 8 * j_)); \
        if (kk_ != kcur) { asm volatile("" ::: "memory"); GL_VSWITCH(kk_); } \
        gl_axpy<DUMMY && (GL_PROBE_SKIP & 4) != 0>(bufc[j_], w_, cur); } } while (0)
#define GL_SWEEP(tab, STEP) do { GL_RLOAD(buf0, tab, 0); GL_RLOAD(buf1, tab, 1); GL_RLOAD(buf2, tab, 2); \
    _Pragma("unroll 1") for (int b_ = 0; b_ < GL_NBT; b_ += 4) { \
        STEP(buf0, buf3, b_, b_ + 3); \
        STEP(buf1, buf0, b_ + 1, (b_ + 4 < GL_NBT ? b_ + 4 : GL_NBT - 1)); \
        STEP(buf2, buf1, b_ + 2, (b_ + 5 < GL_NBT ? b_ + 5 : GL_NBT - 1)); \
        STEP(buf3, buf2, b_ + 3, (b_ + 6 < GL_NBT ? b_ + 6 : GL_NBT - 1)); } } while (0)

template <bool DUMMY> __device__ __forceinline__ void p10_gather(const Args& A, LAS unsigned char* lds, int wave, int lane, const XcdBarrier& bar, unsigned emask) {
    unsigned* EIDX = (unsigned*)(A.ws + WS_EIDX); float* GATE = (float*)(A.ws + WS_GATE); const bf16* XN = (const bf16*)(A.ws + WS_XN);
    const unsigned char* U = A.ws + WS_U; const unsigned char* V = A.ws + WS_V;
    const float* USC = (const float*)(A.ws + WS_USC); const float* VSC = (const float*)(A.ws + WS_VSC);
    float* MODV = (float*)(A.ws + WS_MODV); float* OUT = A.out; const float* fnw = A.in[I_FNW];
    LAS unsigned char* wl = lds + wave * GL_WAVE_BYTES;
    LAS unsigned* Ls = (LAS unsigned*)(wl + GL_L); LAS unsigned char* Ks = wl + GL_K; LAS float* Ws = (LAS float*)(wl + GL_W); LAS float* USs = (LAS float*)(wl + GL_US); LAS float* Ds = (LAS float*)(wl + GL_D);
    LAS unsigned* CNT = (LAS unsigned*)(wl + GL_CNT); LAS unsigned* OFF = (LAS unsigned*)(wl + GL_OFF); LAS unsigned char* XS = wl + GL_X; LAS unsigned char* ACCS = wl + GL_ACC; LAS float* SXS = (LAS float*)(wl + GL_CNT);
    const unsigned lane16 = 16u * (unsigned)lane;
    const int gw = blockIdx.x * 8 + wave, NGW = gridDim.x * 8, NGRP = T / GL_TG;
    (void)bar;
    unsigned e[2 * GL_TG]; float g[2 * GL_TG], us[2 * GL_TG]; const float* USA = (const float*)(A.ws + WS_USA);
#define GL_LOADSEL(E_, G_, U_, grp_) do { _Pragma("unroll") for (int j = 0; j < 2 * GL_TG; ++j) { const size_t o = (size_t)(GL_TG * (grp_) + (j >> 1)) * 128 + (j & 1) * 64 + lane; E_[j] = EIDX[o] & emask; G_[j] = GATE[o]; U_[j] = USA[o]; } } while (0)
    if (gw < NGRP) GL_LOADSEL(e, g, us, gw);
    for (int it = 0; it < (NGRP + NGW - 1) / NGW; ++it) {
        const int gi = gw + it * NGW;
#ifndef GL_GRID_SYNC
#define GL_GRID_SYNC 0
#endif
        if (GL_GRID_SYNC && N_LAUNCHES == 1 && it > 0 && !DUMMY) xcd_barrier(bar); else __syncthreads();
        if (gi < NGRP) {
            const int t0 = GL_TG * gi;
            CNT[lane] = 0u; GL_WAIT();
            unsigned ps[2 * GL_TG]; v4u xr[GL_TG];
#pragma unroll
            for (int j = 0; j < 2 * GL_TG; ++j) ps[j] = __hip_atomic_fetch_add(CNT + (((e[j] >> GL_RSH) << GL_KB) | (unsigned)(j >> 1)), 1u, __ATOMIC_RELAXED, __HIP_MEMORY_SCOPE_WORKGROUP);
            GL_WAIT();
            { const unsigned c = CNT[lane]; unsigned incl = c;
#pragma unroll
              for (int o = 1; o < 64; o <<= 1) { const unsigned v = (unsigned)__shfl_up((int)incl, o); if (lane >= o) incl += v; }
              OFF[lane] = incl - c; }
            GL_WAIT();
#pragma unroll
            for (int j = 0; j < 2 * GL_TG; ++j) { const unsigned i2 = OFF[((e[j] >> GL_RSH) << GL_KB) | (unsigned)(j >> 1)] + ps[j];
                Ls[i2] = e[j] << 10; Ks[i2] = (unsigned char)(j >> 1); Ws[i2] = g[j]; USs[i2] = us[j]; }
#pragma unroll
            for (int k = 0; k < GL_TG; ++k) { const v4u a = *(const v4u*)(XN + (size_t)(t0 + k) * 1024 + 16 * lane), b2 = *(const v4u*)(XN + (size_t)(t0 + k) * 1024 + 16 * lane + 8);
                float xv[16]; float am = 0.f;
#pragma unroll
                for (int j = 0; j < 4; ++j) { xv[2 * j] = bflo(a[j]); xv[2 * j + 1] = bfhi(a[j]); xv[8 + 2 * j] = bflo(b2[j]); xv[8 + 2 * j + 1] = bfhi(b2[j]); }
#pragma unroll
                for (int j = 0; j < 16; ++j) am = fmaxf(am, fabsf(xv[j]));
                am = wave_max(am); const float inv8 = am > 0.f ? 127.f / am : 0.f;
                v4u qx;
#pragma unroll
                for (int j = 0; j < 4; ++j) qx[j] = ((unsigned)__float2int_rn(xv[4 * j] * inv8) & 255u) | (((unsigned)__float2int_rn(xv[4 * j + 1] * inv8) & 255u) << 8)
                                                  | (((unsigned)__float2int_rn(xv[4 * j + 2] * inv8) & 255u) << 16) | (((unsigned)__float2int_rn(xv[4 * j + 3] * inv8) & 255u) << 24);
                xr[k] = qx; if (lane == 0) SXS[k] = am * (1.f / 127.f); }
            GL_WAIT();
            v4u buf0[8], buf1[8], buf2[8], buf3[8];
            { v4u xcur = xr[0]; int kcu = 0;
              if (!(DUMMY && (GL_PROBE_SKIP & 1))) GL_SWEEP(U, GL_USTEP); }
            GL_WAIT();
#pragma unroll
            for (int j = 0; j < 2 * GL_TG; ++j) { const int i = lane + 64 * j; Ws[i] = Ws[i] * gelu_f(Ds[i] * USs[i] * SXS[Ks[i]]); }
            GL_WAIT();
            f32x2 cur[8]; int kcur = 0; int mapbits = (0 << 2) | (1 << 4) | (2 << 6);
            { LAS unsigned char* zp = ACCS + 64 * lane;
#pragma unroll
              for (int q = 0; q < 4 * (GL_TG - 1); ++q) *(LAS f32x4*)(zp + (q >> 2) * 4096 + (q & 3) * 16) = (f32x4){0.f, 0.f, 0.f, 0.f}; }
#pragma unroll
            for (int i = 0; i < 8; ++i) cur[i] = (f32x2){0.f, 0.f};
            GL_WAIT();
            if (!(DUMMY && (GL_PROBE_SKIP & 2)))
            GL_SWEEP(V, GL_VSTEP);
            { const int gn = gi + NGW < NGRP ? gi + NGW : gi; GL_LOADSEL(e, g, us, gn); }
            const float* fnw_ = fnw; asm volatile("" : "+s"(fnw_));
            v4u xa1_[GL_TG], xb1_[GL_TG]; f32x4 ga_[4], wa_[4];
#pragma unroll
            for (int k = 0; k < GL_TG; ++k) { const bf16* x1p = (const bf16*)(A.ws + WS_X1B) + x1b_off(t0 + k, 16 * lane); xa1_[k] = *(const v4u*)x1p; xb1_[k] = *(const v4u*)(x1p + 8); }
            { const float* g5 = MODV + (size_t)(t0 >> 12) * 6144 + 5 * 1024 + 16 * lane;
#pragma unroll
              for (int q = 0; q < 4; ++q) { ga_[q] = *(const f32x4*)(g5 + 4 * q); wa_[q] = *(const f32x4*)(fnw_ + 16 * lane + 4 * q); } }
#pragma unroll
            for (int k = 0; k < GL_TG; ++k) { const int t = t0 + k;
                if (k != kcur) { asm volatile("" ::: "memory"); GL_VSWITCH(k); }
                float* orow = OUT + (size_t)t * 1024 + 16 * lane; const v4u xa1 = xa1_[k], xb1 = xb1_[k];
                float x2[16]; float ss = 0.f;
#pragma unroll
                for (int q = 0; q < 4; ++q) { const unsigned w0_ = q < 2 ? xa1[2 * q] : xb1[2 * q - 4], w1_ = q < 2 ? xa1[2 * q + 1] : xb1[2 * q - 3];
                    const f32x4 a = {bflo(w0_), bfhi(w0_), bflo(w1_), bfhi(w1_)}, ga = ga_[q];
                    x2[4 * q] = a[0] + ga[0] * cur[2 * q].x; x2[4 * q + 1] = a[1] + ga[1] * cur[2 * q].y; x2[4 * q + 2] = a[2] + ga[2] * cur[2 * q + 1].x; x2[4 * q + 3] = a[3] + ga[3] * cur[2 * q + 1].y; }
#pragma unroll
                for (int i = 0; i < 16; ++i) ss += x2[i] * x2[i];
                const float rstd = rsqrtf(wave_sum(ss) * (1.f / 1024.f) + EPS);
#pragma unroll
                for (int q = 0; q < 4; ++q) { const f32x4 wa = wa_[q]; f32x4 oa;
#pragma unroll
                    for (int i = 0; i < 4; ++i) oa[i] = x2[4 * q + i] * rstd * wa[i];
                    if (!DUMMY || rstd == 123.456f) *(f32x4*)(orow + 4 * q) = oa; } }
        }
    }
}
#endif
__global__ void __launch_bounds__(512, 2) fwd_kernel(Args args) {
    extern __shared__ __attribute__((aligned(16))) unsigned char lds_raw[];
    LAS unsigned char* lds = (LAS unsigned char*)lds_raw;
    volatile LAS unsigned* MISC = (volatile LAS unsigned*)(lds + MISC_OFF);
    const int tid = threadIdx.x, lane = tid & 63, wave = __builtin_amdgcn_readfirstlane(tid >> 6);
    for (int u = tid; u < (LDS_BYTES - LDSCTL_OFF) / 4; u += 512) ((LAS unsigned*)(lds + LDSCTL_OFF))[u] = 0u;
    __syncthreads();
    unsigned* ctl = (unsigned*)(args.ws + WS_CTL);
    XcdBarrier bar; bar.bar = ctl + CW_BAR; bar.x = 0; bar.st = nullptr;
    if (N_LAUNCHES == 1) bar = xcd_barrier_post(ctl + CW_BAR, MISC + 8);
    const int lo = args.ph_lo, hi = args.ph_hi;
#ifndef ONLY_PHASE
#define ONLY_PHASE -1
#endif
#define IN(k) ((ONLY_PHASE < 0 || ONLY_PHASE == (k)) && lo <= (k) && (k) < hi)
#define SEAM(k) do { if (IN(k) && IN((k) + 1)) xcd_barrier(bar); } while (0)
#ifndef DUP_MASK
#define DUP_MASK 0
#endif
#define REP(k) for (int rep_ = 0; rep_ < (((DUP_MASK >> (k)) & 1) ? 2 : 1); ++rep_, (rep_ < (((DUP_MASK >> (k)) & 1) ? 2 : 1) ? xcd_barrier(bar) : (void)0))

#ifdef UB_KIND
    {
        f32x2 a0 = {1.f + tid, 2.f}, a1 = a0 * 1.5f, a2 = a0 * 2.5f, a3 = a0 * 3.5f, a4 = a0 * 4.5f, a5 = a0 * 5.5f, a6 = a0 * 6.5f, a7 = a0 * 7.5f;
        f32x2 m = {1.0001f, 0.9999f}, c = {1e-3f, -1e-3f}; unsigned w = 0x38343c30u + tid;
#if UB_KIND == 1
#define UB_OP(q_) asm volatile("v_pk_fma_f32 %0, %0, %1, %2" : "+v"(q_) : "v"(m), "v"(c))
#elif UB_KIND == 2
#define UB_OP(q_) asm volatile("v_fma_f32 %0, %0, %1, %2" : "+v"(q_.x) : "v"(m.x), "v"(c.x))
#elif UB_KIND == 3
#define UB_OP(q_) asm volatile("v_cvt_pk_f32_fp8 %0, %1" : "=v"(q_) : "v"(w))
#elif UB_KIND == 4
#define UB_OP(q_) asm volatile("v_dot4c_i32_i8 %0, %1, %2" : "+v"(q_.x) : "v"(w), "v"(m.x))
#elif UB_KIND == 5
#define UB_OP(q_) asm volatile("v_pk_fma_f16 %0, %0, %1, %2" : "+v"(q_.x) : "v"(m.x), "v"(c.x))
#elif UB_KIND == 6
#define UB_OP(q_) asm volatile("v_cvt_scalef32_pk_f16_fp8 %0, %1, %2" : "+v"(q_.x) : "v"(w), "v"(m.x))
#endif
#pragma unroll 1
        for (int i = 0; i < UB_N; ++i) {
#pragma unroll
            for (int r = 0; r < 4; ++r) { UB_OP(a0); UB_OP(a1); UB_OP(a2); UB_OP(a3); UB_OP(a4); UB_OP(a5); UB_OP(a6); UB_OP(a7); }
        }
        const f32x2 sum = a0 + a1 + a2 + a3 + a4 + a5 + a6 + a7;
        if (sum.x == 123.456f && sum.y == 654.321f) ((float*)(args.ws + WS_END - 4096))[tid] = sum.x;
    }
#endif
    if (IN(0)) REP(0) { p0_mod(args, lds, tid); p0_weights(args, lds, tid, wave, lane); p0_wc(args, lds, tid); }
    SEAM(0);
    if (IN(1)) REP(1) { p1_norm(args, lds, tid, wave, lane, 0); }
    SEAM(1);
    if (IN(2)) REP(2) {
        pg8::Gemm g{(const pg8::bf16_t*)(args.ws + WS_XN), (const pg8::bf16_t*)(args.ws + WS_WIN), MROWS, 2560, 1024};
        InProjOrder S; S.init((int)gridDim.x, (int)blockIdx.x);
        EpiInProj E{(bf16*)(args.ws + WS_ZS), (bf16*)(args.ws + WS_XBC), (bf16*)(args.ws + WS_UGLU)};
        pg8::gemm_phase<EpiInProj, InProjOrder, true, true>(lds, g, S, E);
    }
    SEAM(2);
    if (IN(3)) REP(3) {
        const int G3 = (int)gridDim.x, c3 = (int)blockIdx.x, NSSD = NB * NCC * 2, NCTX = NB * 2 * 2, NCONV = NB * 2 * 64;
        for (int it = c3; it < NSSD; it += G3) ssd_local_item(args, lds, it, tid, wave, lane);
        const bool split = G3 == 256;
        if (!split || c3 >= NCTX) for (int j = split ? c3 - NCTX : c3; j < NCONV; j += split ? G3 - NCTX : G3) cfm_conv_item(args, j, tid);
    }
    SEAM(3);
    if (IN(4)) REP(4) { p4_recur(args, tid); }
    SEAM(4);
    if (IN(5)) REP(5) {
        for (int it = blockIdx.x; it < NB * 32 * 2; it += gridDim.x) ssd_out_item(args, lds, it, tid, wave, lane);
        cfm_ln_rows(args, wave, lane);
    }
    SEAM(5);
    if (IN(6)) REP(6) {
        pg8::Gemm g{(const pg8::bf16_t*)(args.ws + WS_XN), (const pg8::bf16_t*)(args.ws + WS_WOUT), T, 1024, 1024};
        pg8::StaticOrder S; S.init(T, 1024, (int)gridDim.x, (int)blockIdx.x);
        EpiOutProj E{args.in[I_X], (bf16*)(args.ws + WS_X1B), (float*)(args.ws + WS_MODV)};
        pg8::gemm_phase<EpiOutProj, pg8::StaticOrder, true, true>(lds, g, S, E);
    }
    SEAM(6);
    if (IN(7)) REP(7) { p7_norm2(args, wave, lane); }
    SEAM(7);
    if (IN(8)) REP(8) {
        pg8::Gemm g{(const pg8::bf16_t*)(args.ws + WS_WC), (const pg8::bf16_t*)(args.ws + WS_XN), 2048, T, 1024};
        pg8::StaticOrder S; S.init(2048, T, (int)gridDim.x, (int)blockIdx.x);
        EpiScore E{(_Float16*)(args.ws + WS_SC)};
        pg8::gemm_phase<EpiScore, pg8::StaticOrder, true, true>(lds, g, S, E);
    }
    SEAM(8);
    if (IN(9)) REP(9) {
        p9_select_init(lds, tid); __syncthreads();
        for (int item = blockIdx.x; item < 8 * (T / 512); item += gridDim.x) p9_select_one(args, lds, tid, (item >> 3) * 512 + tid, item & 7);
    }
    SEAM(9);
#if PEER_FP8 && !defined(PEER_FLAT)
#ifdef PEER_PROBE_MASK
    if (IN(10)) { p10_gather<true>(args, lds, wave, lane, bar, PEER_PROBE_MASK); }
#endif
    if (IN(10)) REP(10) { p10_gather<false>(args, lds, wave, lane, bar, 0xffffffffu); }
#else
    if (IN(10)) REP(10) { p9_peer<false>(args, wave, lane, 0xffffffffu); }
#endif
#undef IN
#undef SEAM
}

#ifndef HOST_DUP_MASK
#define HOST_DUP_MASK 0
#endif
extern "C" void kernel_launch(void* const* d_in, const int* in_sizes, int n_in, void* d_out, int out_size, void* d_ws, size_t ws_size, hipStream_t stream) {
    static int grid = 0;
    if (grid == 0) {
        if (n_in != 25 || in_sizes[0] != T * D || out_size != T * D || ws_size < WS_END) {
            fprintf(stderr, "kernel_launch: unexpected problem (n_in %d, in0 %d, out %d, ws %zu); nothing launched\n", n_in, n_in > 0 ? in_sizes[0] : -1, out_size, ws_size); grid = -1; return; }
        int dev = 0, cus = 0, per_cu = 0;
        if (hipGetDevice(&dev) != hipSuccess || hipDeviceGetAttribute(&cus, hipDeviceAttributeMultiprocessorCount, dev) != hipSuccess) { grid = -1; return; }
        if (hipFuncSetAttribute((const void*)fwd_kernel, hipFuncAttributeMaxDynamicSharedMemorySize, LDS_BYTES) != hipSuccess) { fprintf(stderr, "kernel_launch: hipFuncSetAttribute failed\n"); grid = -1; return; }
        if (hipOccupancyMaxActiveBlocksPerMultiprocessor(&per_cu, (const void*)fwd_kernel, 512, LDS_BYTES) != hipSuccess || per_cu < 1) { fprintf(stderr, "kernel_launch: occupancy query says %d blocks/CU\n", per_cu); grid = -1; (void)hipGetLastError(); return; }
        (void)hipGetLastError();
        grid = cus;
    }
    if (grid < 0) return;
    (void)hipMemsetAsync((char*)d_ws + WS_CTL, 0, CTL_ZERO_BYTES, stream);
    Args a{};
    for (int i = 0; i < 25; ++i) a.in[i] = (const float*)d_in[i];
    a.out = (float*)d_out; a.ws = (unsigned char*)d_ws;
    if (N_LAUNCHES == 1) {
        a.ph_lo = 0; a.ph_hi = NPHASE; a.li = 0;
        hipLaunchKernelGGL(fwd_kernel, dim3(grid), dim3(512), LDS_BYTES, stream, a);
    } else {
        for (int li = 0; li < NPHASE; ++li) { a.ph_lo = li; a.ph_hi = li + 1; a.li = li;
            for (int r = 0; r < (((HOST_DUP_MASK >> li) & 1) ? 2 : 1); ++r) hipLaunchKernelGGL(fwd_kernel, dim3(grid), dim3(512), LDS_BYTES, stream, a); }
    }
}
```
